# Optimizing an MI355X kernel written in HIP

```python
import math
import jax, jax.numpy as jnp
from jax import lax
import numpy as np

D_MODEL = 1024
BATCH = 8
SEQ = 4096
DEPTH = 2

CHUNK = 64
Q_BLOCK = 128
EPS = 1e-6

D_MIX = D_MODEL
D_SSM = D_MIX // 2
SSM_GROUP = 16
SSM_GROUPS = D_SSM // SSM_GROUP
SSM_STATE = 64
STEP_MIN = 0.001
STEP_MAX = 0.1

MLA_HEADS = 8
D_MLA = D_MIX - D_SSM
MLA_V_DIM = D_MLA // MLA_HEADS
MLA_NOPE = 64
MLA_ROPE = 32
MLA_QK = MLA_NOPE + MLA_ROPE
MLA_Q_RANK = 256
MLA_KV_RANK = 128
ROPE_THETA = 10000.0

D_IN = D_SSM + MLA_Q_RANK + MLA_KV_RANK + MLA_ROPE

FFN_DENSE = 2816
N_EXPERTS = 8
TOP_K = 2
FFN_EXPERT = 3584
N_DENSE = (DEPTH + 1) // 2
N_MOE = DEPTH // 2

kernel_name = "hybrid_s5_mla_moe_chunk_causal"


def rms_norm(x, g):
    xf = x.astype(jnp.float32)
    y = xf * lax.rsqrt(jnp.mean(xf * xf, axis=-1, keepdims=True) + EPS)
    return (y * g.astype(jnp.float32)).astype(x.dtype)


def rope_tables(length):
    inv = 1.0 / (ROPE_THETA ** (jnp.arange(0, MLA_ROPE, 2, dtype=jnp.float32) / MLA_ROPE))
    ang = jnp.arange(length, dtype=jnp.float32)[:, None] * inv[None, :]
    return jnp.cos(ang), jnp.sin(ang)


def apply_rope(x, cos, sin):
    x1, x2 = jnp.split(x, 2, axis=-1)
    c = cos[None, :, None, :].astype(x.dtype)
    s = sin[None, :, None, :].astype(x.dtype)
    return jnp.concatenate([x1 * c - x2 * s, x1 * s + x2 * c], axis=-1)


def swiglu(x, w_gate, w_up, w_down):
    return (jax.nn.silu(x @ w_gate) * (x @ w_up)) @ w_down


def s5_mixer(u, A_re, A_im, log_step, B_re, B_im, C_re, C_im, D, w_glu, b_glu):
    f32 = jnp.float32
    bsz, length, _ = u.shape
    n_chunks = length // CHUNK
    lam = lax.complex(A_re.astype(f32), A_im.astype(f32))
    step = jnp.exp(log_step.astype(f32))[:, None]
    a_bar = jnp.exp(lam * step)
    b_scale = (a_bar - 1.0) / lam
    b_bar = lax.complex(B_re.astype(f32), B_im.astype(f32)) * b_scale[:, :, None]
    c_re = C_re.astype(f32)
    c_im = C_im.astype(f32)
    uf = u.astype(f32).reshape(bsz, n_chunks, CHUNK, SSM_GROUPS, SSM_GROUP)
    uf = jnp.transpose(uf, (1, 2, 0, 3, 4))
    a_seq = jnp.broadcast_to(a_bar, (CHUNK, bsz, SSM_GROUPS, SSM_STATE))

    def combine(earlier, later):
        a1, b1 = earlier
        a2, b2 = later
        return a2 * a1, a2 * b1 + b2

    def chunk_step(state, u_c):
        bu = jnp.einsum('tbgh,gph->tbgp', u_c.astype(jnp.complex64), b_bar)
        a_cum, s_loc = lax.associative_scan(combine, (a_seq, bu), axis=0)
        s = s_loc + a_cum * state[None]
        y = (jnp.einsum('tbgp,ghp->tbgh', s.real, c_re)
             - jnp.einsum('tbgp,ghp->tbgh', s.imag, c_im))
        return s[-1], y

    init = jnp.zeros((bsz, SSM_GROUPS, SSM_STATE), jnp.complex64)
    _, ys = lax.scan(chunk_step, init, uf)
    ys = ys + D.astype(f32) * uf
    y = jnp.transpose(ys, (2, 0, 1, 3, 4)).reshape(bsz, length, D_SSM)
    y = jax.nn.gelu(y)
    y = y * jax.nn.sigmoid(y @ w_glu.astype(f32) + b_glu.astype(f32))
    return y.astype(u.dtype)


def mla_mixer(q_lat, kv_lat, k_rope, q_norm, w_q_up, kv_norm, w_kv_up, q_gain, k_gain, cos, sin):
    bsz, length, _ = q_lat.shape
    q = (rms_norm(q_lat, q_norm) @ w_q_up).reshape(bsz, length, MLA_HEADS, MLA_QK)
    kv = (rms_norm(kv_lat, kv_norm) @ w_kv_up).reshape(bsz, length, MLA_HEADS, MLA_NOPE + MLA_V_DIM)
    k_nope, v = kv[..., :MLA_NOPE], kv[..., MLA_NOPE:]
    k = jnp.concatenate(
        [k_nope, jnp.broadcast_to(k_rope[:, :, None, :], (bsz, length, MLA_HEADS, MLA_ROPE))], axis=-1)
    q = rms_norm(q, q_gain)
    k = rms_norm(k, k_gain)
    q = jnp.concatenate([q[..., :MLA_NOPE], apply_rope(q[..., MLA_NOPE:], cos, sin)], axis=-1)
    k = jnp.concatenate([k[..., :MLA_NOPE], apply_rope(k[..., MLA_NOPE:], cos, sin)], axis=-1)
    scale = MLA_QK ** -0.5
    chunk_id = jnp.arange(length) // CHUNK
    outs = []
    for blk in range(length // Q_BLOCK):
        q0 = blk * Q_BLOCK
        k_end = q0 + Q_BLOCK
        s = jnp.einsum('bqhd,bkhd->bhqk', q[:, q0:k_end], k[:, :k_end],
                       preferred_element_type=jnp.float32) * scale
        mask = chunk_id[q0:k_end, None] >= chunk_id[None, :k_end]
        s = jnp.where(mask[None, None], s, -jnp.inf)
        p = jax.nn.softmax(s, axis=-1)
        outs.append(jnp.einsum('bhqk,bkhd->bqhd', p.astype(v.dtype), v[:, :k_end]))
    return jnp.concatenate(outs, axis=1).reshape(bsz, length, D_MLA)


def moe_swiglu(h, w_router, w_gate, w_up, w_down):
    logits = (h @ w_router).astype(jnp.float32)
    top_val, top_idx = lax.top_k(logits, TOP_K)
    top_w = jax.nn.softmax(top_val, axis=-1)
    gates = jnp.sum(jax.nn.one_hot(top_idx, N_EXPERTS, dtype=jnp.float32) * top_w[..., None], axis=-2)
    out = jnp.zeros_like(h)
    for e in range(N_EXPERTS):
        out = out + gates[..., e:e + 1].astype(h.dtype) * swiglu(h, w_gate[e], w_up[e], w_down[e])
    return out


def setup_inputs(seed: int = 0) -> dict:
    key = jax.random.key(seed)
    ks = jax.random.split(key, 40)
    f32 = jnp.float32

    def nrm(k, shape, scale):
        return jax.random.normal(k, shape, f32) * scale

    def gain(k, shape):
        return 1.0 + 0.02 * jax.random.normal(k, shape, f32)

    G, P, H = SSM_GROUPS, SSM_STATE, SSM_GROUP
    x = jax.random.normal(ks[0], (BATCH, SEQ, D_MODEL), f32)
    attn_norm = gain(ks[1], (DEPTH, D_MODEL))
    w_in = nrm(ks[2], (DEPTH, D_MODEL, D_IN), D_MODEL ** -0.5)
    ssm_A_re = -0.5 + 0.01 * jax.random.normal(ks[3], (DEPTH, G, P), f32)
    ssm_A_im = (math.pi * jnp.arange(P, dtype=f32))[None, None, :] + 0.01 * jax.random.normal(ks[4], (DEPTH, G, P), f32)
    ssm_log_step = jax.random.uniform(ks[5], (DEPTH, G), f32, math.log(STEP_MIN), math.log(STEP_MAX))
    ssm_B_re = nrm(ks[6], (DEPTH, G, P, H), (2 * H) ** -0.5)
    ssm_B_im = nrm(ks[7], (DEPTH, G, P, H), (2 * H) ** -0.5)
    ssm_C_re = nrm(ks[8], (DEPTH, G, H, P), (2 * P) ** -0.5)
    ssm_C_im = nrm(ks[9], (DEPTH, G, H, P), (2 * P) ** -0.5)
    ssm_D = nrm(ks[10], (DEPTH, G, H), 1.0)
    ssm_w_glu = nrm(ks[11], (DEPTH, D_SSM, D_SSM), D_SSM ** -0.5)
    ssm_b_glu = nrm(ks[12], (DEPTH, D_SSM), 0.01)
    mla_q_norm = gain(ks[13], (DEPTH, MLA_Q_RANK))
    mla_w_q_up = nrm(ks[14], (DEPTH, MLA_Q_RANK, MLA_HEADS * MLA_QK), MLA_Q_RANK ** -0.5)
    mla_kv_norm = gain(ks[15], (DEPTH, MLA_KV_RANK))
    mla_w_kv_up = nrm(ks[16], (DEPTH, MLA_KV_RANK, MLA_HEADS * (MLA_NOPE + MLA_V_DIM)), MLA_KV_RANK ** -0.5)
    mla_q_gain = gain(ks[17], (DEPTH, MLA_QK))
    mla_k_gain = gain(ks[18], (DEPTH, MLA_QK))
    ssm_out_norm = gain(ks[19], (DEPTH, D_SSM))
    mla_out_norm = gain(ks[20], (DEPTH, D_MLA))
    w_out = nrm(ks[21], (DEPTH, D_MIX, D_MODEL), D_MIX ** -0.5)
    ffn_norm = gain(ks[22], (DEPTH, D_MODEL))
    dense_w_gate = nrm(ks[23], (N_DENSE, D_MODEL, FFN_DENSE), D_MODEL ** -0.5)
    dense_w_up = nrm(ks[24], (N_DENSE, D_MODEL, FFN_DENSE), D_MODEL ** -0.5)
    dense_w_down = nrm(ks[25], (N_DENSE, FFN_DENSE, D_MODEL), FFN_DENSE ** -0.5)
    moe_w_router = nrm(ks[26], (N_MOE, D_MODEL, N_EXPERTS), D_MODEL ** -0.5)
    moe_w_gate = nrm(ks[27], (N_MOE, N_EXPERTS, D_MODEL, FFN_EXPERT), D_MODEL ** -0.5)
    moe_w_up = nrm(ks[28], (N_MOE, N_EXPERTS, D_MODEL, FFN_EXPERT), D_MODEL ** -0.5)
    moe_w_down = nrm(ks[29], (N_MOE, N_EXPERTS, FFN_EXPERT, D_MODEL), FFN_EXPERT ** -0.5)
    return {
        "x": x, "attn_norm": attn_norm, "w_in": w_in,
        "ssm_A_re": ssm_A_re, "ssm_A_im": ssm_A_im, "ssm_log_step": ssm_log_step,
        "ssm_B_re": ssm_B_re, "ssm_B_im": ssm_B_im, "ssm_C_re": ssm_C_re, "ssm_C_im": ssm_C_im,
        "ssm_D": ssm_D, "ssm_w_glu": ssm_w_glu, "ssm_b_glu": ssm_b_glu,
        "mla_q_norm": mla_q_norm, "mla_w_q_up": mla_w_q_up, "mla_kv_norm": mla_kv_norm,
        "mla_w_kv_up": mla_w_kv_up, "mla_q_gain": mla_q_gain, "mla_k_gain": mla_k_gain,
        "ssm_out_norm": ssm_out_norm, "mla_out_norm": mla_out_norm, "w_out": w_out,
        "ffn_norm": ffn_norm, "dense_w_gate": dense_w_gate, "dense_w_up": dense_w_up,
        "dense_w_down": dense_w_down, "moe_w_router": moe_w_router, "moe_w_gate": moe_w_gate,
        "moe_w_up": moe_w_up, "moe_w_down": moe_w_down,
    }


def reference(x, attn_norm, w_in, ssm_A_re, ssm_A_im, ssm_log_step, ssm_B_re, ssm_B_im,
              ssm_C_re, ssm_C_im, ssm_D, ssm_w_glu, ssm_b_glu, mla_q_norm, mla_w_q_up,
              mla_kv_norm, mla_w_kv_up, mla_q_gain, mla_k_gain, ssm_out_norm, mla_out_norm,
              w_out, ffn_norm, dense_w_gate, dense_w_up, dense_w_down, moe_w_router,
              moe_w_gate, moe_w_up, moe_w_down):
    cos, sin = rope_tables(x.shape[1])
    split_at = [D_SSM, D_SSM + MLA_Q_RANK, D_SSM + MLA_Q_RANK + MLA_KV_RANK]
    h = x
    for layer in range(DEPTH):
        z = rms_norm(h, attn_norm[layer])
        proj = z @ w_in[layer]
        u, q_lat, kv_lat, k_rope = jnp.split(proj, split_at, axis=-1)
        y_ssm = s5_mixer(u, ssm_A_re[layer], ssm_A_im[layer], ssm_log_step[layer],
                         ssm_B_re[layer], ssm_B_im[layer], ssm_C_re[layer], ssm_C_im[layer],
                         ssm_D[layer], ssm_w_glu[layer], ssm_b_glu[layer])
        y_mla = mla_mixer(q_lat, kv_lat, k_rope, mla_q_norm[layer], mla_w_q_up[layer],
                          mla_kv_norm[layer], mla_w_kv_up[layer], mla_q_gain[layer],
                          mla_k_gain[layer], cos, sin)
        mixed = jnp.concatenate([rms_norm(y_ssm, ssm_out_norm[layer]),
                                 rms_norm(y_mla, mla_out_norm[layer])], axis=-1)
        h = h + mixed @ w_out[layer]
        z = rms_norm(h, ffn_norm[layer])
        if layer % 2 == 0:
            i = layer // 2
            h = h + swiglu(z, dense_w_gate[i], dense_w_up[i], dense_w_down[i])
        else:
            i = layer // 2
            h = h + moe_swiglu(z, moe_w_router[i], moe_w_gate[i], moe_w_up[i], moe_w_down[i])
    return h
```

```cpp
#include <hip/hip_runtime.h>
#include <cstdio>
#include <cstdint>

constexpr int NB = 8, SEQ = 4096, DM = 1024, M = NB * SEQ, DEPTH = 2;
#ifndef SSM_TCH
#define SSM_TCH 32
#endif
constexpr int DSSM = 512, NG = 32, GH = 16, NP = 64, TCH = SSM_TCH, NCH = SEQ / TCH;
constexpr int NROWG = NB * NCH, NYC = TCH * 16, SSM_RT = NROWG / 256, SSM_CT = NYC / 256, TP1 = TCH + 1;
constexpr int NHEAD = 8, DV = 64, DNOPE = 64, DROPE = 32, DQK = 96, QRANK = 256, KVRANK = 128;
constexpr int DIN = 928, FFD = 2816, NE = 8, FFE = 3584;
constexpr float EPS = 1e-6f;
constexpr int UAW = 128 + NYC;
constexpr int MOE_SLOTS = 34816;
constexpr int MOE_TILES = MOE_SLOTS / 256;

constexpr size_t MiB = 1u << 20;
constexpr size_t WS_CTL = 0, CTL_ZERO_BYTES = 64 * 1024;
constexpr size_t WS_WSMALL = 1 * MiB;
constexpr size_t WSM_IN = 0, WSM_GLU = 2 * MiB, WSM_Q = 2 * MiB + 512 * 1024, WSM_KV = 3 * MiB, WSM_OUT = 3 * MiB + 512 * 1024, WSM_STRIDE = 6 * MiB;
constexpr size_t WS_APOW = 13 * MiB;
constexpr size_t WS_ROUTE = 14 * MiB;
constexpr size_t RT_SLOT_TOK = 512 * 1024, RT_SLOT_W = RT_SLOT_TOK + 2 * MOE_SLOTS * 4, RT_TILE_E = RT_SLOT_W + 2 * MOE_SLOTS * 4, RT_NTILES = RT_TILE_E + 2 * MOE_TILES * 4;
constexpr size_t WS_SS = 16 * MiB;
constexpr size_t WS_SS2 = 126 * MiB, WS_SS3 = 124 * MiB;
constexpr size_t WS_BIGW = 19 * MiB;
constexpr size_t BW_MAUG = 0, BW_WST = 72 * MiB, BW_DGU = 88 * MiB, BW_DD = 99 * MiB;
constexpr size_t BW_MGU = 0, BW_MD = 112 * MiB;
constexpr size_t WS_HB = 195 * MiB;
constexpr size_t WS_MIX = 259 * MiB;
constexpr size_t WS_PL = 323 * MiB;
constexpr size_t WS_UAUG = 355 * MiB;
constexpr size_t WS_YG = 395 * MiB;
constexpr size_t WS_KVRAW = 128 * MiB;
constexpr size_t WS_QRAW = 427 * MiB;
constexpr size_t WS_ACTD = 323 * MiB;
constexpr size_t WS_ACTM = 259 * MiB;
constexpr size_t WS_END = 511 * MiB;
static_assert(WS_ACTM + (size_t)MOE_SLOTS * FFE * 2 <= WS_END && WS_ACTD + (size_t)M * FFD * 2 <= WS_END && WS_QRAW + (size_t)M * 768 * 2 <= WS_END, "ws map");
static_assert(WS_BIGW + BW_MD + (size_t)NE * DM * FFE * 2 <= WS_HB && WS_UAUG + (size_t)NG * NROWG * UAW * 2 <= WS_YG, "ws map 2");
static_assert(RT_NTILES + 64 <= 5 * MiB, "route map");

constexpr int CW_BAR = 4096;

#define GAS __attribute__((address_space(1)))
#define LAS __attribute__((address_space(3)))
typedef unsigned short bf16;
typedef unsigned v4u __attribute__((ext_vector_type(4)));
typedef unsigned v2u __attribute__((ext_vector_type(2)));
typedef float f32x4 __attribute__((ext_vector_type(4)));
typedef float f32x2 __attribute__((ext_vector_type(2)));
typedef short bf16x8 __attribute__((ext_vector_type(8)));
typedef __bf16 bf16x2_t __attribute__((ext_vector_type(2)));
#define LDS_WAIT() asm volatile("s_waitcnt lgkmcnt(0)" ::: "memory")
#define VM_WAIT() asm volatile("s_waitcnt vmcnt(0)" ::: "memory")
__device__ __forceinline__ unsigned pk2(float lo, float hi) { f32x2 v = {lo, hi}; bf16x2_t b = __builtin_convertvector(v, bf16x2_t); return __builtin_bit_cast(unsigned, b); }
__device__ __forceinline__ bf16 f2bf(float f) { return (bf16)(pk2(f, 0.f) & 0xffffu); }
__device__ __forceinline__ float bf2f(bf16 b) { return __builtin_bit_cast(float, (unsigned)b << 16); }
__device__ __forceinline__ float bflo(unsigned w) { return __builtin_bit_cast(float, w << 16); }
__device__ __forceinline__ float bfhi(unsigned w) { return __builtin_bit_cast(float, w & 0xffff0000u); }
__device__ __forceinline__ float wave_sum(float v) {
#pragma unroll
    for (int o = 1; o < 64; o <<= 1) v += __shfl_xor(v, o);
    return v;
}
__device__ __forceinline__ float sigmoidf_(float x) { return __builtin_amdgcn_rcpf(1.f + __builtin_amdgcn_exp2f(-1.4426950408889634f * x)); }
__device__ __forceinline__ float gelu_tanh(float x) { const float u = 0.7978845608028654f * (x + 0.044715f * x * x * x); return x * sigmoidf_(2.f * u); }

struct Params { const float* in[30]; float* out; unsigned char* ws; };
__device__ __forceinline__ const float* kin(int i) { const float* const* ka = (const float* const*)__builtin_amdgcn_kernarg_segment_ptr(); asm volatile("" : "+s"(ka)); return ka[i]; }
enum { I_X = 0, I_ATTN_NORM, I_W_IN, I_A_RE, I_A_IM, I_LOG_STEP, I_B_RE, I_B_IM, I_C_RE, I_C_IM, I_D, I_W_GLU, I_B_GLU, I_Q_NORM, I_W_Q_UP, I_KV_NORM, I_W_KV_UP,
       I_Q_GAIN, I_K_GAIN, I_SSM_OUT_NORM, I_MLA_OUT_NORM, I_W_OUT, I_FFN_NORM, I_DW_GATE, I_DW_UP, I_DW_DOWN, I_MW_ROUTER, I_MW_GATE, I_MW_UP, I_MW_DOWN };

#ifndef NAIVE
#define NAIVE 0
#endif
#ifndef FAST_GEMM
#define FAST_GEMM 1
#endif
namespace pg8 {
constexpr int BM = 256, BK = 64, HALF = 128, HTB = HALF * BK * 2, STAGE_BYTES = 8 * HTB, NXCD = 8, WGM = 8;
__host__ __device__ __forceinline__ int lds_byte(int r, int c) { const int st = (r >> 4) * 2 + (c >> 5), rr = r & 15, cc = c & 31, ob = rr * 64 + cc * 2; return st * 1024 + (ob ^ (((ob >> 9) & 1) << 5)); }
__host__ __device__ __forceinline__ void stage_rc(int b, int& R, int& C) { const int st = b / 1024, sb = b % 1024, swz = sb ^ (((sb >> 9) & 1) << 5); R = (st >> 1) * 16 + swz / 64; C = (st & 1) * 32 + (swz % 64) / 2; }
__host__ __device__ __forceinline__ int perm32(int rho) { const int n = rho >> 4, i = rho & 15; return 8 * (i >> 2) + 4 * n + (i & 3); }

struct Unit { int pm, pn, aux, kp, seq; };

__device__ __forceinline__ bool static_unit(int i, int G, int c, int nM, int nN, Unit& u) {
    const int nwg = nM * nN; const long L = (long)i * G + c; if (L >= nwg) return false;
    int wgid = (int)L; { const int q = nwg / NXCD, r = nwg % NXCD, xcd = wgid % NXCD, off = wgid / NXCD; wgid = (xcd < r ? xcd * (q + 1) : r * (q + 1) + (xcd - r) * q) + off; }
    const int nig = WGM * nN, gid = wgid / nig, fm = gid * WGM, gsz = (nM - fm) < WGM ? (nM - fm) : WGM;
    u.pm = fm + ((wgid % nig) % gsz); u.pn = (wgid % nig) / gsz; u.aux = 0; u.kp = -1; return true;
}

template <class T, class = void> struct has_mid { static constexpr bool value = false; };
template <class T> struct has_mid<T, decltype((void)T::MID_T)> { static constexpr bool value = true; };
template <class T, class = void> struct has_begin { static constexpr bool value = false; };
template <class T> struct has_begin<T, decltype((void)T::BEGIN)> { static constexpr bool value = true; };
template <class T, class = void> struct epi_nst { static constexpr int value = 0; };
template <class T> struct epi_nst<T, decltype((void)T::NST)> { static constexpr int value = T::NST; };
template <class T, class = void> struct has_pair { static constexpr bool value = false; };
template <class T> struct has_pair<T, decltype((void)T::PAIR)> { static constexpr bool value = true; };
template <class T, class = void> struct has_custom { static constexpr bool value = false; };
template <class T> struct has_custom<T, decltype((void)T::CUSTOM)> { static constexpr bool value = true; };
template <class Epi> __device__ __forceinline__ void epi_apply(const Epi& E, const f32x4 (&acc)[2][2][4][2], const Unit& u, int wr, int wc, int fr, int fq) {
    if constexpr (has_custom<Epi>::value) E.apply(acc, u, wr, wc, fr, fq);
    else {
#pragma unroll
    for (int ai = 0; ai < 2; ++ai)
#pragma unroll
        for (int m = 0; m < 4; ++m) { const int r = ai * HALF + wr * 64 + m * 16 + fr;
            if constexpr (has_pair<Epi>::value) E.putpair(u, r, wc * 32 + 8 * fq, acc[ai][0][m][0], acc[ai][0][m][1], acc[ai][1][m][0], acc[ai][1][m][1]);
            else {
#pragma unroll
            for (int bj = 0; bj < 2; ++bj) {
                if constexpr (Epi::PERM) E.put8(u, r, bj * HALF + wc * 32 + 8 * fq, acc[ai][bj][m][0], acc[ai][bj][m][1]);
                else { E.put4(u, r, bj * HALF + wc * 32 + 4 * fq, acc[ai][bj][m][0]); E.put4(u, r, bj * HALF + wc * 32 + 16 + 4 * fq, acc[ai][bj][m][1]); } } }
            asm volatile("" ::: "memory"); }
    }
}

template <class Epi, class Sched, bool ALIGN_EPI = true, bool SP2 = true>
__device__ __forceinline__ void gemm_phase(LAS unsigned char* lds, const Sched& S, const Epi& E) {
    int tid = threadIdx.x; asm volatile("" : "+v"(tid));
    const int wid = __builtin_amdgcn_readfirstlane(tid >> 6), lane = tid & 63, wr = wid >> 2, wc = wid & 3, fr = lane & 15, fq = lane >> 4;
    constexpr int NST_ = epi_nst<Epi>::value; static_assert(SP2 && (NST_ == 0 || NST_ == 8 || NST_ == 16), "SP2 body; NST 0, 8 or 16");
    int RA[2], CA2[2]; unsigned voffB[2], voA0[2], voA1[2], nvA0[2], nvA1[2];
    const unsigned lda = S.lda, ldb = S.ldb;
#pragma unroll
    for (int i = 0; i < 2; ++i) { int R, C; stage_rc(tid * 16 + i * 8192, R, C); const int Rb = Epi::PERM ? ((R & ~31) + perm32(R & 31)) : R;
        RA[i] = R; CA2[i] = C * 2; voffB[i] = (unsigned)Rb * ldb + (unsigned)C * 2u; voA0[i] = (unsigned)R * lda + (unsigned)C * 2u; voA1[i] = (unsigned)(R + HALF) * lda + (unsigned)C * 2u; nvA0[i] = voA0[i]; nvA1[i] = voA1[i]; }
    const size_t kstep = (size_t)(BK * 2);
    const size_t hstepB = (size_t)HALF * ldb;
    const unsigned ldsw = (unsigned)wid * 1024u;
    const int aoff = lds_byte(wr * 64 + fr, fq * 8), boff = lds_byte(wc * 32 + fr, fq * 8);
#define PG8_SA(b, h) (((b) * 2 + (h)) * HTB)
#define PG8_SB(b, h) ((4 + (b) * 2 + (h)) * HTB)
#define PG8_STAGE(bufoff, gbase, voff) do { _Pragma("unroll") for (int _i = 0; _i < 2; ++_i) \
        __builtin_amdgcn_global_load_lds((const unsigned*)((const char*)(gbase) + (voff)[_i]), (LAS unsigned*)(lds + (bufoff) + ldsw + _i * 8192), 16, 0, 0); } while (0)
#define PG8_LDA(dst, b, h) do { _Pragma("unroll") for (int m = 0; m < 4; ++m) _Pragma("unroll") for (int k = 0; k < 2; ++k) dst[m][k] = *(const LAS bf16x8*)(lds + PG8_SA(b, h) + aoff + m * 2048 + k * 1024); } while (0)
#define PG8_LDB(dst, b, h) do { _Pragma("unroll") for (int n = 0; n < 2; ++n) _Pragma("unroll") for (int k = 0; k < 2; ++k) dst[n][k] = *(const LAS bf16x8*)(lds + PG8_SB(b, h) + boff + n * 2048 + k * 1024); } while (0)
#define PG8_MMA(ai, bj, At, Bt) do { __builtin_amdgcn_s_setprio(1); _Pragma("unroll") for (int m = 0; m < 4; ++m) _Pragma("unroll") for (int n = 0; n < 2; ++n) _Pragma("unroll") for (int k = 0; k < 2; ++k) \
        acc[ai][bj][m][n] = __builtin_amdgcn_mfma_f32_16x16x32_bf16(Bt[n][k], At[m][k], acc[ai][bj][m][n], 0, 0, 0); __builtin_amdgcn_s_setprio(0); } while (0)
#define PG8_WAIT_V(n) asm volatile("s_waitcnt vmcnt(" #n ")" ::: "memory")
#define PG8_WAIT_VX_(NSTR) asm volatile("s_cmp_lg_u32 %0, 0\n\ts_cbranch_scc1 1f\n\ts_cmp_eq_u32 %1, 0\n\ts_cbranch_scc1 1f\n\ts_waitcnt vmcnt(" NSTR ")\n\ts_branch 2f\n1:\n\ts_waitcnt vmcnt(8)\n2:" :: "s"(t), "s"(ui) : "memory", "scc")
#define PG8_WAIT_VX do { if constexpr (NST_ == 8) PG8_WAIT_VX_("16"); else if constexpr (NST_ == 16) PG8_WAIT_VX_("24"); else PG8_WAIT_V(8); } while (0)
#define PG8_WAIT_L(n) asm volatile("s_waitcnt lgkmcnt(" #n ")" ::: "memory")
#define PG8_BAR __builtin_amdgcn_s_barrier()
#define PG8_SCHED __builtin_amdgcn_sched_barrier(0)
    Unit cur, nxt; int ui = 0;
    if (!S.next(0, cur)) return;
    cur.seq = 0;
    if constexpr (Sched::GATHER) {
#pragma unroll
        for (int i = 0; i < 2; ++i) { voA0[i] = S.a_rowoff(cur, RA[i]) + (unsigned)CA2[i]; voA1[i] = S.a_rowoff(cur, RA[i] + HALF) + (unsigned)CA2[i]; }
    }
    f32x4 acc[2][2][4][2];
#pragma unroll
    for (int a = 0; a < 2; ++a)
#pragma unroll
        for (int b = 0; b < 2; ++b)
#pragma unroll
            for (int m = 0; m < 4; ++m)
#pragma unroll
                for (int n = 0; n < 2; ++n) acc[a][b][m][n] = (f32x4){0.f, 0.f, 0.f, 0.f};
    bf16x8 At[4][2], B0[2][2], B1[2][2];
    const char* cA = S.a_base(cur); const char* cB = S.b_base(cur);
    if constexpr (SP2) {
        PG8_STAGE(PG8_SB(0, 0), cB, voffB); PG8_STAGE(PG8_SB(0, 1), cB + hstepB, voffB); PG8_STAGE(PG8_SA(0, 0), cA, voA0); PG8_STAGE(PG8_SA(0, 1), cA, voA1);
        if (wr == 1) PG8_BAR;
        PG8_WAIT_V(2); PG8_BAR;
        PG8_STAGE(PG8_SB(1, 0), cB + kstep, voffB); PG8_STAGE(PG8_SA(1, 0), cA + kstep, voA0); PG8_STAGE(PG8_SB(1, 1), cB + hstepB + kstep, voffB);
        PG8_WAIT_V(6); PG8_BAR;
    } else {
        PG8_STAGE(PG8_SB(0, 0), cB, voffB); PG8_STAGE(PG8_SA(0, 0), cA, voA0); PG8_STAGE(PG8_SB(0, 1), cB + hstepB, voffB); PG8_STAGE(PG8_SA(0, 1), cA, voA1);
        if (wr == 1) PG8_BAR;
        PG8_WAIT_V(4); PG8_BAR;
        PG8_STAGE(PG8_SB(1, 0), cB + kstep, voffB); PG8_STAGE(PG8_SA(1, 0), cA + kstep, voA0); PG8_STAGE(PG8_SB(1, 1), cB + hstepB + kstep, voffB);
        PG8_WAIT_V(6); PG8_BAR;
    }
    for (;;) {
        const bool has_next = S.next(ui + 1, nxt);
        const char* nA = has_next ? S.a_base(nxt) : cA; const char* nB = has_next ? S.b_base(nxt) : cB;
        if constexpr (Sched::GATHER) {
            if (has_next) {
#pragma unroll
                for (int i = 0; i < 2; ++i) { nvA0[i] = S.a_rowoff(nxt, RA[i]) + (unsigned)CA2[i]; nvA1[i] = S.a_rowoff(nxt, RA[i] + HALF) + (unsigned)CA2[i]; }
            } else {
#pragma unroll
                for (int i = 0; i < 2; ++i) { nvA0[i] = voA0[i]; nvA1[i] = voA1[i]; }
            }
        }
        if constexpr (has_begin<Epi>::value) E.unit_begin(cur, lds, tid);
        const int nt = S.nt(cur);
        for (int t = 0; t < nt; t += 2) {
            const bool last = (t == nt - 2);
            if constexpr (has_mid<Epi>::value) { if (t == Epi::MID_T) E.mid(acc, cur, wr, fr, lds); }
            const char* a1 = cA + (size_t)(t + 1) * kstep;
            const char* a2 = last ? nA : cA + (size_t)(t + 2) * kstep; const char* b2 = last ? nB : cB + (size_t)(t + 2) * kstep;
            const char* a3 = a2 + kstep; const char* b3 = b2 + kstep;
            unsigned w0[2], w1[2];
            if constexpr (Sched::GATHER) {
#pragma unroll
                for (int i = 0; i < 2; ++i) { w0[i] = last ? nvA0[i] : voA0[i]; w1[i] = last ? nvA1[i] : voA1[i]; }
            } else {
#pragma unroll
                for (int i = 0; i < 2; ++i) { w0[i] = voA0[i]; w1[i] = voA1[i]; }
            }
            if constexpr (SP2) {
            PG8_LDB(B0, 0, 0); PG8_LDB(B1, 0, 1); PG8_SCHED; PG8_LDA(At, 0, 0); PG8_STAGE(PG8_SA(1, 1), a1, voA1);
            PG8_WAIT_VX; PG8_WAIT_L(0); PG8_BAR; PG8_MMA(0, 0, At, B0); PG8_MMA(0, 1, At, B1); PG8_BAR; PG8_SCHED;
            PG8_LDA(At, 0, 1); PG8_STAGE(PG8_SB(0, 0), b2, voffB); PG8_STAGE(PG8_SB(0, 1), b2 + hstepB, voffB); PG8_STAGE(PG8_SA(0, 0), a2, w0);
            PG8_WAIT_VX; PG8_WAIT_L(0); PG8_BAR; PG8_MMA(1, 0, At, B0); PG8_MMA(1, 1, At, B1); PG8_BAR; PG8_SCHED;
            PG8_LDB(B0, 1, 0); PG8_LDB(B1, 1, 1); PG8_SCHED; PG8_LDA(At, 1, 0); PG8_STAGE(PG8_SA(0, 1), a2, w1);
            PG8_WAIT_VX; PG8_WAIT_L(0); PG8_BAR; PG8_MMA(0, 0, At, B0); PG8_MMA(0, 1, At, B1); PG8_BAR; PG8_SCHED;
            PG8_LDA(At, 1, 1); PG8_STAGE(PG8_SB(1, 0), b3, voffB); PG8_STAGE(PG8_SB(1, 1), b3 + hstepB, voffB); PG8_STAGE(PG8_SA(1, 0), a3, w0);
            PG8_WAIT_VX; PG8_WAIT_L(0); PG8_BAR; PG8_MMA(1, 0, At, B0); PG8_MMA(1, 1, At, B1); PG8_BAR; PG8_SCHED;
            } else {
            PG8_LDB(B0, 0, 0); PG8_SCHED; PG8_LDA(At, 0, 0); PG8_STAGE(PG8_SA(1, 1), a1, voA1);
            PG8_WAIT_L(8); PG8_BAR; PG8_WAIT_L(0); PG8_MMA(0, 0, At, B0); PG8_BAR; PG8_SCHED;
            PG8_LDB(B1, 0, 1); PG8_STAGE(PG8_SB(0, 0), b2, voffB);
            PG8_BAR; PG8_WAIT_L(0); PG8_MMA(0, 1, At, B1); PG8_BAR;
            PG8_LDA(At, 0, 1); PG8_STAGE(PG8_SA(0, 0), a2, w0);
            PG8_BAR; PG8_WAIT_L(0); PG8_MMA(1, 0, At, B0); PG8_BAR; PG8_SCHED;
            PG8_STAGE(PG8_SB(0, 1), b2 + hstepB, voffB);
            PG8_WAIT_V(6); PG8_BAR; PG8_MMA(1, 1, At, B1); PG8_BAR;
            PG8_LDB(B0, 1, 0); PG8_SCHED; PG8_LDA(At, 1, 0); PG8_STAGE(PG8_SA(0, 1), a2, w1);
            PG8_WAIT_L(8); PG8_BAR; PG8_WAIT_L(0); PG8_MMA(0, 0, At, B0); PG8_BAR; PG8_SCHED;
            PG8_LDB(B1, 1, 1); PG8_STAGE(PG8_SB(1, 0), b3, voffB);
            PG8_BAR; PG8_WAIT_L(0); PG8_MMA(0, 1, At, B1); PG8_BAR;
            PG8_LDA(At, 1, 1); PG8_STAGE(PG8_SA(1, 0), a3, w0);
            PG8_BAR; PG8_WAIT_L(0); PG8_MMA(1, 0, At, B0); PG8_BAR; PG8_SCHED;
            PG8_STAGE(PG8_SB(1, 1), b3 + hstepB, voffB);
            PG8_WAIT_V(6); PG8_BAR; PG8_MMA(1, 1, At, B1); PG8_BAR;
            }
        }
        if constexpr (NST_ > 0) { PG8_STAGE(PG8_SA(1, 1), nA + kstep, nvA1); asm volatile("" ::: "memory"); }
        if constexpr (ALIGN_EPI) { if (wr == 0) PG8_BAR; }
        if constexpr (!Epi::AFTER_DRAIN) { int fr_ = fr, fq_ = fq; asm volatile("" : "+v"(fr_), "+v"(fq_));
            epi_apply(E, acc, cur, wr, wc, fr_, fq_); }
        if (!has_next) break;
#pragma unroll
        for (int a = 0; a < 2; ++a)
#pragma unroll
            for (int b = 0; b < 2; ++b)
#pragma unroll
                for (int m = 0; m < 4; ++m)
#pragma unroll
                    for (int n = 0; n < 2; ++n) acc[a][b][m][n] = (f32x4){0.f, 0.f, 0.f, 0.f};
        cur = nxt; cA = nA; cB = nB; ++ui; cur.seq = ui;
        if constexpr (Sched::GATHER) {
#pragma unroll
            for (int i = 0; i < 2; ++i) { voA0[i] = nvA0[i]; voA1[i] = nvA1[i]; }
        }
        if constexpr (ALIGN_EPI) { if (wr == 1) PG8_BAR; }
    }
    PG8_WAIT_V(0);
    if constexpr (!ALIGN_EPI) { if (wr == 0) PG8_BAR; }
    PG8_BAR;
    if constexpr (Epi::AFTER_DRAIN) { int fr_ = fr, fq_ = fq, lane_ = lane; asm volatile("" : "+v"(fr_), "+v"(fq_), "+v"(lane_)); E.fused(acc, cur, wr, wc, fr_, fq_, lds, wid, lane_); }
#undef PG8_SA
#undef PG8_SB
#undef PG8_STAGE
#undef PG8_LDA
#undef PG8_LDB
#undef PG8_MMA
#undef PG8_WAIT_V
#undef PG8_WAIT_VX
#undef PG8_WAIT_VX_
#undef PG8_WAIT_L
#undef PG8_BAR
#undef PG8_SCHED
}
}
using pg8::Unit;

struct DenseSched {
    static constexpr bool GATHER = false;
    const char* A; const char* Bt; unsigned lda, ldb; int nM, nN, ntk, G, c;
    __device__ __forceinline__ bool next(int i, Unit& u) const { return pg8::static_unit(i, G, c, nM, nN, u); }
    __device__ __forceinline__ int nt(const Unit&) const { return ntk; }
    __device__ __forceinline__ const char* a_base(const Unit& u) const { return A + (size_t)u.pm * 256 * lda; }
    __device__ __forceinline__ const char* b_base(const Unit& u) const { return Bt + (size_t)u.pn * 256 * ldb; }
    __device__ __forceinline__ unsigned a_rowoff(const Unit&, int) const { return 0; }
};
struct SsmSSched {
    static constexpr bool GATHER = false;
    const char* U; const char* W; unsigned lda, ldb; int G, c;
    __device__ __forceinline__ bool next(int i, Unit& u) const { const int L = i * G + c; if (L >= NG * SSM_RT) return false; u.aux = L / SSM_RT; u.pm = L % SSM_RT; u.pn = 0; u.kp = -1; return true; }
    __device__ __forceinline__ int nt(const Unit&) const { return NYC / 64; }
    __device__ __forceinline__ const char* a_base(const Unit& u) const { return U + ((size_t)(u.aux * NROWG + u.pm * 256) * UAW + 128) * 2; }
    __device__ __forceinline__ const char* b_base(const Unit& u) const { return W + (size_t)u.aux * 256 * NYC * 2; }
    __device__ __forceinline__ unsigned a_rowoff(const Unit&, int) const { return 0; }
};
struct SsmYSched {
    static constexpr bool GATHER = false;
    const char* U; const char* W; unsigned lda, ldb; int G, c;
    __device__ __forceinline__ bool next(int i, Unit& u) const { const int L = i * G + c; if (L >= NG * SSM_RT * SSM_CT) return false; const int rem = L % (NG * SSM_RT);
        u.pn = SSM_CT - 1 - L / (NG * SSM_RT); u.aux = rem / SSM_RT; u.pm = rem % SSM_RT; u.kp = -1; return true; }
    __device__ __forceinline__ int nt(const Unit& u) const { return 2 + 4 * (u.pn + 1); }
    __device__ __forceinline__ const char* a_base(const Unit& u) const { return U + (size_t)(u.aux * NROWG + u.pm * 256) * UAW * 2; }
    __device__ __forceinline__ const char* b_base(const Unit& u) const { return W + (size_t)(u.aux * NYC + u.pn * 256) * UAW * 2; }
    __device__ __forceinline__ unsigned a_rowoff(const Unit&, int) const { return 0; }
};
struct MoeSched {
    static constexpr bool GATHER = true;
    const char* A; const char* Bt; unsigned lda, ldb; size_t bstride; int nN, ntk, G, c;
    const int* tile_e; const int* slot_tok; const int* ntp;
    __device__ __forceinline__ bool next(int i, Unit& u) const { const int ntiles = *ntp; if (!pg8::static_unit(i, G, c, ntiles, nN, u)) return false; u.aux = tile_e[u.pm]; return true; }
    __device__ __forceinline__ int nt(const Unit&) const { return ntk; }
    __device__ __forceinline__ const char* a_base(const Unit&) const { return A; }
    __device__ __forceinline__ const char* b_base(const Unit& u) const { return Bt + (size_t)u.aux * bstride + (size_t)u.pn * 256 * ldb; }
    __device__ __forceinline__ unsigned a_rowoff(const Unit& u, int r) const { const int s = u.pm * 256 + r; if (slot_tok) { int t = slot_tok[s]; t = t < 0 ? 0 : t; return (unsigned)t * lda; } return (unsigned)s * lda; }
};

constexpr int KSPLIT = 7, MOE_LEFT_ROWS = 2048;
struct MoeDownSched {
    static constexpr bool GATHER = false;
    const char* A; const char* Bt; unsigned lda, ldb; size_t bstride; int G, c; const int* tile_e; const int* ntp;
    __device__ __forceinline__ bool next(int i, Unit& u) const { const int T = *ntp, Tm = T & ~63, nmain = Tm * 4, nmini = (T - Tm) * 4 * KSPLIT;
        const int nr = nmain > c ? (nmain - c + G - 1) / G : 0;
        if (i < nr) { pg8::static_unit(i, G, c, Tm, 4, u); u.aux = tile_e[u.pm]; return true; }
        const int j = (i - nr) * G + c; if (j >= nmini) return false;
        u.pm = Tm + j / (4 * KSPLIT); u.pn = (j / KSPLIT) & 3; u.kp = j % KSPLIT; u.aux = tile_e[u.pm]; return true; }
    __device__ __forceinline__ int nt(const Unit& u) const { return u.kp < 0 ? FFE / 64 : FFE / 64 / KSPLIT; }
    __device__ __forceinline__ const char* a_base(const Unit& u) const { return A + (size_t)u.pm * 256 * lda + (u.kp < 0 ? (size_t)0 : (size_t)u.kp * (FFE / KSPLIT) * 2); }
    __device__ __forceinline__ const char* b_base(const Unit& u) const { return Bt + (size_t)u.aux * bstride + (size_t)u.pn * 256 * ldb + (u.kp < 0 ? (size_t)0 : (size_t)u.kp * (FFE / KSPLIT) * 2); }
    __device__ __forceinline__ unsigned a_rowoff(const Unit&, int) const { return 0; }
};
static_assert((FFE / 64) % (2 * KSPLIT) == 0 && FFE / 64 / KSPLIT >= 4, "K-split parts: an even number of K-tiles, >= 4");

__device__ __forceinline__ v4u pack8(const f32x4& a, const f32x4& b) { v4u w; w.x = pk2(a[0], a[1]); w.y = pk2(a[2], a[3]); w.z = pk2(b[0], b[1]); w.w = pk2(b[2], b[3]); return w; }
struct EpiInProj {
    static constexpr bool PERM = true, AFTER_DRAIN = false; bf16* UA; bf16* PL;
    __device__ __forceinline__ void put8(const Unit& u, int r, int c, const f32x4& v0, const f32x4& v1) const {
        const int m = u.pm * 256 + r, col = u.pn * 256 + c; bf16* dst;
        if (col < 512) { const int g = col >> 4, hc = col & 15, b = m >> 12, l = m & 4095; dst = UA + ((size_t)(g * NROWG + b * NCH + l / TCH) * UAW + 128 + (l % TCH) * 16 + hc); }
        else dst = PL + (size_t)m * 512 + (col - 512);
        *(GAS v4u*)dst = pack8(v0, v1); }
};
struct EpiBf16 {
    static constexpr bool PERM = true, AFTER_DRAIN = false; bf16* O; int ldc;
    __device__ __forceinline__ void put8(const Unit& u, int r, int c, const f32x4& v0, const f32x4& v1) const { *(GAS v4u*)(O + (size_t)(u.pm * 256 + r) * ldc + u.pn * 256 + c) = pack8(v0, v1); }
};
constexpr int RS_OFF = pg8::STAGE_BYTES + 1024;
__device__ __forceinline__ void rs_begin(const float* SSp, const Unit& u, LAS unsigned char* lds, int tid) {
    if (tid < 256) { const GAS f32x4* p = (const GAS f32x4*)(SSp + (size_t)(u.pm * 256 + tid) * 16); const f32x4 a = p[0], b = p[1], c = p[2], d = p[3];
        const float ss = ((a[0] + a[1]) + (a[2] + a[3])) + ((b[0] + b[1]) + (b[2] + b[3])) + ((c[0] + c[1]) + (c[2] + c[3])) + ((d[0] + d[1]) + (d[2] + d[3]));
        ((LAS float*)(lds + RS_OFF + (u.seq & 1) * 2048))[tid] = 1.f / sqrtf(ss * (1.f / DM) + EPS); }
}
struct EpiInProjRs {
    static constexpr bool PERM = true, AFTER_DRAIN = false, BEGIN = true; bf16* UA; bf16* PL; const float* SSp; LAS unsigned char* L;
    __device__ __forceinline__ void unit_begin(const Unit& u, LAS unsigned char* lds, int tid) const { rs_begin(SSp, u, lds, tid); }
    __device__ __forceinline__ void put8(const Unit& u, int r, int c, const f32x4& v0, const f32x4& v1) const {
        const float q = ((const LAS float*)(L + RS_OFF + (u.seq & 1) * 2048))[r];
        const int m = u.pm * 256 + r, col = u.pn * 256 + c; bf16* dst;
        if (col < 512) { const int g = col >> 4, hc = col & 15, b = m >> 12, l = m & 4095; dst = UA + ((size_t)(g * NROWG + b * NCH + l / TCH) * UAW + 128 + (l % TCH) * 16 + hc); }
        else dst = PL + (size_t)m * 512 + (col - 512);
        *(GAS v4u*)dst = pack8(v0 * q, v1 * q); }
};
struct EpiSwigluRs {
    static constexpr bool PERM = true, AFTER_DRAIN = false, PAIR = true, BEGIN = true; bf16* ACT; int ldact; const float* SSp; LAS unsigned char* L;
    __device__ __forceinline__ void unit_begin(const Unit& u, LAS unsigned char* lds, int tid) const { rs_begin(SSp, u, lds, tid); }
    __device__ __forceinline__ void putpair(const Unit& u, int r, int c, const f32x4& g0_, const f32x4& g1_, const f32x4& u0_, const f32x4& u1_) const {
        const float q = ((const LAS float*)(L + RS_OFF + (u.seq & 1) * 2048))[r];
        const f32x4 g0 = g0_ * q, g1 = g1_ * q, u0 = u0_ * q, u1 = u1_ * q; f32x4 a, b;
#pragma unroll
        for (int j = 0; j < 4; ++j) { a[j] = g0[j] * sigmoidf_(g0[j]) * u0[j]; b[j] = g1[j] * sigmoidf_(g1[j]) * u1[j]; }
        *(GAS v4u*)(ACT + (size_t)(u.pm * 256 + r) * ldact + u.pn * 128 + c) = pack8(a, b); }
};
struct EpiGlu {
    static constexpr bool PERM = true, AFTER_DRAIN = false, CUSTOM = true; const bf16* YG; const float* bias; bf16* MIX; float* SS;
    __device__ __forceinline__ void apply(const f32x4 (&acc)[2][2][4][2], const Unit& u, int wr, int wc, int fr, int fq) const {
#pragma unroll
        for (int ai = 0; ai < 2; ++ai)
#pragma unroll
            for (int mi = 0; mi < 4; ++mi) { const int m = u.pm * 256 + ai * 128 + wr * 64 + mi * 16 + fr; float ssq = 0.f;
#pragma unroll
                for (int bj = 0; bj < 2; ++bj) { const int col = u.pn * 256 + bj * 128 + wc * 32 + 8 * fq; const f32x4& v0 = acc[ai][bj][mi][0]; const f32x4& v1 = acc[ai][bj][mi][1];
                    const v4u yw = *(const GAS v4u*)(YG + (size_t)m * 512 + col); const f32x4 b0 = *(const GAS f32x4*)(bias + col), b1 = *(const GAS f32x4*)(bias + col + 4);
                    f32x4 o0, o1; o0[0] = bflo(yw.x) * sigmoidf_(v0[0] + b0[0]); o0[1] = bfhi(yw.x) * sigmoidf_(v0[1] + b0[1]); o0[2] = bflo(yw.y) * sigmoidf_(v0[2] + b0[2]); o0[3] = bfhi(yw.y) * sigmoidf_(v0[3] + b0[3]);
                    o1[0] = bflo(yw.z) * sigmoidf_(v1[0] + b1[0]); o1[1] = bfhi(yw.z) * sigmoidf_(v1[1] + b1[1]); o1[2] = bflo(yw.w) * sigmoidf_(v1[2] + b1[2]); o1[3] = bfhi(yw.w) * sigmoidf_(v1[3] + b1[3]);
                    ssq += (o0[0] * o0[0] + o0[1] * o0[1]) + (o0[2] * o0[2] + o0[3] * o0[3]) + (o1[0] * o1[0] + o1[1] * o1[1]) + (o1[2] * o1[2] + o1[3] * o1[3]);
                    *(GAS v4u*)(MIX + (size_t)m * 1024 + col) = pack8(o0, o1); }
                ssq += __shfl_xor(ssq, 16); ssq += __shfl_xor(ssq, 32);
                if (fq == 0) ((GAS float*)SS)[(size_t)m * 16 + u.pn * 4 + wc] = ssq;
                asm volatile("" ::: "memory"); }
    }
};
struct EpiSsmY {
    static constexpr bool PERM = true, AFTER_DRAIN = false; bf16* YG;
    __device__ __forceinline__ void put8(const Unit& u, int r, int c, const f32x4& v0, const f32x4& v1) const {
        const int rr = u.pm * 256 + r, n = u.pn * 256 + c, tok = (rr / NCH) * SEQ + (rr % NCH) * TCH + (n >> 4);
        f32x4 a, b;
#pragma unroll
        for (int j = 0; j < 4; ++j) { a[j] = gelu_tanh(v0[j]); b[j] = gelu_tanh(v1[j]); }
        *(GAS v4u*)(YG + (size_t)tok * 512 + u.aux * 16 + (n & 15)) = pack8(a, b); }
};
struct EpiResid {
    static constexpr bool PERM = true, AFTER_DRAIN = false, CUSTOM = true; bf16* HB; float ascale; float* SSo;
    __device__ __forceinline__ void apply(const f32x4 (&acc)[2][2][4][2], const Unit& u, int wr, int wc, int fr, int fq) const {
        bf16* base = HB + (size_t)(u.pm * 256 + wr * 64 + fr) * DM + u.pn * 256 + wc * 32 + 8 * fq;
#pragma unroll
        for (int ai = 0; ai < 2; ++ai) { v4u rv[4][2];
#pragma unroll
            for (int m = 0; m < 4; ++m)
#pragma unroll
                for (int bj = 0; bj < 2; ++bj) rv[m][bj] = *(const GAS v4u*)(base + (size_t)(ai * 128 + m * 16) * DM + bj * 128);
#pragma unroll
            for (int m = 0; m < 4; ++m) { float ssq = 0.f;
#pragma unroll
                for (int bj = 0; bj < 2; ++bj) { const v4u x = rv[m][bj]; const f32x4 a0 = acc[ai][bj][m][0] * ascale, a1 = acc[ai][bj][m][1] * ascale; v4u w;
                    const f32x4 h0 = (f32x4){bflo(x.x), bfhi(x.x), bflo(x.y), bfhi(x.y)} + a0, h1 = (f32x4){bflo(x.z), bfhi(x.z), bflo(x.w), bfhi(x.w)} + a1;
                    ssq += ((h0[0] * h0[0] + h0[1] * h0[1]) + (h0[2] * h0[2] + h0[3] * h0[3])) + ((h1[0] * h1[0] + h1[1] * h1[1]) + (h1[2] * h1[2] + h1[3] * h1[3]));
                    w.x = pk2(h0[0], h0[1]); w.y = pk2(h0[2], h0[3]); w.z = pk2(h1[0], h1[1]); w.w = pk2(h1[2], h1[3]);
                    *(GAS v4u*)(base + (size_t)(ai * 128 + m * 16) * DM + bj * 128) = w; }
                ssq += __shfl_xor(ssq, 16); ssq += __shfl_xor(ssq, 32);
                if (fq == 0) ((GAS float*)SSo)[(size_t)(u.pm * 256 + ai * 128 + wr * 64 + m * 16 + fr) * 16 + u.pn * 4 + wc] = ssq; }
            asm volatile("" ::: "memory"); }
    }
};
struct EpiOutProj {
    static constexpr bool PERM = true, AFTER_DRAIN = false, CUSTOM = true, BEGIN = true; static constexpr int MID_T = 8; bf16* HB; const float* SS; float ascale; LAS unsigned char* L; float* SSo;
    __device__ __forceinline__ void unit_begin(const Unit& u, LAS unsigned char* lds, int tid) const {
        if (tid < 256) { const GAS f32x4* p = (const GAS f32x4*)(SS + (size_t)(u.pm * 256 + tid) * 16); const f32x4 a = p[0], b = p[1], c = p[2], d = p[3];
            const float ss = (a[0] + a[1]) + (a[2] + a[3]) + (b[0] + b[1]) + (b[2] + b[3]), sm = (c[0] + c[1]) + (c[2] + c[3]) + (d[0] + d[1]) + (d[2] + d[3]);
            const float rs = 1.f / sqrtf(ss * (1.f / 512) + EPS), rm = 1.f / sqrtf(sm * (1.f / 512) + EPS);
            ((LAS f32x2*)(lds + RS_OFF + (u.seq & 1) * 2048))[tid] = (f32x2){rs / rm, rm}; }
    }
    __device__ __forceinline__ void mid(f32x4 (&acc)[2][2][4][2], const Unit& u, int wr, int fr, LAS unsigned char* lds) const {
        const LAS f32x2* rsp = (const LAS f32x2*)(lds + RS_OFF + (u.seq & 1) * 2048);
#pragma unroll
        for (int ai = 0; ai < 2; ++ai)
#pragma unroll
            for (int m = 0; m < 4; ++m) { const float q = rsp[ai * 128 + wr * 64 + m * 16 + fr][0];
#pragma unroll
                for (int bj = 0; bj < 2; ++bj)
#pragma unroll
                    for (int n = 0; n < 2; ++n) acc[ai][bj][m][n] *= q; }
    }
    __device__ __forceinline__ void apply(const f32x4 (&acc)[2][2][4][2], const Unit& u, int wr, int wc, int fr, int fq) const {
        const LAS f32x2* rsp = (const LAS f32x2*)(L + RS_OFF + (u.seq & 1) * 2048);
        bf16* base = HB + (size_t)(u.pm * 256 + wr * 64 + fr) * DM + u.pn * 256 + wc * 32 + 8 * fq;
#pragma unroll
        for (int ai = 0; ai < 2; ++ai) { v4u rv[4][2];
#pragma unroll
            for (int m = 0; m < 4; ++m)
#pragma unroll
                for (int bj = 0; bj < 2; ++bj) rv[m][bj] = *(const GAS v4u*)(base + (size_t)(ai * 128 + m * 16) * DM + bj * 128);
#pragma unroll
            for (int m = 0; m < 4; ++m) { const float q = rsp[ai * 128 + wr * 64 + m * 16 + fr][1] * ascale; float ssq = 0.f;
#pragma unroll
                for (int bj = 0; bj < 2; ++bj) { const v4u x = rv[m][bj]; const f32x4 a0 = acc[ai][bj][m][0] * q, a1 = acc[ai][bj][m][1] * q; v4u w;
                    const f32x4 h0 = (f32x4){bflo(x.x), bfhi(x.x), bflo(x.y), bfhi(x.y)} + a0, h1 = (f32x4){bflo(x.z), bfhi(x.z), bflo(x.w), bfhi(x.w)} + a1;
                    ssq += ((h0[0] * h0[0] + h0[1] * h0[1]) + (h0[2] * h0[2] + h0[3] * h0[3])) + ((h1[0] * h1[0] + h1[1] * h1[1]) + (h1[2] * h1[2] + h1[3] * h1[3]));
                    w.x = pk2(h0[0], h0[1]); w.y = pk2(h0[2], h0[3]); w.z = pk2(h1[0], h1[1]); w.w = pk2(h1[2], h1[3]);
                    *(GAS v4u*)(base + (size_t)(ai * 128 + m * 16) * DM + bj * 128) = w; }
                ssq += __shfl_xor(ssq, 16); ssq += __shfl_xor(ssq, 32);
                if (fq == 0) ((GAS float*)SSo)[(size_t)(u.pm * 256 + ai * 128 + wr * 64 + m * 16 + fr) * 16 + u.pn * 4 + wc] = ssq; }
            asm volatile("" ::: "memory"); }
    }
};
struct EpiSwiglu {
    static constexpr bool PERM = true, AFTER_DRAIN = false, PAIR = true; static constexpr int NST = 8; bf16* ACT; int ldact;
    __device__ __forceinline__ void putpair(const Unit& u, int r, int c, const f32x4& g0, const f32x4& g1, const f32x4& u0, const f32x4& u1) const {
        f32x4 a, b;
#pragma unroll
        for (int j = 0; j < 4; ++j) { a[j] = g0[j] * sigmoidf_(g0[j]) * u0[j]; b[j] = g1[j] * sigmoidf_(g1[j]) * u1[j]; }
        *(GAS v4u*)(ACT + (size_t)(u.pm * 256 + r) * ldact + u.pn * 128 + c) = pack8(a, b); }
};
template <bool FINAL> struct EpiMoeDown {
    static constexpr bool PERM = true, AFTER_DRAIN = false, CUSTOM = true; const int* slot_tok; const float* slot_w; bf16* HB; float* out; float ascale; const int* ntp; bf16* PART;
    __device__ __forceinline__ void apply(const f32x4 (&acc)[2][2][4][2], const Unit& u, int wr, int wc, int fr, int fq) const {
        int tok[2][4]; float w[2][4]; const int s0 = u.pm * 256 + wr * 64 + fr;
        const int Tm = (*ntp) & ~63;
#pragma unroll
        for (int ai = 0; ai < 2; ++ai)
#pragma unroll
            for (int m = 0; m < 4; ++m) { tok[ai][m] = ((const GAS int*)slot_tok)[s0 + ai * 128 + m * 16]; w[ai][m] = ((const GAS float*)slot_w)[s0 + ai * 128 + m * 16] * ascale; }
        const int cb = u.pn * 256 + wc * 32 + 8 * fq;
        if (u.kp >= 0) {
            bf16* pb = PART + ((size_t)u.kp * MOE_LEFT_ROWS + (size_t)(u.pm - Tm) * 256 + wr * 64 + fr) * DM + cb;
#pragma unroll
            for (int ai = 0; ai < 2; ++ai)
#pragma unroll
                for (int m = 0; m < 4; ++m)
#pragma unroll
                    for (int bj = 0; bj < 2; ++bj) *(GAS v4u*)(pb + (size_t)(ai * 128 + m * 16) * DM + bj * 128) = pack8(acc[ai][bj][m][0] * w[ai][m], acc[ai][bj][m][1] * w[ai][m]);
            return; }
#pragma unroll
        for (int ai = 0; ai < 2; ++ai) { v4u rv[4][2];
#pragma unroll
            for (int m = 0; m < 4; ++m) { const int t = tok[ai][m] < 0 ? 0 : tok[ai][m];
#pragma unroll
                for (int bj = 0; bj < 2; ++bj) rv[m][bj] = *(const GAS v4u*)(HB + (size_t)t * DM + cb + bj * 128); }
#pragma unroll
            for (int m = 0; m < 4; ++m) { if (tok[ai][m] < 0) continue;
#pragma unroll
                for (int bj = 0; bj < 2; ++bj) { const v4u x = rv[m][bj]; const f32x4 a0 = acc[ai][bj][m][0] * w[ai][m], a1 = acc[ai][bj][m][1] * w[ai][m];
                    const f32x4 r0 = {bflo(x.x) + a0[0], bfhi(x.x) + a0[1], bflo(x.y) + a0[2], bfhi(x.y) + a0[3]}, r1 = {bflo(x.z) + a1[0], bfhi(x.z) + a1[1], bflo(x.w) + a1[2], bfhi(x.w) + a1[3]};
                    if constexpr (FINAL) { GAS f32x4* o = (GAS f32x4*)(out + (size_t)tok[ai][m] * DM + cb + bj * 128); o[0] = r0; o[1] = r1; }
                    else *(GAS v4u*)(HB + (size_t)tok[ai][m] * DM + cb + bj * 128) = pack8(r0, r1); } }
            asm volatile("" ::: "memory"); }
    }
};
struct EpiSsmS {
    static constexpr bool PERM = false, AFTER_DRAIN = true; bf16* UA; const float* aT;
    __device__ __forceinline__ void fused(const f32x4 (&acc)[2][2][4][2], const Unit& u, int wr, int wc, int fr, int fq, LAS unsigned char* lds, int wid, int lane) const {
        LAS float* T = (LAS float*)lds;
#pragma unroll
        for (int ai = 0; ai < 2; ++ai)
#pragma unroll
            for (int m = 0; m < 4; ++m) { const int r = ai * 128 + wr * 64 + m * 16 + fr;
#pragma unroll
                for (int n = 0; n < 2; ++n) *(LAS f32x4*)(T + r * 128 + wc * 32 + 16 * n + 4 * fq) = acc[ai][0][m][n]; }
        LDS_WAIT(); __builtin_amdgcn_s_barrier(); asm volatile("" ::: "memory");
        const int tid = wid * 64 + lane;
        if (tid < 64 * (256 / NCH)) { const int bl = tid >> 6, p = tid & 63, g = u.aux; const float ar = aT[(g * 64 + p) * 2], ai_ = aT[(g * 64 + p) * 2 + 1]; float sr = 0.f, si = 0.f;
            bf16* dst = UA + (size_t)(g * NROWG + u.pm * 256 + bl * NCH) * UAW;
            for (int c = 0; c < NCH; ++c) { dst[(size_t)c * UAW + p] = f2bf(sr); dst[(size_t)c * UAW + 64 + p] = f2bf(si);
                const float lr = T[(bl * NCH + c) * 128 + p], li = T[(bl * NCH + c) * 128 + 64 + p]; const float nr = ar * sr - ai_ * si + lr, ni = ar * si + ai_ * sr + li; sr = nr; si = ni; } }
        LDS_WAIT(); __builtin_amdgcn_s_barrier(); asm volatile("" ::: "memory");
    }
};

struct RmId { int off; __device__ __forceinline__ int operator()(int n) const { return off + n; } };
struct RmGU { int up; __device__ __forceinline__ int operator()(int n) const { return 256 * (n >> 7) + 128 * up + (n & 127); } };
struct KgNone { __device__ __forceinline__ float operator()(int) const { return 1.f; } };
struct KgVec { const float* g; __device__ __forceinline__ float operator()(int k) const { return ((const GAS float*)g)[k]; } };
struct KgOut { const float* gs; const float* gm; __device__ __forceinline__ float operator()(int k) const { return k < 512 ? ((const GAS float*)gs)[k] : ((const GAS float*)gm)[k - 512]; } };
template <class RowMap, class KG = KgNone> __device__ __forceinline__ void tr_matrix(const float* W, int K, int N, bf16* WT, int ldt, RowMap rm, LAS float* scr, int gw, int NGW, int lane, KG kg = KG()) { asm volatile("" : "+v"(lane));
    const int nnb = N / 32, items = (K / 64) * nnb; const int rr = lane >> 3, c4 = (lane & 7) * 4, c = lane & 7;
    int it = gw; if (it >= items) return;
    f32x4 v[8];
#pragma unroll
    for (int i = 0; i < 8; ++i) v[i] = *(const GAS f32x4*)(W + (size_t)(64 * (it / nnb) + 8 * i + rr) * N + 32 * (it % nnb) + c4);
    for (;;) {
        const int k0 = 64 * (it / nnb), n0 = 32 * (it % nnb), nx = it + NGW; const bool more = nx < items;
#pragma unroll
        for (int i = 0; i < 8; ++i) { LAS float* d = scr + (8 * i + rr) * 33 + c4; const float g_ = kg(k0 + 8 * i + rr); d[0] = v[i][0] * g_; d[1] = v[i][1] * g_; d[2] = v[i][2] * g_; d[3] = v[i][3] * g_; }
        if (more) {
#pragma unroll
            for (int i = 0; i < 8; ++i) v[i] = *(const GAS f32x4*)(W + (size_t)(64 * (nx / nnb) + 8 * i + rr) * N + 32 * (nx % nnb) + c4); }
        LDS_WAIT(); asm volatile("" ::: "memory");
#pragma unroll
        for (int j = 0; j < 4; ++j) { const int n = (lane >> 3) + 8 * j; const LAS float* sp = scr + (8 * c) * 33 + n;
            v4u o; o.x = pk2(sp[0 * 33], sp[1 * 33]); o.y = pk2(sp[2 * 33], sp[3 * 33]); o.z = pk2(sp[4 * 33], sp[5 * 33]); o.w = pk2(sp[6 * 33], sp[7 * 33]);
            *(GAS v4u*)(WT + (size_t)rm(n0 + n) * ldt + k0 + 8 * c) = o; }
        LDS_WAIT(); asm volatile("" ::: "memory");
        if (!more) break; it = nx;
    }
}
__device__ __forceinline__ void zero_bf16(bf16* p, size_t n8  , int gtid, int gthreads) { asm volatile("" : "+v"(gtid)); for (size_t i = gtid; i < n8; i += gthreads) ((v4u*)p)[i] = (v4u){0u, 0u, 0u, 0u}; }

__device__ __forceinline__ void conv_small(unsigned char* ws_, int layer, LAS float* scr, int gw, int NGW, int lane, int gtid, int gthreads) {
    unsigned char* wb = ws_ + WS_WSMALL + (size_t)layer * WSM_STRIDE;
    bf16* Win_t = (bf16*)(wb + WSM_IN); bf16* Wglu_t = (bf16*)(wb + WSM_GLU); bf16* Wq_t = (bf16*)(wb + WSM_Q); bf16* Wkv_t = (bf16*)(wb + WSM_KV); bf16* Wout_t = (bf16*)(wb + WSM_OUT);
    tr_matrix(kin(I_W_IN) + (size_t)layer * DM * DIN, DM, DIN, Win_t, DM, RmId{0}, scr, gw, NGW, lane, KgVec{kin(I_ATTN_NORM) + layer * DM});
    zero_bf16(Win_t + (size_t)DIN * DM, (size_t)(1024 - DIN) * DM / 8, gtid, gthreads);
    tr_matrix(kin(I_W_GLU) + (size_t)layer * DSSM * DSSM, DSSM, DSSM, Wglu_t, DSSM, RmId{0}, scr, gw, NGW, lane);
    tr_matrix(kin(I_W_Q_UP) + (size_t)layer * QRANK * 768, QRANK, 768, Wq_t, QRANK, RmId{0}, scr, gw, NGW, lane);
    tr_matrix(kin(I_W_KV_UP) + (size_t)layer * KVRANK * 1024, KVRANK, 1024, Wkv_t, 256, RmId{0}, scr, gw, NGW, lane);
    asm volatile("" : "+v"(gtid));
    for (int i = gtid; i < 1024 * 16; i += gthreads) ((v4u*)(Wkv_t + (size_t)(i >> 4) * 256 + 128))[i & 15] = (v4u){0u, 0u, 0u, 0u};
    tr_matrix(kin(I_W_OUT) + (size_t)layer * DM * DM, DM, DM, Wout_t, DM, RmId{0}, scr, gw, NGW, lane, KgOut{kin(I_SSM_OUT_NORM) + layer * DSSM, kin(I_MLA_OUT_NORM) + layer * DSSM});
}
__device__ __forceinline__ void conv_dense(unsigned char* ws_, LAS float* scr, int gw, int NGW, int lane) {
    bf16* Wgu = (bf16*)(ws_ + WS_BIGW + BW_DGU); bf16* Wd = (bf16*)(ws_ + WS_BIGW + BW_DD);
    tr_matrix(kin(I_DW_GATE), DM, FFD, Wgu, DM, RmGU{0}, scr, gw, NGW, lane, KgVec{kin(I_FFN_NORM)});
    tr_matrix(kin(I_DW_UP), DM, FFD, Wgu, DM, RmGU{1}, scr, gw, NGW, lane, KgVec{kin(I_FFN_NORM)});
    tr_matrix(kin(I_DW_DOWN), FFD, DM, Wd, FFD, RmId{0}, scr, gw, NGW, lane);
}
__device__ __forceinline__ void conv_moe(unsigned char* ws_, LAS float* scr, int gw, int NGW, int lane) {
    bf16* Wgu = (bf16*)(ws_ + WS_BIGW + BW_MGU); bf16* Wd = (bf16*)(ws_ + WS_BIGW + BW_MD);
    for (int e = 0; e < NE; ++e) {
        tr_matrix(kin(I_MW_GATE) + (size_t)e * DM * FFE, DM, FFE, Wgu + (size_t)e * 2 * FFE * DM, DM, RmGU{0}, scr, gw, NGW, lane);
        tr_matrix(kin(I_MW_UP) + (size_t)e * DM * FFE, DM, FFE, Wgu + (size_t)e * 2 * FFE * DM, DM, RmGU{1}, scr, gw, NGW, lane);
        tr_matrix(kin(I_MW_DOWN) + (size_t)e * FFE * DM, FFE, DM, Wd + (size_t)e * DM * FFE, FFE, RmId{0}, scr, gw, NGW, lane);
    }
}
__device__ __forceinline__ void rms_row(const float* xrow, const float* g, bf16* orow, int lane) {
    const GAS f32x4* xr = (const GAS f32x4*)xrow + lane; const GAS f32x4* gr = (const GAS f32x4*)g + lane; f32x4 v[4]; float s = 0.f;
#pragma unroll
    for (int j = 0; j < 4; ++j) { v[j] = xr[64 * j]; s += (v[j][0] * v[j][0] + v[j][1] * v[j][1]) + (v[j][2] * v[j][2] + v[j][3] * v[j][3]); }
    const float rstd = 1.f / sqrtf(wave_sum(s) * (1.f / DM) + EPS);
    GAS v2u* o8 = (GAS v2u*)orow + lane;
#pragma unroll
    for (int j = 0; j < 4; ++j) { const f32x4 gg = gr[64 * j]; v2u w; w.x = pk2(v[j][0] * rstd * gg[0], v[j][1] * rstd * gg[1]); w.y = pk2(v[j][2] * rstd * gg[2], v[j][3] * rstd * gg[3]); o8[64 * j] = w; }
}
__device__ __forceinline__ void rms_row_b(const bf16* xrow, const float* g, bf16* orow, int lane) {
    const v4u a = *((const GAS v4u*)xrow + lane), b = *((const GAS v4u*)xrow + 64 + lane);
    float v[16] = {bflo(a.x), bfhi(a.x), bflo(a.y), bfhi(a.y), bflo(a.z), bfhi(a.z), bflo(a.w), bfhi(a.w), bflo(b.x), bfhi(b.x), bflo(b.y), bfhi(b.y), bflo(b.z), bfhi(b.z), bflo(b.w), bfhi(b.w)}; float s = 0.f;
#pragma unroll
    for (int j = 0; j < 16; ++j) s += v[j] * v[j];
    const float rstd = 1.f / sqrtf(wave_sum(s) * (1.f / DM) + EPS);
    const f32x4 g0 = *((const GAS f32x4*)g + 2 * lane), g1 = *((const GAS f32x4*)g + 2 * lane + 1), g2 = *((const GAS f32x4*)g + 128 + 2 * lane), g3 = *((const GAS f32x4*)g + 128 + 2 * lane + 1);
    v4u w; w.x = pk2(v[0] * rstd * g0[0], v[1] * rstd * g0[1]); w.y = pk2(v[2] * rstd * g0[2], v[3] * rstd * g0[3]); w.z = pk2(v[4] * rstd * g1[0], v[5] * rstd * g1[1]); w.w = pk2(v[6] * rstd * g1[2], v[7] * rstd * g1[3]);
    *((GAS v4u*)orow + lane) = w;
    w.x = pk2(v[8] * rstd * g2[0], v[9] * rstd * g2[1]); w.y = pk2(v[10] * rstd * g2[2], v[11] * rstd * g2[3]); w.z = pk2(v[12] * rstd * g3[0], v[13] * rstd * g3[1]); w.w = pk2(v[14] * rstd * g3[2], v[15] * rstd * g3[3]);
    *((GAS v4u*)orow + 64 + lane) = w;
}
__device__ __forceinline__ void ph_rmsnorm_b(const bf16* HB, const float* g, bf16* Z, int gw, int NGW, int lane) { asm volatile("" : "+v"(lane)); for (int m = gw; m < M; m += NGW) rms_row_b(HB + (size_t)m * DM, g, Z + (size_t)m * DM, lane); }
__device__ __forceinline__ void ph_x2hb(const float* x, bf16* HB, float* SSo, int gw, int NGW, int lane) { asm volatile("" : "+v"(lane));
    for (int m = gw; m < M; m += NGW) { const GAS f32x4* xr = (const GAS f32x4*)(x + (size_t)m * DM) + lane; f32x4 v[4]; float s = 0.f;
#pragma unroll
        for (int j = 0; j < 4; ++j) { v[j] = xr[64 * j]; s += (v[j][0] * v[j][0] + v[j][1] * v[j][1]) + (v[j][2] * v[j][2] + v[j][3] * v[j][3]); }
        s = wave_sum(s);
        GAS v2u* h8 = (GAS v2u*)(HB + (size_t)m * DM) + lane;
#pragma unroll
        for (int j = 0; j < 4; ++j) { v2u hw; hw.x = pk2(v[j][0], v[j][1]); hw.y = pk2(v[j][2], v[j][3]); h8[64 * j] = hw; }
        if (lane < 4) ((GAS f32x4*)(SSo + (size_t)m * 16))[lane] = (f32x4){lane == 0 ? s : 0.f, 0.f, 0.f, 0.f}; }
}
__device__ __forceinline__ void ph_rmsnorm(const float* h, const float* g, bf16* Z, int gw, int NGW, int lane) { asm volatile("" : "+v"(lane)); for (int m = gw; m < M; m += NGW) rms_row(h + (size_t)m * DM, g, Z + (size_t)m * DM, lane); }
__device__ __forceinline__ void ph_latnorm(const bf16* PL, const float* gq, const float* gkv, bf16* LAT, int gw, int NGW, int lane) { asm volatile("" : "+v"(lane));
    for (int m = gw; m < M; m += NGW) {
        const v2u qa = *((const v2u*)(PL + (size_t)m * 512) + lane); const unsigned ka = *((const unsigned*)(PL + (size_t)m * 512 + 256) + lane);
        const float q0 = bflo(qa.x), q1 = bfhi(qa.x), q2 = bflo(qa.y), q3 = bfhi(qa.y), k0 = bflo(ka), k1 = bfhi(ka);
        const float rq = 1.f / sqrtf(wave_sum(q0 * q0 + q1 * q1 + q2 * q2 + q3 * q3) * (1.f / 256) + EPS), rk = 1.f / sqrtf(wave_sum(k0 * k0 + k1 * k1) * (1.f / 128) + EPS);
        const f32x4 g4 = *((const f32x4*)gq + lane); const f32x2 g2 = *((const f32x2*)gkv + lane);
        v2u w; w.x = pk2(q0 * rq * g4[0], q1 * rq * g4[1]); w.y = pk2(q2 * rq * g4[2], q3 * rq * g4[3]); *((v2u*)(LAT + (size_t)m * 512) + lane) = w;
        *((unsigned*)(LAT + (size_t)m * 512 + 256) + lane) = pk2(k0 * rk * g2[0], k1 * rk * g2[1]); *((unsigned*)(LAT + (size_t)m * 512 + 384) + lane) = 0u; }
}
constexpr float QSCALE = 0.10206207261596575f * 1.4426950408889634f;
__device__ __forceinline__ void ph_qkprep(bf16* QR, const bf16* KVR, const bf16* PL, bf16* KN, const float* qg, const float* kg, int gw, int NGW, int lane) { asm volatile("" : "+v"(lane));
    const int hd = lane >> 3, sub = lane & 7;
    float gq[12], gk[12];
#pragma unroll
    for (int j = 0; j < 8; ++j) { gq[j] = qg[sub * 8 + j]; gk[j] = kg[sub * 8 + j]; }
#pragma unroll
    for (int j = 0; j < 2; ++j) { gq[8 + j] = qg[64 + sub * 2 + j]; gq[10 + j] = qg[80 + sub * 2 + j]; gk[8 + j] = kg[64 + sub * 2 + j]; gk[10 + j] = kg[80 + sub * 2 + j]; }
    const float inv0 = powf(10000.f, -(float)(sub * 2) / 16.f), inv1 = powf(10000.f, -(float)(sub * 2 + 1) / 16.f);
    for (int m = gw; m < M; m += NGW) {
        const int pos = m & (SEQ - 1); float c0, s0, c1, s1; sincosf((float)pos * inv0, &s0, &c0); sincosf((float)pos * inv1, &s1, &c1);
        bf16* qp = QR + (size_t)m * 768 + hd * 96; const bf16* kp = KVR + (size_t)m * 1024 + hd * 128; const bf16* rp = PL + (size_t)m * 512 + 384;
        const v4u qn = *(const v4u*)(qp + sub * 8); const unsigned qx1 = *(const unsigned*)(qp + 64 + sub * 2), qx2 = *(const unsigned*)(qp + 80 + sub * 2);
        const v4u kn = *(const v4u*)(kp + sub * 8); const unsigned kx1 = *(const unsigned*)(rp + sub * 2), kx2 = *(const unsigned*)(rp + 16 + sub * 2);
        float q[12] = {bflo(qn.x), bfhi(qn.x), bflo(qn.y), bfhi(qn.y), bflo(qn.z), bfhi(qn.z), bflo(qn.w), bfhi(qn.w), bflo(qx1), bfhi(qx1), bflo(qx2), bfhi(qx2)};
        float k[12] = {bflo(kn.x), bfhi(kn.x), bflo(kn.y), bfhi(kn.y), bflo(kn.z), bfhi(kn.z), bflo(kn.w), bfhi(kn.w), bflo(kx1), bfhi(kx1), bflo(kx2), bfhi(kx2)};
        float sq = 0.f, sk = 0.f;
#pragma unroll
        for (int j = 0; j < 12; ++j) { sq += q[j] * q[j]; sk += k[j] * k[j]; }
        sq += __shfl_xor(sq, 1); sq += __shfl_xor(sq, 2); sq += __shfl_xor(sq, 4); sk += __shfl_xor(sk, 1); sk += __shfl_xor(sk, 2); sk += __shfl_xor(sk, 4);
        const float rq = QSCALE / sqrtf(sq * (1.f / 96) + EPS), rk = 1.f / sqrtf(sk * (1.f / 96) + EPS);
#pragma unroll
        for (int j = 0; j < 12; ++j) { q[j] *= rq * gq[j]; k[j] *= rk * gk[j]; }
        const float qa0 = q[8] * c0 - q[10] * s0, qb0 = q[8] * s0 + q[10] * c0, qa1 = q[9] * c1 - q[11] * s1, qb1 = q[9] * s1 + q[11] * c1;
        const float ka0 = k[8] * c0 - k[10] * s0, kb0 = k[8] * s0 + k[10] * c0, ka1 = k[9] * c1 - k[11] * s1, kb1 = k[9] * s1 + k[11] * c1;
        v4u w; w.x = pk2(q[0], q[1]); w.y = pk2(q[2], q[3]); w.z = pk2(q[4], q[5]); w.w = pk2(q[6], q[7]);
        *(v4u*)(qp + sub * 8) = w; *(unsigned*)(qp + 64 + sub * 2) = pk2(qa0, qa1); *(unsigned*)(qp + 80 + sub * 2) = pk2(qb0, qb1);
        bf16* ko = KN + (size_t)m * 768 + hd * 96;
        w.x = pk2(k[0], k[1]); w.y = pk2(k[2], k[3]); w.z = pk2(k[4], k[5]); w.w = pk2(k[6], k[7]);
        *(v4u*)(ko + sub * 8) = w; *(unsigned*)(ko + 64 + sub * 2) = pk2(ka0, ka1); *(unsigned*)(ko + 80 + sub * 2) = pk2(kb0, kb1);
    }
}
__device__ __forceinline__ void ph_outnorm(bf16* MIX, const float* gs, const float* gm, int gw, int NGW, int lane) { asm volatile("" : "+v"(lane));
    for (int m = gw; m < M; m += NGW) { v4u* rp = (v4u*)(MIX + (size_t)m * 1024) + 2 * lane;
        const v4u a = rp[0], b = rp[1]; float v[16] = {bflo(a.x), bfhi(a.x), bflo(a.y), bfhi(a.y), bflo(a.z), bfhi(a.z), bflo(a.w), bfhi(a.w), bflo(b.x), bfhi(b.x), bflo(b.y), bfhi(b.y), bflo(b.z), bfhi(b.z), bflo(b.w), bfhi(b.w)}; float s = 0.f;
#pragma unroll
        for (int j = 0; j < 16; ++j) s += v[j] * v[j];
#pragma unroll
        for (int o = 1; o < 32; o <<= 1) s += __shfl_xor(s, o);
        const float rstd = 1.f / sqrtf(s * (1.f / 512) + EPS); const float* g = (lane < 32 ? gs : gm) + (lane & 31) * 16;
#pragma unroll
        for (int j = 0; j < 16; ++j) v[j] *= rstd * g[j];
        v4u w; w.x = pk2(v[0], v[1]); w.y = pk2(v[2], v[3]); w.z = pk2(v[4], v[5]); w.w = pk2(v[6], v[7]); rp[0] = w;
        w.x = pk2(v[8], v[9]); w.y = pk2(v[10], v[11]); w.z = pk2(v[12], v[13]); w.w = pk2(v[14], v[15]); rp[1] = w; }
}
__device__ __forceinline__ void ph_norm_route(const bf16* HB, const float* g, const float* Wr, bf16* Z, v4u* route, int gw, int NGW, int lane) { asm volatile("" : "+v"(lane));
    for (int m = gw; m < M; m += NGW) {
        const v2u* xr = (const v2u*)(HB + (size_t)m * DM) + lane; const f32x4* gr = (const f32x4*)g + lane; f32x4 v[4]; float s = 0.f;
#pragma unroll
        for (int j = 0; j < 4; ++j) { const v2u x = *((const GAS v2u*)xr + 64 * j); v[j] = (f32x4){bflo(x.x), bfhi(x.x), bflo(x.y), bfhi(x.y)}; s += (v[j][0] * v[j][0] + v[j][1] * v[j][1]) + (v[j][2] * v[j][2] + v[j][3] * v[j][3]); }
        const float rstd = 1.f / sqrtf(wave_sum(s) * (1.f / DM) + EPS);
        float lg[8] = {0.f, 0.f, 0.f, 0.f, 0.f, 0.f, 0.f, 0.f}; v2u* o8 = (v2u*)(Z + (size_t)m * DM) + lane;
#pragma unroll
        for (int j = 0; j < 4; ++j) { const f32x4 gg = gr[64 * j]; float z[4];
#pragma unroll
            for (int q = 0; q < 4; ++q) { z[q] = v[j][q] * rstd * gg[q]; const f32x4* wr = (const f32x4*)(Wr + (size_t)(256 * j + 4 * lane + q) * 8); const f32x4 wa = wr[0], wb = wr[1];
                lg[0] += z[q] * wa[0]; lg[1] += z[q] * wa[1]; lg[2] += z[q] * wa[2]; lg[3] += z[q] * wa[3]; lg[4] += z[q] * wb[0]; lg[5] += z[q] * wb[1]; lg[6] += z[q] * wb[2]; lg[7] += z[q] * wb[3]; }
            v2u w; w.x = pk2(z[0], z[1]); w.y = pk2(z[2], z[3]); *((GAS v2u*)o8 + 64 * j) = w; }
#pragma unroll
        for (int e = 0; e < 8; ++e) lg[e] = wave_sum(lg[e]);
        int e0 = 0; float v0 = lg[0];
#pragma unroll
        for (int e = 1; e < 8; ++e) if (lg[e] > v0) { v0 = lg[e]; e0 = e; }
        int e1 = -1; float v1 = -3.0e38f;
#pragma unroll
        for (int e = 0; e < 8; ++e) if (e != e0 && lg[e] > v1) { v1 = lg[e]; e1 = e; }
        const float w1 = 1.f / (1.f + expf(v0 - v1)), w0 = 1.f - w1;
        if (lane == 0) { ((v2u*)route)[m] = (v2u){(unsigned)e0, (unsigned)e1}; ((f32x2*)((unsigned char*)route + 256 * 1024))[m] = (f32x2){w0, w1}; }
    }
}
__device__ __forceinline__ void ph_route_sort(const v4u* route, unsigned char* rt, LAS unsigned char* lds, int tid) { asm volatile("" : "+v"(tid));
    int* slot_tok = (int*)(rt + RT_SLOT_TOK); float* slot_w = (float*)(rt + RT_SLOT_W); int* tile_e = (int*)(rt + RT_TILE_E); int* ntl = (int*)(rt + RT_NTILES);
    const v2u* re = (const v2u*)route; const f32x2* rw = (const f32x2*)((const unsigned char*)route + 256 * 1024);
    LAS int* wtot = (LAS int*)lds;
    LAS int* wbase = wtot + 128;
    LAS int* etot = wbase + 128;
    const int lane = tid & 63, w = tid >> 6;
    int c[16];
#pragma unroll
    for (int j = 0; j < 16; ++j) c[j] = 0;
    for (int i = 0; i < 64; ++i) { const v2u r = re[w * 4096 + i * 64 + lane];
#pragma unroll
        for (int j = 0; j < 8; ++j) { c[j] += __popcll(__ballot(r.x == (unsigned)j)); c[8 + j] += __popcll(__ballot(r.y == (unsigned)j)); } }
    if (lane == 0) {
#pragma unroll
        for (int j = 0; j < 16; ++j) wtot[w * 16 + j] = c[j]; }
    __syncthreads();
    if (tid < 16) { int s = 0; for (int ww = 0; ww < 8; ++ww) { wbase[ww * 16 + tid] = s; s += wtot[ww * 16 + tid]; } etot[tid] = s; }
    __syncthreads();
    if (tid < 2) { int off = 0; for (int e = 0; e < 8; ++e) { const int n = etot[tid * 8 + e]; const int pad = (n + 255) & ~255; etot[16 + tid * 8 + e] = off;
            for (int t = off / 256; t < (off + pad) / 256; ++t) tile_e[tid * MOE_TILES + t] = e; off += pad; } ntl[tid] = off / 256; }
    __syncthreads();
    for (int j = 0; j < 16; ++j) { const int n = etot[j], off = etot[16 + j], pad = (n + 255) & ~255, k = j >> 3; for (int s = off + n + tid; s < off + pad; s += 512) { slot_tok[k * MOE_SLOTS + s] = -1; slot_w[k * MOE_SLOTS + s] = 0.f; } }
#pragma unroll
    for (int j = 0; j < 16; ++j) c[j] = wbase[w * 16 + j] + etot[16 + j];
    const unsigned long long ltmask = (1ull << lane) - 1ull;
    for (int i = 0; i < 64; ++i) { const int m = w * 4096 + i * 64 + lane; const v2u r = re[m]; const f32x2 wv = rw[m]; int s0 = 0, s1 = 0;
#pragma unroll
        for (int j = 0; j < 8; ++j) { const unsigned long long b0 = __ballot(r.x == (unsigned)j), b1 = __ballot(r.y == (unsigned)j);
            if (r.x == (unsigned)j) s0 = c[j] + __popcll(b0 & ltmask); if (r.y == (unsigned)j) s1 = c[8 + j] + __popcll(b1 & ltmask);
            c[j] += __popcll(b0); c[8 + j] += __popcll(b1); }
        slot_tok[s0] = m; slot_w[s0] = wv[0]; slot_tok[MOE_SLOTS + s1] = m; slot_w[MOE_SLOTS + s1] = wv[1]; }
}
__device__ __forceinline__ void ph_ssm_prep(unsigned char* ws_, int layer, int g, int part, LAS unsigned char* lds, int tid) { asm volatile("" : "+v"(tid));
    LAS float* apr = (LAS float*)lds;
    LAS float* api = apr + 64 * TP1;
    LAS float* bbr = api + 64 * TP1;
    LAS float* bbi = bbr + 1024;
    LAS float* ccr = bbi + 1024;
    LAS float* cci = ccr + 1024;
    LAS float* kt = cci + 1024;
    constexpr int BAND = TCH / 8;
    const float* A_re = kin(I_A_RE) + (size_t)(layer * NG + g) * NP; const float* A_im = kin(I_A_IM) + (size_t)(layer * NG + g) * NP;
    const float step = expf(kin(I_LOG_STEP)[layer * NG + g]);
    const float* B_re = kin(I_B_RE) + (size_t)(layer * NG + g) * NP * GH; const float* B_im = kin(I_B_IM) + (size_t)(layer * NG + g) * NP * GH;
    const float* C_re = kin(I_C_RE) + (size_t)(layer * NG + g) * GH * NP; const float* C_im = kin(I_C_IM) + (size_t)(layer * NG + g) * GH * NP;
    const float* Dv = kin(I_D) + (size_t)(layer * NG + g) * GH;
    for (int i = tid; i < 64 * TP1; i += 512) { const int p = i / TP1, tau = i % TP1; const float e = expf(A_re[p] * step * (float)tau); float sn, cs; sincosf(A_im[p] * step * (float)tau, &sn, &cs); apr[i] = e * cs; api[i] = e * sn; }
    for (int i = tid; i < 1024; i += 512) { const int p = i >> 4; const float lr = A_re[p], li = A_im[p]; const float e = expf(lr * step); float sn, cs; sincosf(li * step, &sn, &cs);
        const float nr = e * cs - 1.f, ni = e * sn, den = lr * lr + li * li, sr = (nr * lr + ni * li) / den, si = (ni * lr - nr * li) / den;
        const float br = B_re[i], bi = B_im[i]; bbr[i] = br * sr - bi * si; bbi[i] = br * si + bi * sr; ccr[i] = C_re[i]; cci[i] = C_im[i]; }
    __syncthreads();
    for (int i = tid; i < BAND * 256; i += 512) { const int tau = BAND * part + (i >> 8), h = (i >> 4) & 15, h2 = i & 15; float s = 0.f;
        for (int p = 0; p < 64; ++p) { const float cr = ccr[h * 64 + p], ci = cci[h * 64 + p], ar = apr[p * TP1 + tau], ai = api[p * TP1 + tau], br = bbr[p * 16 + h2], bi = bbi[p * 16 + h2];
            const float xr = cr * ar - ci * ai, xi = cr * ai + ci * ar; s += xr * br - xi * bi; }
        if (tau == 0 && h == h2) s += Dv[h];
        kt[i] = s; }
    if (part == 0 && tid < 64) { float* aT = (float*)(ws_ + WS_APOW) + (size_t)(g * 64 + tid) * 2; aT[0] = apr[tid * TP1 + TCH]; aT[1] = api[tid * TP1 + TCH]; }
    __syncthreads();
    bf16* Mg = (bf16*)(ws_ + WS_BIGW + BW_MAUG) + (size_t)g * NYC * UAW;
    { const int t0 = BAND * part;
      for (int i = tid; i < BAND * TCH * 32; i += 512) { const int tl = i / (TCH * 32), t = (i >> 5) % TCH, h = (i >> 1) & 15, hf = i & 1, tau = t0 + tl, sft = t - tau; if (sft < 0) continue;
          const LAS f32x4* src = (const LAS f32x4*)(kt + (tl << 8) + h * 16 + hf * 8); const f32x4 x = src[0], y = src[1];
          v4u w; w.x = pk2(x[0], x[1]); w.y = pk2(x[2], x[3]); w.z = pk2(y[0], y[1]); w.w = pk2(y[2], y[3]);
          *(GAS v4u*)(Mg + (size_t)(t * 16 + h) * UAW + 128 + sft * 16 + hf * 8) = w; } }
    for (int i = tid; i < (NYC / 8) * (UAW / 8); i += 512) { const int n = part * (NYC / 8) + i / (UAW / 8), k0 = (i % (UAW / 8)) * 8, t = n >> 4, h = n & 15; float v[8];
        if (k0 >= 128) { if (((k0 - 128) >> 4) <= t) continue;
#pragma unroll
            for (int j = 0; j < 8; ++j) v[j] = 0.f; }
        else {
#pragma unroll
            for (int j = 0; j < 8; ++j) { const int k = k0 + j, p = k & 63; const float cr = ccr[h * 64 + p], ci = cci[h * 64 + p], ar = apr[p * TP1 + t + 1], ai = api[p * TP1 + t + 1];
                v[j] = (k < 64) ? (cr * ar - ci * ai) : -(cr * ai + ci * ar); } }
        v4u w; w.x = pk2(v[0], v[1]); w.y = pk2(v[2], v[3]); w.z = pk2(v[4], v[5]); w.w = pk2(v[6], v[7]); *(GAS v4u*)(Mg + (size_t)n * UAW + k0) = w; }
    bf16* Wg = (bf16*)(ws_ + WS_BIGW + BW_WST) + (size_t)g * 256 * NYC;
    for (int i = tid; i < 32 * (NYC / 8); i += 512) { const int n = part * 32 + i / (NYC / 8), k0 = (i % (NYC / 8)) * 8, s = k0 >> 4, h2 = k0 & 15; float v[8];
        if (n < 128) { const int p = n & 63; const float ar = apr[p * TP1 + TCH - 1 - s], ai = api[p * TP1 + TCH - 1 - s];
#pragma unroll
            for (int j = 0; j < 8; ++j) { const float br = bbr[p * 16 + h2 + j], bi = bbi[p * 16 + h2 + j]; v[j] = (n < 64) ? (ar * br - ai * bi) : (ar * bi + ai * br); } }
        else {
#pragma unroll
            for (int j = 0; j < 8; ++j) v[j] = 0.f; }
        v4u w; w.x = pk2(v[0], v[1]); w.y = pk2(v[2], v[3]); w.z = pk2(v[4], v[5]); w.w = pk2(v[6], v[7]); *(GAS v4u*)(Wg + (size_t)n * NYC + k0) = w; }
    __syncthreads();
}
template <bool FINAL> __device__ __forceinline__ void ph_moe_reduce(const int* slot_tok, const int* ntp, const bf16* PART, bf16* HB, float* out, int gw, int NGW, int lane) { asm volatile("" : "+v"(lane));
    const int T = *ntp, Tm = T & ~63, nrow = (T - Tm) * 256;
    for (int r = gw; r < nrow; r += NGW) { const int tok = ((const GAS int*)slot_tok)[Tm * 256 + r]; if (tok < 0) continue;
#pragma unroll
        for (int hf = 0; hf < 2; ++hf) { const v4u h = *((const GAS v4u*)(HB + (size_t)tok * DM) + hf * 64 + lane);
            float v[8] = {bflo(h.x), bfhi(h.x), bflo(h.y), bfhi(h.y), bflo(h.z), bfhi(h.z), bflo(h.w), bfhi(h.w)};
#pragma unroll
            for (int kp = 0; kp < KSPLIT; ++kp) { const v4u p = *((const GAS v4u*)(PART + ((size_t)kp * MOE_LEFT_ROWS + r) * DM) + hf * 64 + lane);
                v[0] += bflo(p.x); v[1] += bfhi(p.x); v[2] += bflo(p.y); v[3] += bfhi(p.y); v[4] += bflo(p.z); v[5] += bfhi(p.z); v[6] += bflo(p.w); v[7] += bfhi(p.w); }
            if constexpr (FINAL) { GAS f32x4* o = (GAS f32x4*)(out + (size_t)tok * DM) + hf * 128 + 2 * lane; o[0] = (f32x4){v[0], v[1], v[2], v[3]}; o[1] = (f32x4){v[4], v[5], v[6], v[7]}; }
            else { v4u w; w.x = pk2(v[0], v[1]); w.y = pk2(v[2], v[3]); w.z = pk2(v[4], v[5]); w.w = pk2(v[6], v[7]); *((GAS v4u*)(HB + (size_t)tok * DM) + hf * 64 + lane) = w; } } }
}

namespace att {
typedef float f32x16 __attribute__((ext_vector_type(16)));
typedef short s16x4 __attribute__((ext_vector_type(4)));
constexpr int SLOTK = 12288, SLOTV = 8192, LDS_K = 0, LDS_V = 2 * SLOTK, LDS_WS = LDS_V + 2 * SLOTV, LDS_OST = LDS_WS + 8 * 256, LDS_BYTES = LDS_OST + 8 * 4096;
__device__ __forceinline__ int crow(int r, int hi) { return (r & 3) + 8 * (r >> 2) + 4 * hi; }
__device__ __forceinline__ void glds16(const void* gsrc, unsigned lds_dst) { unsigned keep;
    asm volatile("s_mov_b32 %0, m0\n\ts_mov_b32 m0, %2\n\ts_nop 0\n\tglobal_load_lds_dwordx4 %1, off\n\ts_mov_b32 m0, %0" : "=&s"(keep) : "v"(gsrc), "s"(lds_dst) : "memory"); }
#define ATT_WAIT_BAR() asm volatile("s_waitcnt vmcnt(0) lgkmcnt(0)\n\ts_barrier" ::: "memory")
#define ATT_SBAR() __builtin_amdgcn_sched_barrier(0)
__device__ __forceinline__ float max3f(float a, float b, float c) { return __builtin_fmaxf(__builtin_fmaxf(a, b), c); }
__device__ __forceinline__ float rowmax32(const f32x16& p0, const f32x16& p1) {
    float a = max3f(p0[0], p0[1], p1[0]), b = max3f(p0[2], p0[3], p1[1]); a = max3f(a, p1[2], p1[3]);
#pragma unroll
    for (int r = 4; r < 16; r += 4) { a = max3f(a, p0[r], p0[r + 1]); b = max3f(b, p0[r + 2], p0[r + 3]); a = max3f(a, p1[r], p1[r + 1]); b = max3f(b, p1[r + 2], p1[r + 3]); }
    const float m = fmaxf(a, b);
    auto rr = __builtin_amdgcn_permlane32_swap(__float_as_uint(m), __float_as_uint(m), false, false);
    return fmaxf(__uint_as_float(rr[0]), __uint_as_float(rr[1]));
}
__device__ __forceinline__ void pv(f32x16* o, int vb, bf16x8 pa0, bf16x8 pa1, bf16x8 pa2, bf16x8 pa3) {
#pragma unroll
    for (int d0 = 0; d0 < 2; ++d0) { s16x4 lo[4], hi[4];
#pragma unroll
        for (int ks = 0; ks < 4; ++ks) {
            asm volatile("ds_read_b64_tr_b16 %0,%1 offset:%c2" : "=&v"(lo[ks]) : "v"(vb), "i"(d0 * 4096 + ks * 1024) : "memory");
            asm volatile("ds_read_b64_tr_b16 %0,%1 offset:%c2" : "=&v"(hi[ks]) : "v"(vb), "i"(d0 * 4096 + ks * 1024 + 512) : "memory"); }
        asm volatile("s_waitcnt lgkmcnt(0)" ::: "memory"); ATT_SBAR();
#define ATT_PK(k) (bf16x8){lo[k][0], lo[k][1], lo[k][2], lo[k][3], hi[k][0], hi[k][1], hi[k][2], hi[k][3]}
        o[d0] = __builtin_amdgcn_mfma_f32_32x32x16_bf16(pa0, ATT_PK(0), o[d0], 0, 0, 0);
        o[d0] = __builtin_amdgcn_mfma_f32_32x32x16_bf16(pa1, ATT_PK(1), o[d0], 0, 0, 0);
        o[d0] = __builtin_amdgcn_mfma_f32_32x32x16_bf16(pa2, ATT_PK(2), o[d0], 0, 0, 0);
        o[d0] = __builtin_amdgcn_mfma_f32_32x32x16_bf16(pa3, ATT_PK(3), o[d0], 0, 0, 0);
#undef ATT_PK
    }
}
__device__ __forceinline__ void attn_unit(int b, int h, int qb, const bf16* QN, const bf16* KN, const bf16* KVR, bf16* MIX, float* SS, LAS unsigned char* shm) {
    int tid = threadIdx.x; asm volatile("" : "+v"(tid));
    const int lane = tid & 63, r32 = lane & 31, hi = lane >> 5, wid = __builtin_amdgcn_readfirstlane(tid >> 6);
    const long rowbase = (long)b * SEQ; const int q0 = qb * 256;
    const unsigned lds0 = (unsigned)(uintptr_t)shm;
    LAS float* wsf = (LAS float*)(shm + LDS_WS) + wid * 64;
    const bf16* ksrc0 = KN + (rowbase + lane) * 768 + h * 96 + wid * 8;
    const bf16* ksrc1 = ksrc0 + 64;
    const bf16* vsrc = KVR + (rowbase + 16 * (wid & 3) + (lane >> 2)) * 1024 + h * 128 + 64 + (wid >> 2) * 32 + (lane & 3) * 8;
    const unsigned kdst0 = lds0 + LDS_K + wid * 1024, kdst1 = lds0 + LDS_K + (8 + wid) * 1024, vdst = lds0 + LDS_V + wid * 1024;
#define ATT_DMA(t, s) do { glds16(ksrc0 + (long)(t) * 64 * 768, (unsigned)__builtin_amdgcn_readfirstlane(kdst0 + (s) * SLOTK)); \
        if (wid < 4) glds16(ksrc1 + (long)(t) * 64 * 768, (unsigned)__builtin_amdgcn_readfirstlane(kdst1 + (s) * SLOTK)); \
        glds16(vsrc + (long)(t) * 64 * 1024, (unsigned)__builtin_amdgcn_readfirstlane(vdst + (s) * SLOTV)); } while (0)
    const int vb0 = (int)(lds0 + LDS_V) + ((lane >> 4) & 1) * 32 + (lane & 3) * 8 + (4 * hi + ((lane & 15) >> 2)) * 64;
    const int NT = 4 * qb + 4, jmax = 4 * qb + (wid >> 1);
    ATT_DMA(0, 0);
    bf16x8 qr[6];
    const bf16* Qw = QN + (rowbase + q0 + wid * 32 + r32) * 768 + h * 96 + hi * 8;
#pragma unroll
    for (int d0 = 0; d0 < 6; ++d0) qr[d0] = *(const bf16x8*)(Qw + d0 * 16);
    float mhat = 0.f, l_reg = 0.f; f32x16 o[2]; f32x16 negm;
#pragma unroll
    for (int r = 0; r < 16; ++r) { o[0][r] = 0.f; o[1][r] = 0.f; negm[r] = 0.f; }
    constexpr float THRL = 8.f;
    for (int j = 0; j < NT; ++j) {
        ATT_WAIT_BAR();
        const int s = j & 1;
        if (j + 1 < NT) ATT_DMA(j + 1, s ^ 1);
        if (j <= jmax) {
            const LAS unsigned char* kb = shm + LDS_K + s * SLOTK + hi * 1024 + r32 * 16;
            f32x16 p0 = negm, p1 = negm;
#pragma unroll
            for (int d0 = 0; d0 < 6; ++d0) { const bf16x8 k0 = *(const LAS bf16x8*)(kb + d0 * 2048), k1 = *(const LAS bf16x8*)(kb + d0 * 2048 + 512);
                p0 = __builtin_amdgcn_mfma_f32_32x32x16_bf16(k0, qr[d0], p0, 0, 0, 0); p1 = __builtin_amdgcn_mfma_f32_32x32x16_bf16(k1, qr[d0], p1, 0, 0, 0); }
            const float rm = rowmax32(p0, p1);
            if (__any(rm > THRL) || j == 0) {
                const float dl = (j == 0) ? rm : fmaxf(rm, 0.f); mhat += dl;
#pragma unroll
                for (int r = 0; r < 16; ++r) { p0[r] -= dl; p1[r] -= dl; negm[r] = -mhat; }
                const float f = __builtin_amdgcn_exp2f(-dl); l_reg *= f;
                if (hi == 0) wsf[r32] = f;
                asm volatile("s_waitcnt lgkmcnt(0)" ::: "memory");
#pragma unroll
                for (int r = 0; r < 16; ++r) { const float g = wsf[crow(r, hi)]; o[0][r] *= g; o[1][r] *= g; }
            }
            float sacc = 0.f;
#pragma unroll
            for (int r = 0; r < 16; ++r) { p0[r] = __builtin_amdgcn_exp2f(p0[r]); p1[r] = __builtin_amdgcn_exp2f(p1[r]); sacc += p0[r] + p1[r]; }
            l_reg += sacc;
            v4u pw0, pw1, pw2, pw3;
            pw0 = (v4u){pk2(p0[0], p0[1]), pk2(p0[2], p0[3]), pk2(p0[4], p0[5]), pk2(p0[6], p0[7])}; pw1 = (v4u){pk2(p0[8], p0[9]), pk2(p0[10], p0[11]), pk2(p0[12], p0[13]), pk2(p0[14], p0[15])};
            pw2 = (v4u){pk2(p1[0], p1[1]), pk2(p1[2], p1[3]), pk2(p1[4], p1[5]), pk2(p1[6], p1[7])}; pw3 = (v4u){pk2(p1[8], p1[9]), pk2(p1[10], p1[11]), pk2(p1[12], p1[13]), pk2(p1[14], p1[15])};
            ATT_SBAR();
            pv(o, vb0 + s * SLOTV, __builtin_bit_cast(bf16x8, pw0), __builtin_bit_cast(bf16x8, pw1), __builtin_bit_cast(bf16x8, pw2), __builtin_bit_cast(bf16x8, pw3));
        }
    }
    { auto rr = __builtin_amdgcn_permlane32_swap(__float_as_uint(l_reg), __float_as_uint(l_reg), false, false); l_reg = __uint_as_float(rr[0]) + __uint_as_float(rr[1]); }
    if (hi == 0) wsf[32 + r32] = l_reg;
    asm volatile("s_waitcnt lgkmcnt(0)" ::: "memory");
    float rli[16];
#pragma unroll
    for (int r = 0; r < 16; ++r) rli[r] = __builtin_amdgcn_rcpf(wsf[32 + crow(r, hi)]);
    bf16* Ow = MIX + (rowbase + q0 + wid * 32) * 1024 + 512 + h * 64;
    { LAS bf16* stg = (LAS bf16*)(shm + LDS_OST) + wid * 2048;
#pragma unroll
      for (int r = 0; r < 16; ++r) { const int orow = crow(r, hi);
#pragma unroll
          for (int d0 = 0; d0 < 2; ++d0) stg[orow * 64 + d0 * 32 + r32] = f2bf(o[d0][r] * rli[r]); }
      asm volatile("s_waitcnt lgkmcnt(0)" ::: "memory");
#pragma unroll
      for (int i = 0; i < 4; ++i) { const int row = i * 8 + (lane >> 3), ch = lane & 7; const v4u v = *(const LAS v4u*)(stg + row * 64 + ch * 8); *(v4u*)(Ow + (long)row * 1024 + ch * 8) = v;
          float ss = (bflo(v.x) * bflo(v.x) + bfhi(v.x) * bfhi(v.x)) + (bflo(v.y) * bflo(v.y) + bfhi(v.y) * bfhi(v.y)) + (bflo(v.z) * bflo(v.z) + bfhi(v.z) * bfhi(v.z)) + (bflo(v.w) * bflo(v.w) + bfhi(v.w) * bfhi(v.w));
          ss += __shfl_xor(ss, 1); ss += __shfl_xor(ss, 2); ss += __shfl_xor(ss, 4);
          if (ch == 0) ((GAS float*)SS)[(rowbase + q0 + wid * 32 + row) * 16 + 8 + h] = ss; } }
    ATT_WAIT_BAR();
#undef ATT_DMA
}
__device__ __forceinline__ void attn_phase(const bf16* QN, const bf16* KN, const bf16* KVR, bf16* MIX, float* SS, LAS unsigned char* lds, int vcu, int G) {
#pragma unroll 1
    for (int v = vcu; v < 256; v += G) {
        const int bh = v >> 2, s = v & 3;
#pragma unroll 1
        for (int i = 0; i < 4; ++i) { const int qb = (i == 0) ? s : (i == 1) ? 7 - s : (i == 2) ? 8 + s : 15 - s; attn_unit(bh >> 3, bh & 7, qb, QN, KN, KVR, MIX, SS, lds); } }
}
}
#define XB_TMO      128
#define XB_XCNT(j)  (256  + 64 * (j))
#define XB_XSUB(j)  (1280 + 64 * (j))
#define XB_XGEN(j)  (2304 + 64 * (j))
#define XB_TOP      3328
#define XB_TOPGEN   3392
#define XCD_BAR_WORDS 3456
#define XB_SPIN_CAP (1u << 18)
__device__ __forceinline__ unsigned xb_ld(unsigned* p)              { return __hip_atomic_load(p, __ATOMIC_RELAXED, __HIP_MEMORY_SCOPE_AGENT); }
__device__ __forceinline__ unsigned xb_add(unsigned* p, unsigned v) { return __hip_atomic_fetch_add(p, v, __ATOMIC_RELAXED, __HIP_MEMORY_SCOPE_AGENT); }
__device__ __forceinline__ unsigned xb_xcc_id() { return (unsigned)__builtin_amdgcn_s_getreg((3 << 11) | 20) & 0xFu; }
#define XB_SPIN(cond, bar) do { unsigned _sp = 0; while (cond) { __builtin_amdgcn_s_sleep(1); \
    if ((++_sp & 255u) == 0u) { if (xb_ld(&(bar)[XB_TMO])) break; if (_sp > XB_SPIN_CAP) { atomicAdd(&(bar)[XB_TMO], 1u); break; } } } } while (0)
struct XcdBarrier { unsigned* bar; unsigned x; volatile LAS unsigned* st; };
__device__ __forceinline__ XcdBarrier xcd_barrier_post(unsigned* bar, volatile LAS unsigned* st) {
    XcdBarrier b; b.bar = bar; b.x = xb_xcc_id(); b.st = st;
    if (threadIdx.x == 0) (void)xb_add(&bar[XB_XCNT(b.x)], 1u);
    return b;
}
__device__ __forceinline__ void xcd_barrier_complete(unsigned* bar, unsigned x, unsigned& nloc, unsigned& nx) {
    const unsigned G = gridDim.x * gridDim.y * gridDim.z;
    unsigned sum, cnt, mine, sp = 0u;
    for (;;) {
        sum = 0u; cnt = 0u; mine = 0u;
#pragma unroll
        for (unsigned j = 0; j < 16; ++j) { const unsigned c = xb_ld(&bar[XB_XCNT(j)]); sum += c; cnt += (c > 0u) ? 1u : 0u; mine = (j == x) ? c : mine; }
        if (sum == G) break;
        __builtin_amdgcn_s_sleep(1);
        if ((++sp & 255u) == 0u) { if (xb_ld(&bar[XB_TMO])) break; if (sp > XB_SPIN_CAP) { atomicAdd(&bar[XB_TMO], 1u); break; } }
    }
    nloc = mine > 0u ? mine : 1u; nx = cnt > 0u ? cnt : 1u;
}
__device__ __forceinline__ void xcd_barrier(const XcdBarrier& b) {
    asm volatile("s_waitcnt vmcnt(0)" ::: "memory");
    __syncthreads();
    if (threadIdx.x == 0) {
        unsigned* bar = b.bar; asm volatile("" : "+s"(bar));
        __builtin_amdgcn_s_waitcnt(0);
        unsigned nloc = b.st[0], nx = b.st[1];
        if (nloc == 0u) { xcd_barrier_complete(bar, b.x, nloc, nx); b.st[0] = nloc; b.st[1] = nx; }
        const unsigned old = xb_add(&bar[XB_XSUB(b.x)], 1u);
        const unsigned gen = old / nloc;
        if (old + 1u == (gen + 1u) * nloc) {
            __builtin_amdgcn_fence(__ATOMIC_RELEASE, "agent");
            asm volatile("s_waitcnt vmcnt(0)" ::: "memory");
            const unsigned og = xb_add(&bar[XB_TOP], 1u);
            const unsigned tg = og / nx;
            if (og + 1u == (tg + 1u) * nx) xb_add(&bar[XB_TOPGEN], 1u);
            else XB_SPIN(xb_ld(&bar[XB_TOPGEN]) == tg, bar);
            __builtin_amdgcn_fence(__ATOMIC_ACQUIRE, "agent");
            xb_add(&bar[XB_XGEN(b.x)], 1u);
            asm volatile("s_waitcnt vmcnt(0)" ::: "memory");
        } else {
            XB_SPIN(xb_ld(&bar[XB_XGEN(b.x)]) == gen, bar);
            __builtin_amdgcn_fence(__ATOMIC_ACQUIRE, "agent");
            asm volatile("s_waitcnt vmcnt(0)" ::: "memory");
        }
    }
    __syncthreads();
}

constexpr int RING_BYTES = 131072, MISC_OFF = RING_BYTES + 320, LDS_BYTES = 147456;
enum { PH_PREP = 0, PH_NORM1, PH_INPROJ, PH_SSMS, PH_SSMY, PH_GLU, PH_LATNORM, PH_QUP, PH_KVUP, PH_QKPREP, PH_ATTN, PH_OUTNORM, PH_OUTPROJ, PH_NORM2, PH_F0, PH_F1, PH_F2, PH_F3, PH_F4, PH_PER_LAYER = 32 };
struct Args { Params P; int ph_lo, ph_hi; unsigned skip_mask; int pad; };

struct LArgs { unsigned char* ws; float* outp; int G, bx, vcu, pad; };
#ifndef REPMASK0
#define REPMASK0 0x0
#define REPMASK1 0x0
#endif
#define REPS(k) (((((unsigned)(layer == 0 ? REPMASK0 : REPMASK1)) >> (k)) & 1u) ? 2 : 1)
#define RUN(k, ...) do { { const float rep_scale = 1.f; (void)rep_scale; __VA_ARGS__; } if constexpr (REPS(k) > 1) { const float rep_scale = 0.f; (void)rep_scale; __syncthreads(); __VA_ARGS__; } } while (0)
#define BAR() xcd_barrier(bar)
template <int layer> __device__ __forceinline__ void run_layer(const LArgs a, const XcdBarrier bar, LAS unsigned char* lds) {
    unsigned char* const ws = a.ws; float* const outp = a.outp; const int G = a.G, bx = a.bx, vcu = a.vcu;
    const int tid = threadIdx.x, lane = tid & 63, wave = __builtin_amdgcn_readfirstlane(tid >> 6);
    const int gw = vcu * 8 + wave, NGW = G * 8, gtid = bx * 512 + tid, gthreads = G * 512;
    bf16* HB = (bf16*)(ws + WS_HB); bf16* Z = (bf16*)outp; bf16* LAT = (bf16*)outp; bf16* KN = (bf16*)outp; bf16* MIX = (bf16*)(ws + WS_MIX); bf16* PL = (bf16*)(ws + WS_PL);
    bf16* UA = (bf16*)(ws + WS_UAUG); bf16* YG = (bf16*)(ws + WS_YG); bf16* KVR = (bf16*)(ws + WS_KVRAW); bf16* QR = (bf16*)(ws + WS_QRAW);
    bf16* ACTD = (bf16*)(ws + WS_ACTD); bf16* ACTM = (bf16*)(ws + WS_ACTM);
    LAS float* scr = (LAS float*)(lds + wave * 16384);
    unsigned char* wsm = ws + WS_WSMALL + (size_t)layer * WSM_STRIDE;
    RUN(0, { for (int j = bx; j < 256; j += G) ph_ssm_prep(ws, layer, j & 31, j >> 5, lds, tid);
             conv_small(ws, layer, scr, gw, NGW, lane, gtid, gthreads);
             if constexpr (layer == 0) conv_dense(ws, scr, gw, NGW, lane);
             if constexpr (layer == 0) ph_x2hb(kin(I_X), HB, (float*)(ws + WS_SS3), gw, NGW, lane); });
    BAR();
    RUN(1, { DenseSched S{(const char*)HB, (const char*)(wsm + WSM_IN), DM * 2, DM * 2, M / 256, 4, DM / 64, G, bx}; EpiInProjRs E{UA, PL, (const float*)(ws + WS_SS3), lds}; pg8::gemm_phase(lds, S, E); });
    BAR();
    RUN(2, { { SsmSSched S{(const char*)UA, (const char*)(ws + WS_BIGW + BW_WST), UAW * 2, NYC * 2, G, bx}; EpiSsmS E{UA, (const float*)(ws + WS_APOW)}; pg8::gemm_phase<EpiSsmS, SsmSSched, false, true>(lds, S, E); }
             ph_latnorm(PL, kin(I_Q_NORM) + layer * QRANK, kin(I_KV_NORM) + layer * KVRANK, LAT, gw, NGW, lane); });
    BAR();
    RUN(3, { { SsmYSched S{(const char*)UA, (const char*)(ws + WS_BIGW + BW_MAUG), UAW * 2, UAW * 2, G, bx}; EpiSsmY E{YG}; pg8::gemm_phase(lds, S, E); }
             { DenseSched S{(const char*)LAT, (const char*)(wsm + WSM_Q), 512 * 2, QRANK * 2, M / 256, 3, 4, G, bx}; EpiBf16 E{QR, 768}; pg8::gemm_phase(lds, S, E); }
             { DenseSched S{(const char*)(LAT + 256), (const char*)(wsm + WSM_KV), 512 * 2, 256 * 2, M / 256, 4, 4, G, bx}; EpiBf16 E{KVR, 1024}; pg8::gemm_phase(lds, S, E); } });
    BAR();
    RUN(4, { { DenseSched S{(const char*)YG, (const char*)(wsm + WSM_GLU), DSSM * 2, DSSM * 2, M / 256, 2, DSSM / 64, G, bx}; EpiGlu E{YG, kin(I_B_GLU) + layer * DSSM, MIX, (float*)(ws + WS_SS)}; pg8::gemm_phase(lds, S, E); }
             if (rep_scale == 1.f) ph_qkprep(QR, KVR, PL, KN, kin(I_Q_GAIN) + layer * DQK, kin(I_K_GAIN) + layer * DQK, gw, NGW, lane); });
    BAR();
    RUN(5, att::attn_phase(QR, KN, KVR, MIX, (float*)(ws + WS_SS), lds, vcu, G));
    BAR();
    RUN(7, { DenseSched S{(const char*)MIX, (const char*)(wsm + WSM_OUT), DM * 2, DM * 2, M / 256, 4, DM / 64, G, bx}; EpiOutProj E{HB, (const float*)(ws + WS_SS), rep_scale, lds, (float*)(ws + WS_SS2)}; pg8::gemm_phase(lds, S, E); });
    BAR();
    if constexpr (layer == 0) {
        RUN(9, { DenseSched S{(const char*)HB, (const char*)(ws + WS_BIGW + BW_DGU), DM * 2, DM * 2, M / 256, 22, DM / 64, G, bx}; EpiSwigluRs E{ACTD, FFD, (const float*)(ws + WS_SS2), lds}; pg8::gemm_phase(lds, S, E); });
        BAR();
        RUN(10, { DenseSched S{(const char*)ACTD, (const char*)(ws + WS_BIGW + BW_DD), FFD * 2, FFD * 2, M / 256, 4, FFD / 64, G, bx}; EpiResid E{HB, rep_scale, (float*)(ws + WS_SS3)}; pg8::gemm_phase(lds, S, E); });
        BAR();
    } else {
        unsigned char* rt = ws + WS_ROUTE;
        RUN(8, { ph_norm_route(HB, kin(I_FFN_NORM) + layer * DM, kin(I_MW_ROUTER), Z, (v4u*)rt, gw, NGW, lane); });
        BAR();
        RUN(9, { if (bx == G - 1) { ph_route_sort((const v4u*)rt, rt, lds, tid); __syncthreads(); } conv_moe(ws, scr, gw, NGW, lane); });
        BAR();
        bf16* PART0 = (bf16*)((unsigned char*)outp + 64 * MiB); bf16* PART1 = (bf16*)(ws + WS_BIGW);
#pragma unroll 1
        for (int k = 0; k < 2; ++k) {
            const int* tile_e = (const int*)(rt + RT_TILE_E) + k * MOE_TILES; const int* slot_tok = (const int*)(rt + RT_SLOT_TOK) + k * MOE_SLOTS; const float* slot_w = (const float*)(rt + RT_SLOT_W) + k * MOE_SLOTS; const int* ntl = (const int*)(rt + RT_NTILES) + k;
            if (k == 1) ph_moe_reduce<false>((const int*)(rt + RT_SLOT_TOK), (const int*)(rt + RT_NTILES), PART0, HB, outp, gw, NGW, lane);
            RUN(10, { MoeSched S{(const char*)Z, (const char*)(ws + WS_BIGW + BW_MGU), DM * 2, DM * 2, (size_t)2 * FFE * DM * 2, 28, DM / 64, G, bx, tile_e, slot_tok, ntl}; EpiSwiglu E{ACTM, FFE}; pg8::gemm_phase(lds, S, E); });
            BAR();
            if (k == 0) RUN(11, { MoeDownSched S{(const char*)ACTM, (const char*)(ws + WS_BIGW + BW_MD), FFE * 2, FFE * 2, (size_t)DM * FFE * 2, G, bx, tile_e, ntl}; EpiMoeDown<false> E{slot_tok, slot_w, HB, outp, rep_scale, ntl, PART0}; pg8::gemm_phase(lds, S, E); });
            else RUN(12, { MoeDownSched S{(const char*)ACTM, (const char*)(ws + WS_BIGW + BW_MD), FFE * 2, FFE * 2, (size_t)DM * FFE * 2, G, bx, tile_e, ntl}; EpiMoeDown<true> E{slot_tok, slot_w, HB, outp, 1.f, ntl, PART1}; pg8::gemm_phase(lds, S, E); });
            BAR();
            if (k == 1) ph_moe_reduce<true>(slot_tok, ntl, PART1, HB, outp, gw, NGW, lane);
        }
    }
}
__global__ void __launch_bounds__(512, 2) fwd(Args args) {
    extern __shared__ __attribute__((aligned(16))) unsigned char lds_raw[];
    LAS unsigned char* lds = (LAS unsigned char*)lds_raw;
    unsigned char* const ws = args.P.ws; float* const outp = args.P.out;
    const int tid = threadIdx.x, lane = tid & 63, wave = __builtin_amdgcn_readfirstlane(tid >> 6);
    const int G = gridDim.x, bx = blockIdx.x; const int vcu = (G % 8 == 0) ? (bx % 8) * (G / 8) + bx / 8 : bx;
    const int gw = vcu * 8 + wave, NGW = G * 8, gtid = bx * 512 + tid, gthreads = G * 512;
    volatile LAS unsigned* MISC = (volatile LAS unsigned*)(lds + MISC_OFF);
    for (int u = tid; u < (LDS_BYTES - RING_BYTES) / 4; u += 512) ((LAS unsigned*)(lds + RING_BYTES))[u] = 0u;
    __syncthreads();
    unsigned* ctl = (unsigned*)(ws + WS_CTL);
    XcdBarrier bar = xcd_barrier_post(ctl + CW_BAR, MISC + 8);

    LArgs la; la.ws = ws; la.outp = outp; la.G = G; la.bx = bx; la.vcu = vcu; la.pad = 0;
    run_layer<0>(la, bar, lds);
    run_layer<1>(la, bar, lds);
}
static void launch_fwd(const Params& P, int lo, int hi, unsigned skip, int grid, hipStream_t st) {
    Args a{}; a.P = P; a.ph_lo = lo; a.ph_hi = hi; a.skip_mask = skip; a.pad = 0;
    hipLaunchKernelGGL(fwd, dim3(grid), dim3(512), LDS_BYTES, st, a);
}
extern "C" void kernel_launch(void* const* d_in, const int* in_sizes, int n_in, void* d_out, int out_size, void* d_ws, size_t ws_size, hipStream_t stream) {
    static int grid = 0;
    if (grid == 0) {
        if (n_in != 30 || out_size != M * DM || ws_size < WS_END) { fprintf(stderr, "kernel_launch: unexpected shapes: n_in %d out %d ws %zu (need %zu)\n", n_in, out_size, ws_size, (size_t)WS_END); grid = -1; return; }
        int dev = 0, cus = 0;
        if (hipGetDevice(&dev) != hipSuccess || hipDeviceGetAttribute(&cus, hipDeviceAttributeMultiprocessorCount, dev) != hipSuccess) { grid = -1; return; }
        if (hipFuncSetAttribute((const void*)fwd, hipFuncAttributeMaxDynamicSharedMemorySize, LDS_BYTES) != hipSuccess) { fprintf(stderr, "kernel_launch: hipFuncSetAttribute failed\n"); grid = -1; return; }
        (void)hipGetLastError();
        grid = cus;
    }
    if (grid < 0) return;
    Params P{};
    for (int i = 0; i < 30; ++i) P.in[i] = (const float*)d_in[i];
    P.out = (float*)d_out; P.ws = (unsigned char*)d_ws;
    unsigned char* ws = P.ws;
    (void)hipMemsetAsync(ws + WS_CTL, 0, CTL_ZERO_BYTES, stream);
    launch_fwd(P, 0, DEPTH * PH_PER_LAYER, 0, grid, stream);
}
```

```cpp
#include <hip/hip_runtime.h>
#include <cstdio>
#include <cstdint>

constexpr int NB = 8, SEQ = 4096, DM = 1024, M = NB * SEQ, DEPTH = 2;
#ifndef SSM_TCH
#define SSM_TCH 32
#endif
constexpr int DSSM = 512, NG = 32, GH = 16, NP = 64, TCH = SSM_TCH, NCH = SEQ / TCH;
constexpr int NROWG = NB * NCH, NYC = TCH * 16, SSM_RT = NROWG / 256, SSM_CT = NYC / 256, TP1 = TCH + 1;
constexpr int NHEAD = 8, DV = 64, DNOPE = 64, DROPE = 32, DQK = 96, QRANK = 256, KVRANK = 128;
constexpr int DIN = 928, FFD = 2816, NE = 8, FFE = 3584;
constexpr float EPS = 1e-6f;
constexpr int UAW = 128 + NYC;
constexpr int MOE_SLOTS = 34816;
constexpr int MOE_TILES = MOE_SLOTS / 256;

constexpr size_t MiB = 1u << 20;
constexpr size_t WS_CTL = 0, CTL_ZERO_BYTES = 64 * 1024;
constexpr size_t WS_WSMALL = 1 * MiB;
constexpr size_t WSM_IN = 0, WSM_GLU = 2 * MiB, WSM_Q = 2 * MiB + 512 * 1024, WSM_KV = 3 * MiB, WSM_OUT = 3 * MiB + 512 * 1024, WSM_STRIDE = 6 * MiB;
constexpr size_t WS_APOW = 13 * MiB;
constexpr size_t WS_ROUTE = 14 * MiB;
constexpr size_t RT_SLOT_TOK = 512 * 1024, RT_SLOT_W = RT_SLOT_TOK + 2 * MOE_SLOTS * 4, RT_TILE_E = RT_SLOT_W + 2 * MOE_SLOTS * 4, RT_NTILES = RT_TILE_E + 2 * MOE_TILES * 4;
constexpr size_t WS_SS = 16 * MiB;
constexpr size_t WS_SS2 = 126 * MiB, WS_SS3 = 124 * MiB;
constexpr size_t WS_BIGW = 19 * MiB;
constexpr size_t BW_MAUG = 0, BW_WST = 72 * MiB, BW_DGU = 88 * MiB, BW_DD = 99 * MiB;
constexpr size_t BW_MGU = 0, BW_MD = 112 * MiB;
constexpr size_t WS_HB = 195 * MiB;
constexpr size_t WS_MIX = 259 * MiB;
constexpr size_t WS_PL = 323 * MiB;
constexpr size_t WS_UAUG = 355 * MiB;
constexpr size_t WS_YG = 395 * MiB;
constexpr size_t WS_KVRAW = 128 * MiB;
constexpr size_t WS_QRAW = 427 * MiB;
constexpr size_t WS_ACTD = 323 * MiB;
constexpr size_t WS_ACTM = 259 * MiB;
constexpr size_t WS_END = 511 * MiB;
static_assert(WS_ACTM + (size_t)MOE_SLOTS * FFE * 2 <= WS_END && WS_ACTD + (size_t)M * FFD * 2 <= WS_END && WS_QRAW + (size_t)M * 768 * 2 <= WS_END, "ws map");
static_assert(WS_BIGW + BW_MD + (size_t)NE * DM * FFE * 2 <= WS_HB && WS_UAUG + (size_t)NG * NROWG * UAW * 2 <= WS_YG, "ws map 2");
static_assert(RT_NTILES + 64 <= 5 * MiB, "route map");

constexpr int CW_BAR = 4096;

#define GAS __attribute__((address_space(1)))
#define LAS __attribute__((address_space(3)))
typedef unsigned short bf16;
typedef unsigned v4u __attribute__((ext_vector_type(4)));
typedef unsigned v2u __attribute__((ext_vector_type(2)));
typedef float f32x4 __attribute__((ext_vector_type(4)));
typedef float f32x2 __attribute__((ext_vector_type(2)));
typedef short bf16x8 __attribute__((ext_vector_type(8)));
typedef __bf16 bf16x2_t __attribute__((ext_vector_type(2)));
#define LDS_WAIT() asm volatile("s_waitcnt lgkmcnt(0)" ::: "memory")
#define VM_WAIT() asm volatile("s_waitcnt vmcnt(0)" ::: "memory")
__device__ __forceinline__ unsigned pk2(float lo, float hi) { f32x2 v = {lo, hi}; bf16x2_t b = __builtin_convertvector(v, bf16x2_t); return __builtin_bit_cast(unsigned, b); }
__device__ __forceinline__ bf16 f2bf(float f) { return (bf16)(pk2(f, 0.f) & 0xffffu); }
__device__ __forceinline__ float bf2f(bf16 b) { return __builtin_bit_cast(float, (unsigned)b << 16); }
__device__ __forceinline__ float bflo(unsigned w) { return __builtin_bit_cast(float, w << 16); }
__device__ __forceinline__ float bfhi(unsigned w) { return __builtin_bit_cast(float, w & 0xffff0000u); }
__device__ __forceinline__ float wave_sum(float v) {
#pragma unroll
    for (int o = 1; o < 64; o <<= 1) v += __shfl_xor(v, o);
    return v;
}
__device__ __forceinline__ float sigmoidf_(float x) { return __builtin_amdgcn_rcpf(1.f + __builtin_amdgcn_exp2f(-1.4426950408889634f * x)); }
__device__ __forceinline__ float gelu_tanh(float x) { const float u = 0.7978845608028654f * (x + 0.044715f * x * x * x); return x * sigmoidf_(2.f * u); }

struct Params { const float* in[30]; float* out; unsigned char* ws; };
__device__ __forceinline__ const float* kin(int i) { const float* const* ka = (const float* const*)__builtin_amdgcn_kernarg_segment_ptr(); asm volatile("" : "+s"(ka)); return ka[i]; }
enum { I_X = 0, I_ATTN_NORM, I_W_IN, I_A_RE, I_A_IM, I_LOG_STEP, I_B_RE, I_B_IM, I_C_RE, I_C_IM, I_D, I_W_GLU, I_B_GLU, I_Q_NORM, I_W_Q_UP, I_KV_NORM, I_W_KV_UP,
       I_Q_GAIN, I_K_GAIN, I_SSM_OUT_NORM, I_MLA_OUT_NORM, I_W_OUT, I_FFN_NORM, I_DW_GATE, I_DW_UP, I_DW_DOWN, I_MW_ROUTER, I_MW_GATE, I_MW_UP, I_MW_DOWN };

#ifndef NAIVE
#define NAIVE 0
#endif
#ifndef FAST_GEMM
#define FAST_GEMM 1
#endif
namespace pg8 {
constexpr int BM = 256, BK = 64, HALF = 128, HTB = HALF * BK * 2, STAGE_BYTES = 8 * HTB, NXCD = 8, WGM = 8;
__host__ __device__ __forceinline__ int lds_byte(int r, int c) { const int st = (r >> 4) * 2 + (c >> 5), rr = r & 15, cc = c & 31, ob = rr * 64 + cc * 2; return st * 1024 + (ob ^ (((ob >> 9) & 1) << 5)); }
__host__ __device__ __forceinline__ void stage_rc(int b, int& R, int& C) { const int st = b / 1024, sb = b % 1024, swz = sb ^ (((sb >> 9) & 1) << 5); R = (st >> 1) * 16 + swz / 64; C = (st & 1) * 32 + (swz % 64) / 2; }
__host__ __device__ __forceinline__ int perm32(int rho) { const int n = rho >> 4, i = rho & 15; return 8 * (i >> 2) + 4 * n + (i & 3); }

struct Unit { int pm, pn, aux, kp, seq; };

__device__ __forceinline__ bool static_unit(int i, int G, int c, int nM, int nN, Unit& u) {
    const int nwg = nM * nN; const long L = (long)i * G + c; if (L >= nwg) return false;
    int wgid = (int)L; { const int q = nwg / NXCD, r = nwg % NXCD, xcd = wgid % NXCD, off = wgid / NXCD; wgid = (xcd < r ? xcd * (q + 1) : r * (q + 1) + (xcd - r) * q) + off; }
    const int nig = WGM * nN, gid = wgid / nig, fm = gid * WGM, gsz = (nM - fm) < WGM ? (nM - fm) : WGM;
    u.pm = fm + ((wgid % nig) % gsz); u.pn = (wgid % nig) / gsz; u.aux = 0; u.kp = -1; return true;
}

template <class T, class = void> struct has_mid { static constexpr bool value = false; };
template <class T> struct has_mid<T, decltype((void)T::MID_T)> { static constexpr bool value = true; };
template <class T, class = void> struct has_begin { static constexpr bool value = false; };
template <class T> struct has_begin<T, decltype((void)T::BEGIN)> { static constexpr bool value = true; };
template <class T, class = void> struct has_pair { static constexpr bool value = false; };
template <class T> struct has_pair<T, decltype((void)T::PAIR)> { static constexpr bool value = true; };
template <class T, class = void> struct has_custom { static constexpr bool value = false; };
template <class T> struct has_custom<T, decltype((void)T::CUSTOM)> { static constexpr bool value = true; };
template <class Epi> __device__ __forceinline__ void epi_apply(const Epi& E, const f32x4 (&acc)[2][2][4][2], const Unit& u, int wr, int wc, int fr, int fq) {
    if constexpr (has_custom<Epi>::value) E.apply(acc, u, wr, wc, fr, fq);
    else {
#pragma unroll
    for (int ai = 0; ai < 2; ++ai)
#pragma unroll
        for (int m = 0; m < 4; ++m) { const int r = ai * HALF + wr * 64 + m * 16 + fr;
            if constexpr (has_pair<Epi>::value) E.putpair(u, r, wc * 32 + 8 * fq, acc[ai][0][m][0], acc[ai][0][m][1], acc[ai][1][m][0], acc[ai][1][m][1]);
            else {
#pragma unroll
            for (int bj = 0; bj < 2; ++bj) {
                if constexpr (Epi::PERM) E.put8(u, r, bj * HALF + wc * 32 + 8 * fq, acc[ai][bj][m][0], acc[ai][bj][m][1]);
                else { E.put4(u, r, bj * HALF + wc * 32 + 4 * fq, acc[ai][bj][m][0]); E.put4(u, r, bj * HALF + wc * 32 + 16 + 4 * fq, acc[ai][bj][m][1]); } } }
            asm volatile("" ::: "memory"); }
    }
}

template <class Epi, class Sched, bool ALIGN_EPI = true, bool SP2 = true>
__device__ __forceinline__ void gemm_phase(LAS unsigned char* lds, const Sched& S, const Epi& E) {
    int tid = threadIdx.x; asm volatile("" : "+v"(tid));
    const int wid = __builtin_amdgcn_readfirstlane(tid >> 6), lane = tid & 63, wr = wid >> 2, wc = wid & 3, fr = lane & 15, fq = lane >> 4;
    int RA[2], CA2[2]; unsigned voffB[2], voA0[2], voA1[2], nvA0[2], nvA1[2];
    const unsigned lda = S.lda, ldb = S.ldb;
#pragma unroll
    for (int i = 0; i < 2; ++i) { int R, C; stage_rc(tid * 16 + i * 8192, R, C); const int Rb = Epi::PERM ? ((R & ~31) + perm32(R & 31)) : R;
        RA[i] = R; CA2[i] = C * 2; voffB[i] = (unsigned)Rb * ldb + (unsigned)C * 2u; voA0[i] = (unsigned)R * lda + (unsigned)C * 2u; voA1[i] = (unsigned)(R + HALF) * lda + (unsigned)C * 2u; nvA0[i] = voA0[i]; nvA1[i] = voA1[i]; }
    const size_t kstep = (size_t)(BK * 2);
    const size_t hstepB = (size_t)HALF * ldb;
    const unsigned ldsw = (unsigned)wid * 1024u;
    const int aoff = lds_byte(wr * 64 + fr, fq * 8), boff = lds_byte(wc * 32 + fr, fq * 8);
#define PG8_SA(b, h) (((b) * 2 + (h)) * HTB)
#define PG8_SB(b, h) ((4 + (b) * 2 + (h)) * HTB)
#define PG8_STAGE(bufoff, gbase, voff) do { _Pragma("unroll") for (int _i = 0; _i < 2; ++_i) \
        __builtin_amdgcn_global_load_lds((const unsigned*)((const char*)(gbase) + (voff)[_i]), (LAS unsigned*)(lds + (bufoff) + ldsw + _i * 8192), 16, 0, 0); } while (0)
#define PG8_LDA(dst, b, h) do { _Pragma("unroll") for (int m = 0; m < 4; ++m) _Pragma("unroll") for (int k = 0; k < 2; ++k) dst[m][k] = *(const LAS bf16x8*)(lds + PG8_SA(b, h) + aoff + m * 2048 + k * 1024); } while (0)
#define PG8_LDB(dst, b, h) do { _Pragma("unroll") for (int n = 0; n < 2; ++n) _Pragma("unroll") for (int k = 0; k < 2; ++k) dst[n][k] = *(const LAS bf16x8*)(lds + PG8_SB(b, h) + boff + n * 2048 + k * 1024); } while (0)
#define PG8_MMA(ai, bj, At, Bt) do { __builtin_amdgcn_s_setprio(1); _Pragma("unroll") for (int m = 0; m < 4; ++m) _Pragma("unroll") for (int n = 0; n < 2; ++n) _Pragma("unroll") for (int k = 0; k < 2; ++k) \
        acc[ai][bj][m][n] = __builtin_amdgcn_mfma_f32_16x16x32_bf16(Bt[n][k], At[m][k], acc[ai][bj][m][n], 0, 0, 0); __builtin_amdgcn_s_setprio(0); } while (0)
#define PG8_WAIT_V(n) asm volatile("s_waitcnt vmcnt(" #n ")" ::: "memory")
#define PG8_WAIT_L(n) asm volatile("s_waitcnt lgkmcnt(" #n ")" ::: "memory")
#define PG8_BAR __builtin_amdgcn_s_barrier()
#define PG8_SCHED __builtin_amdgcn_sched_barrier(0)
    Unit cur, nxt; int ui = 0;
    if (!S.next(0, cur)) return;
    cur.seq = 0;
    if constexpr (Sched::GATHER) {
#pragma unroll
        for (int i = 0; i < 2; ++i) { voA0[i] = S.a_rowoff(cur, RA[i]) + (unsigned)CA2[i]; voA1[i] = S.a_rowoff(cur, RA[i] + HALF) + (unsigned)CA2[i]; }
    }
    f32x4 acc[2][2][4][2];
#pragma unroll
    for (int a = 0; a < 2; ++a)
#pragma unroll
        for (int b = 0; b < 2; ++b)
#pragma unroll
            for (int m = 0; m < 4; ++m)
#pragma unroll
                for (int n = 0; n < 2; ++n) acc[a][b][m][n] = (f32x4){0.f, 0.f, 0.f, 0.f};
    bf16x8 At[4][2], B0[2][2], B1[2][2];
    const char* cA = S.a_base(cur); const char* cB = S.b_base(cur);
    if constexpr (SP2) {
        PG8_STAGE(PG8_SB(0, 0), cB, voffB); PG8_STAGE(PG8_SB(0, 1), cB + hstepB, voffB); PG8_STAGE(PG8_SA(0, 0), cA, voA0); PG8_STAGE(PG8_SA(0, 1), cA, voA1);
        if (wr == 1) PG8_BAR;
        PG8_WAIT_V(2); PG8_BAR;
        PG8_STAGE(PG8_SB(1, 0), cB + kstep, voffB); PG8_STAGE(PG8_SA(1, 0), cA + kstep, voA0); PG8_STAGE(PG8_SB(1, 1), cB + hstepB + kstep, voffB);
        PG8_WAIT_V(6); PG8_BAR;
    } else {
        PG8_STAGE(PG8_SB(0, 0), cB, voffB); PG8_STAGE(PG8_SA(0, 0), cA, voA0); PG8_STAGE(PG8_SB(0, 1), cB + hstepB, voffB); PG8_STAGE(PG8_SA(0, 1), cA, voA1);
        if (wr == 1) PG8_BAR;
        PG8_WAIT_V(4); PG8_BAR;
        PG8_STAGE(PG8_SB(1, 0), cB + kstep, voffB); PG8_STAGE(PG8_SA(1, 0), cA + kstep, voA0); PG8_STAGE(PG8_SB(1, 1), cB + hstepB + kstep, voffB);
        PG8_WAIT_V(6); PG8_BAR;
    }
    for (;;) {
        const bool has_next = S.next(ui + 1, nxt);
        const char* nA = has_next ? S.a_base(nxt) : cA; const char* nB = has_next ? S.b_base(nxt) : cB;
        if constexpr (Sched::GATHER) {
            if (has_next) {
#pragma unroll
                for (int i = 0; i < 2; ++i) { nvA0[i] = S.a_rowoff(nxt, RA[i]) + (unsigned)CA2[i]; nvA1[i] = S.a_rowoff(nxt, RA[i] + HALF) + (unsigned)CA2[i]; }
            } else {
#pragma unroll
                for (int i = 0; i < 2; ++i) { nvA0[i] = voA0[i]; nvA1[i] = voA1[i]; }
            }
        }
        if constexpr (has_begin<Epi>::value) E.unit_begin(cur, lds, tid);
        const int nt = S.nt(cur);
        for (int t = 0; t < nt; t += 2) {
            const bool last = (t == nt - 2);
            if constexpr (has_mid<Epi>::value) { if (t == Epi::MID_T) E.mid(acc, cur, wr, fr, lds); }
            const char* a1 = cA + (size_t)(t + 1) * kstep;
            const char* a2 = last ? nA : cA + (size_t)(t + 2) * kstep; const char* b2 = last ? nB : cB + (size_t)(t + 2) * kstep;
            const char* a3 = a2 + kstep; const char* b3 = b2 + kstep;
            unsigned w0[2], w1[2];
            if constexpr (Sched::GATHER) {
#pragma unroll
                for (int i = 0; i < 2; ++i) { w0[i] = last ? nvA0[i] : voA0[i]; w1[i] = last ? nvA1[i] : voA1[i]; }
            } else {
#pragma unroll
                for (int i = 0; i < 2; ++i) { w0[i] = voA0[i]; w1[i] = voA1[i]; }
            }
            if constexpr (SP2) {
            PG8_LDB(B0, 0, 0); PG8_LDB(B1, 0, 1); PG8_SCHED; PG8_LDA(At, 0, 0); PG8_STAGE(PG8_SA(1, 1), a1, voA1);
            PG8_WAIT_V(8); PG8_WAIT_L(0); PG8_BAR; PG8_MMA(0, 0, At, B0); PG8_MMA(0, 1, At, B1); PG8_BAR; PG8_SCHED;
            PG8_LDA(At, 0, 1); PG8_STAGE(PG8_SB(0, 0), b2, voffB); PG8_STAGE(PG8_SB(0, 1), b2 + hstepB, voffB); PG8_STAGE(PG8_SA(0, 0), a2, w0);
            PG8_WAIT_V(8); PG8_WAIT_L(0); PG8_BAR; PG8_MMA(1, 0, At, B0); PG8_MMA(1, 1, At, B1); PG8_BAR; PG8_SCHED;
            PG8_LDB(B0, 1, 0); PG8_LDB(B1, 1, 1); PG8_SCHED; PG8_LDA(At, 1, 0); PG8_STAGE(PG8_SA(0, 1), a2, w1);
            PG8_WAIT_V(8); PG8_WAIT_L(0); PG8_BAR; PG8_MMA(0, 0, At, B0); PG8_MMA(0, 1, At, B1); PG8_BAR; PG8_SCHED;
            PG8_LDA(At, 1, 1); PG8_STAGE(PG8_SB(1, 0), b3, voffB); PG8_STAGE(PG8_SB(1, 1), b3 + hstepB, voffB); PG8_STAGE(PG8_SA(1, 0), a3, w0);
            PG8_WAIT_V(8); PG8_WAIT_L(0); PG8_BAR; PG8_MMA(1, 0, At, B0); PG8_MMA(1, 1, At, B1); PG8_BAR; PG8_SCHED;
            } else {
            PG8_LDB(B0, 0, 0); PG8_SCHED; PG8_LDA(At, 0, 0); PG8_STAGE(PG8_SA(1, 1), a1, voA1);
            PG8_WAIT_L(8); PG8_BAR; PG8_WAIT_L(0); PG8_MMA(0, 0, At, B0); PG8_BAR; PG8_SCHED;
            PG8_LDB(B1, 0, 1); PG8_STAGE(PG8_SB(0, 0), b2, voffB);
            PG8_BAR; PG8_WAIT_L(0); PG8_MMA(0, 1, At, B1); PG8_BAR;
            PG8_LDA(At, 0, 1); PG8_STAGE(PG8_SA(0, 0), a2, w0);
            PG8_BAR; PG8_WAIT_L(0); PG8_MMA(1, 0, At, B0); PG8_BAR; PG8_SCHED;
            PG8_STAGE(PG8_SB(0, 1), b2 + hstepB, voffB);
            PG8_WAIT_V(6); PG8_BAR; PG8_MMA(1, 1, At, B1); PG8_BAR;
            PG8_LDB(B0, 1, 0); PG8_SCHED; PG8_LDA(At, 1, 0); PG8_STAGE(PG8_SA(0, 1), a2, w1);
            PG8_WAIT_L(8); PG8_BAR; PG8_WAIT_L(0); PG8_MMA(0, 0, At, B0); PG8_BAR; PG8_SCHED;
            PG8_LDB(B1, 1, 1); PG8_STAGE(PG8_SB(1, 0), b3, voffB);
            PG8_BAR; PG8_WAIT_L(0); PG8_MMA(0, 1, At, B1); PG8_BAR;
            PG8_LDA(At, 1, 1); PG8_STAGE(PG8_SA(1, 0), a3, w0);
            PG8_BAR; PG8_WAIT_L(0); PG8_MMA(1, 0, At, B0); PG8_BAR; PG8_SCHED;
            PG8_STAGE(PG8_SB(1, 1), b3 + hstepB, voffB);
            PG8_WAIT_V(6); PG8_BAR; PG8_MMA(1, 1, At, B1); PG8_BAR;
            }
        }
        if constexpr (ALIGN_EPI) { if (wr == 0) PG8_BAR; }
        if constexpr (!Epi::AFTER_DRAIN) { int fr_ = fr, fq_ = fq; asm volatile("" : "+v"(fr_), "+v"(fq_));
            epi_apply(E, acc, cur, wr, wc, fr_, fq_); }
        if (!has_next) break;
#pragma unroll
        for (int a = 0; a < 2; ++a)
#pragma unroll
            for (int b = 0; b < 2; ++b)
#pragma unroll
                for (int m = 0; m < 4; ++m)
#pragma unroll
                    for (int n = 0; n < 2; ++n) acc[a][b][m][n] = (f32x4){0.f, 0.f, 0.f, 0.f};
        cur = nxt; cA = nA; cB = nB; ++ui; cur.seq = ui;
        if constexpr (Sched::GATHER) {
#pragma unroll
            for (int i = 0; i < 2; ++i) { voA0[i] = nvA0[i]; voA1[i] = nvA1[i]; }
        }
        if constexpr (ALIGN_EPI) { if (wr == 1) PG8_BAR; }
    }
    PG8_WAIT_V(0);
    if constexpr (!ALIGN_EPI) { if (wr == 0) PG8_BAR; }
    PG8_BAR;
    if constexpr (Epi::AFTER_DRAIN) { int fr_ = fr, fq_ = fq, lane_ = lane; asm volatile("" : "+v"(fr_), "+v"(fq_), "+v"(lane_)); E.fused(acc, cur, wr, wc, fr_, fq_, lds, wid, lane_); }
#undef PG8_SA
#undef PG8_SB
#undef PG8_STAGE
#undef PG8_LDA
#undef PG8_LDB
#undef PG8_MMA
#undef PG8_WAIT_V
#undef PG8_WAIT_L
#undef PG8_BAR
#undef PG8_SCHED
}
}
using pg8::Unit;

struct DenseSched {
    static constexpr bool GATHER = false;
    const char* A; const char* Bt; unsigned lda, ldb; int nM, nN, ntk, G, c;
    __device__ __forceinline__ bool next(int i, Unit& u) const { return pg8::static_unit(i, G, c, nM, nN, u); }
    __device__ __forceinline__ int nt(const Unit&) const { return ntk; }
    __device__ __forceinline__ const char* a_base(const Unit& u) const { return A + (size_t)u.pm * 256 * lda; }
    __device__ __forceinline__ const char* b_base(const Unit& u) const { return Bt + (size_t)u.pn * 256 * ldb; }
    __device__ __forceinline__ unsigned a_rowoff(const Unit&, int) const { return 0; }
};
struct SsmSSched {
    static constexpr bool GATHER = false;
    const char* U; const char* W; unsigned lda, ldb; int G, c;
    __device__ __forceinline__ bool next(int i, Unit& u) const { const int L = i * G + c; if (L >= NG * SSM_RT) return false; u.aux = L / SSM_RT; u.pm = L % SSM_RT; u.pn = 0; u.kp = -1; return true; }
    __device__ __forceinline__ int nt(const Unit&) const { return NYC / 64; }
    __device__ __forceinline__ const char* a_base(const Unit& u) const { return U + ((size_t)(u.aux * NROWG + u.pm * 256) * UAW + 128) * 2; }
    __device__ __forceinline__ const char* b_base(const Unit& u) const { return W + (size_t)u.aux * 256 * NYC * 2; }
    __device__ __forceinline__ unsigned a_rowoff(const Unit&, int) const { return 0; }
};
struct SsmYSched {
    static constexpr bool GATHER = false;
    const char* U; const char* W; unsigned lda, ldb; int G, c;
    __device__ __forceinline__ bool next(int i, Unit& u) const { const int L = i * G + c; if (L >= NG * SSM_RT * SSM_CT) return false; const int rem = L % (NG * SSM_RT);
        u.pn = SSM_CT - 1 - L / (NG * SSM_RT); u.aux = rem / SSM_RT; u.pm = rem % SSM_RT; u.kp = -1; return true; }
    __device__ __forceinline__ int nt(const Unit& u) const { return 2 + 4 * (u.pn + 1); }
    __device__ __forceinline__ const char* a_base(const Unit& u) const { return U + (size_t)(u.aux * NROWG + u.pm * 256) * UAW * 2; }
    __device__ __forceinline__ const char* b_base(const Unit& u) const { return W + (size_t)(u.aux * NYC + u.pn * 256) * UAW * 2; }
    __device__ __forceinline__ unsigned a_rowoff(const Unit&, int) const { return 0; }
};
struct MoeSched {
    static constexpr bool GATHER = true;
    const char* A; const char* Bt; unsigned lda, ldb; size_t bstride; int nN, ntk, G, c;
    const int* tile_e; const int* slot_tok; const int* ntp;
    __device__ __forceinline__ bool next(int i, Unit& u) const { const int ntiles = *ntp; if (!pg8::static_unit(i, G, c, ntiles, nN, u)) return false; u.aux = tile_e[u.pm]; return true; }
    __device__ __forceinline__ int nt(const Unit&) const { return ntk; }
    __device__ __forceinline__ const char* a_base(const Unit&) const { return A; }
    __device__ __forceinline__ const char* b_base(const Unit& u) const { return Bt + (size_t)u.aux * bstride + (size_t)u.pn * 256 * ldb; }
    __device__ __forceinline__ unsigned a_rowoff(const Unit& u, int r) const { const int s = u.pm * 256 + r; if (slot_tok) { int t = slot_tok[s]; t = t < 0 ? 0 : t; return (unsigned)t * lda; } return (unsigned)s * lda; }
};

constexpr int KSPLIT = 7, MOE_LEFT_ROWS = 2048;
struct MoeDownSched {
    static constexpr bool GATHER = false;
    const char* A; const char* Bt; unsigned lda, ldb; size_t bstride; int G, c; const int* tile_e; const int* ntp;
    __device__ __forceinline__ bool next(int i, Unit& u) const { const int T = *ntp, Tm = T & ~63, nmain = Tm * 4, nmini = (T - Tm) * 4 * KSPLIT;
        const int nr = nmain > c ? (nmain - c + G - 1) / G : 0;
        if (i < nr) { pg8::static_unit(i, G, c, Tm, 4, u); u.aux = tile_e[u.pm]; return true; }
        const int j = (i - nr) * G + c; if (j >= nmini) return false;
        u.pm = Tm + j / (4 * KSPLIT); u.pn = (j / KSPLIT) & 3; u.kp = j % KSPLIT; u.aux = tile_e[u.pm]; return true; }
    __device__ __forceinline__ int nt(const Unit& u) const { return u.kp < 0 ? FFE / 64 : FFE / 64 / KSPLIT; }
    __device__ __forceinline__ const char* a_base(const Unit& u) const { return A + (size_t)u.pm * 256 * lda + (u.kp < 0 ? (size_t)0 : (size_t)u.kp * (FFE / KSPLIT) * 2); }
    __device__ __forceinline__ const char* b_base(const Unit& u) const { return Bt + (size_t)u.aux * bstride + (size_t)u.pn * 256 * ldb + (u.kp < 0 ? (size_t)0 : (size_t)u.kp * (FFE / KSPLIT) * 2); }
    __device__ __forceinline__ unsigned a_rowoff(const Unit&, int) const { return 0; }
};
static_assert((FFE / 64) % (2 * KSPLIT) == 0 && FFE / 64 / KSPLIT >= 4, "K-split parts: an even number of K-tiles, >= 4");

__device__ __forceinline__ v4u pack8(const f32x4& a, const f32x4& b) { v4u w; w.x = pk2(a[0], a[1]); w.y = pk2(a[2], a[3]); w.z = pk2(b[0], b[1]); w.w = pk2(b[2], b[3]); return w; }
struct EpiInProj {
    static constexpr bool PERM = true, AFTER_DRAIN = false; bf16* UA; bf16* PL;
    __device__ __forceinline__ void put8(const Unit& u, int r, int c, const f32x4& v0, const f32x4& v1) const {
        const int m = u.pm * 256 + r, col = u.pn * 256 + c; bf16* dst;
        if (col < 512) { const int g = col >> 4, hc = col & 15, b = m >> 12, l = m & 4095; dst = UA + ((size_t)(g * NROWG + b * NCH + l / TCH) * UAW + 128 + (l % TCH) * 16 + hc); }
        else dst = PL + (size_t)m * 512 + (col - 512);
        *(GAS v4u*)dst = pack8(v0, v1); }
};
struct EpiBf16 {
    static constexpr bool PERM = true, AFTER_DRAIN = false; bf16* O; int ldc;
    __device__ __forceinline__ void put8(const Unit& u, int r, int c, const f32x4& v0, const f32x4& v1) const { *(GAS v4u*)(O + (size_t)(u.pm * 256 + r) * ldc + u.pn * 256 + c) = pack8(v0, v1); }
};
constexpr int RS_OFF = pg8::STAGE_BYTES + 1024;
__device__ __forceinline__ void rs_begin(const float* SSp, const Unit& u, LAS unsigned char* lds, int tid) {
    if (tid < 256) { const GAS f32x4* p = (const GAS f32x4*)(SSp + (size_t)(u.pm * 256 + tid) * 16); const f32x4 a = p[0], b = p[1], c = p[2], d = p[3];
        const float ss = ((a[0] + a[1]) + (a[2] + a[3])) + ((b[0] + b[1]) + (b[2] + b[3])) + ((c[0] + c[1]) + (c[2] + c[3])) + ((d[0] + d[1]) + (d[2] + d[3]));
        ((LAS float*)(lds + RS_OFF + (u.seq & 1) * 2048))[tid] = 1.f / sqrtf(ss * (1.f / DM) + EPS); }
}
struct EpiInProjRs {
    static constexpr bool PERM = true, AFTER_DRAIN = false, BEGIN = true; bf16* UA; bf16* PL; const float* SSp; LAS unsigned char* L;
    __device__ __forceinline__ void unit_begin(const Unit& u, LAS unsigned char* lds, int tid) const { rs_begin(SSp, u, lds, tid); }
    __device__ __forceinline__ void put8(const Unit& u, int r, int c, const f32x4& v0, const f32x4& v1) const {
        const float q = ((const LAS float*)(L + RS_OFF + (u.seq & 1) * 2048))[r];
        const int m = u.pm * 256 + r, col = u.pn * 256 + c; bf16* dst;
        if (col < 512) { const int g = col >> 4, hc = col & 15, b = m >> 12, l = m & 4095; dst = UA + ((size_t)(g * NROWG + b * NCH + l / TCH) * UAW + 128 + (l % TCH) * 16 + hc); }
        else dst = PL + (size_t)m * 512 + (col - 512);
        *(GAS v4u*)dst = pack8(v0 * q, v1 * q); }
};
struct EpiSwigluRs {
    static constexpr bool PERM = true, AFTER_DRAIN = false, PAIR = true, BEGIN = true; bf16* ACT; int ldact; const float* SSp; LAS unsigned char* L;
    __device__ __forceinline__ void unit_begin(const Unit& u, LAS unsigned char* lds, int tid) const { rs_begin(SSp, u, lds, tid); }
    __device__ __forceinline__ void putpair(const Unit& u, int r, int c, const f32x4& g0_, const f32x4& g1_, const f32x4& u0_, const f32x4& u1_) const {
        const float q = ((const LAS float*)(L + RS_OFF + (u.seq & 1) * 2048))[r];
        const f32x4 g0 = g0_ * q, g1 = g1_ * q, u0 = u0_ * q, u1 = u1_ * q; f32x4 a, b;
#pragma unroll
        for (int j = 0; j < 4; ++j) { a[j] = g0[j] * sigmoidf_(g0[j]) * u0[j]; b[j] = g1[j] * sigmoidf_(g1[j]) * u1[j]; }
        *(GAS v4u*)(ACT + (size_t)(u.pm * 256 + r) * ldact + u.pn * 128 + c) = pack8(a, b); }
};
struct EpiGlu {
    static constexpr bool PERM = true, AFTER_DRAIN = false, CUSTOM = true; const bf16* YG; const float* bias; bf16* MIX; float* SS;
    __device__ __forceinline__ void apply(const f32x4 (&acc)[2][2][4][2], const Unit& u, int wr, int wc, int fr, int fq) const {
#pragma unroll
        for (int ai = 0; ai < 2; ++ai)
#pragma unroll
            for (int mi = 0; mi < 4; ++mi) { const int m = u.pm * 256 + ai * 128 + wr * 64 + mi * 16 + fr; float ssq = 0.f;
#pragma unroll
                for (int bj = 0; bj < 2; ++bj) { const int col = u.pn * 256 + bj * 128 + wc * 32 + 8 * fq; const f32x4& v0 = acc[ai][bj][mi][0]; const f32x4& v1 = acc[ai][bj][mi][1];
                    const v4u yw = *(const GAS v4u*)(YG + (size_t)m * 512 + col); const f32x4 b0 = *(const GAS f32x4*)(bias + col), b1 = *(const GAS f32x4*)(bias + col + 4);
                    f32x4 o0, o1; o0[0] = bflo(yw.x) * sigmoidf_(v0[0] + b0[0]); o0[1] = bfhi(yw.x) * sigmoidf_(v0[1] + b0[1]); o0[2] = bflo(yw.y) * sigmoidf_(v0[2] + b0[2]); o0[3] = bfhi(yw.y) * sigmoidf_(v0[3] + b0[3]);
                    o1[0] = bflo(yw.z) * sigmoidf_(v1[0] + b1[0]); o1[1] = bfhi(yw.z) * sigmoidf_(v1[1] + b1[1]); o1[2] = bflo(yw.w) * sigmoidf_(v1[2] + b1[2]); o1[3] = bfhi(yw.w) * sigmoidf_(v1[3] + b1[3]);
                    ssq += (o0[0] * o0[0] + o0[1] * o0[1]) + (o0[2] * o0[2] + o0[3] * o0[3]) + (o1[0] * o1[0] + o1[1] * o1[1]) + (o1[2] * o1[2] + o1[3] * o1[3]);
                    *(GAS v4u*)(MIX + (size_t)m * 1024 + col) = pack8(o0, o1); }
                ssq += __shfl_xor(ssq, 16); ssq += __shfl_xor(ssq, 32);
                if (fq == 0) ((GAS float*)SS)[(size_t)m * 16 + u.pn * 4 + wc] = ssq;
                asm volatile("" ::: "memory"); }
    }
};
struct EpiSsmY {
    static constexpr bool PERM = true, AFTER_DRAIN = false; bf16* YG;
    __device__ __forceinline__ void put8(const Unit& u, int r, int c, const f32x4& v0, const f32x4& v1) const {
        const int rr = u.pm * 256 + r, n = u.pn * 256 + c, tok = (rr / NCH) * SEQ + (rr % NCH) * TCH + (n >> 4);
        f32x4 a, b;
#pragma unroll
        for (int j = 0; j < 4; ++j) { a[j] = gelu_tanh(v0[j]); b[j] = gelu_tanh(v1[j]); }
        *(GAS v4u*)(YG + (size_t)tok * 512 + u.aux * 16 + (n & 15)) = pack8(a, b); }
};
struct EpiResid {
    static constexpr bool PERM = true, AFTER_DRAIN = false, CUSTOM = true; bf16* HB; float ascale; float* SSo;
    __device__ __forceinline__ void apply(const f32x4 (&acc)[2][2][4][2], const Unit& u, int wr, int wc, int fr, int fq) const {
        bf16* base = HB + (size_t)(u.pm * 256 + wr * 64 + fr) * DM + u.pn * 256 + wc * 32 + 8 * fq;
#pragma unroll
        for (int ai = 0; ai < 2; ++ai) { v4u rv[4][2];
#pragma unroll
            for (int m = 0; m < 4; ++m)
#pragma unroll
                for (int bj = 0; bj < 2; ++bj) rv[m][bj] = *(const GAS v4u*)(base + (size_t)(ai * 128 + m * 16) * DM + bj * 128);
#pragma unroll
            for (int m = 0; m < 4; ++m) { float ssq = 0.f;
#pragma unroll
                for (int bj = 0; bj < 2; ++bj) { const v4u x = rv[m][bj]; const f32x4 a0 = acc[ai][bj][m][0] * ascale, a1 = acc[ai][bj][m][1] * ascale; v4u w;
                    const f32x4 h0 = (f32x4){bflo(x.x), bfhi(x.x), bflo(x.y), bfhi(x.y)} + a0, h1 = (f32x4){bflo(x.z), bfhi(x.z), bflo(x.w), bfhi(x.w)} + a1;
                    ssq += ((h0[0] * h0[0] + h0[1] * h0[1]) + (h0[2] * h0[2] + h0[3] * h0[3])) + ((h1[0] * h1[0] + h1[1] * h1[1]) + (h1[2] * h1[2] + h1[3] * h1[3]));
                    w.x = pk2(h0[0], h0[1]); w.y = pk2(h0[2], h0[3]); w.z = pk2(h1[0], h1[1]); w.w = pk2(h1[2], h1[3]);
                    *(GAS v4u*)(base + (size_t)(ai * 128 + m * 16) * DM + bj * 128) = w; }
                ssq += __shfl_xor(ssq, 16); ssq += __shfl_xor(ssq, 32);
                if (fq == 0) ((GAS float*)SSo)[(size_t)(u.pm * 256 + ai * 128 + wr * 64 + m * 16 + fr) * 16 + u.pn * 4 + wc] = ssq; }
            asm volatile("" ::: "memory"); }
    }
};
struct EpiOutProj {
    static constexpr bool PERM = true, AFTER_DRAIN = false, CUSTOM = true, BEGIN = true; static constexpr int MID_T = 8; bf16* HB; const float* SS; float ascale; LAS unsigned char* L; float* SSo;
    __device__ __forceinline__ void unit_begin(const Unit& u, LAS unsigned char* lds, int tid) const {
        if (tid < 256) { const GAS f32x4* p = (const GAS f32x4*)(SS + (size_t)(u.pm * 256 + tid) * 16); const f32x4 a = p[0], b = p[1], c = p[2], d = p[3];
            const float ss = (a[0] + a[1]) + (a[2] + a[3]) + (b[0] + b[1]) + (b[2] + b[3]), sm = (c[0] + c[1]) + (c[2] + c[3]) + (d[0] + d[1]) + (d[2] + d[3]);
            const float rs = 1.f / sqrtf(ss * (1.f / 512) + EPS), rm = 1.f / sqrtf(sm * (1.f / 512) + EPS);
            ((LAS f32x2*)(lds + RS_OFF + (u.seq & 1) * 2048))[tid] = (f32x2){rs / rm, rm}; }
    }
    __device__ __forceinline__ void mid(f32x4 (&acc)[2][2][4][2], const Unit& u, int wr, int fr, LAS unsigned char* lds) const {
        const LAS f32x2* rsp = (const LAS f32x2*)(lds + RS_OFF + (u.seq & 1) * 2048);
#pragma unroll
        for (int ai = 0; ai < 2; ++ai)
#pragma unroll
            for (int m = 0; m < 4; ++m) { const float q = rsp[ai * 128 + wr * 64 + m * 16 + fr][0];
#pragma unroll
                for (int bj = 0; bj < 2; ++bj)
#pragma unroll
                    for (int n = 0; n < 2; ++n) acc[ai][bj][m][n] *= q; }
    }
    __device__ __forceinline__ void apply(const f32x4 (&acc)[2][2][4][2], const Unit& u, int wr, int wc, int fr, int fq) const {
        const LAS f32x2* rsp = (const LAS f32x2*)(L + RS_OFF + (u.seq & 1) * 2048);
        bf16* base = HB + (size_t)(u.pm * 256 + wr * 64 + fr) * DM + u.pn * 256 + wc * 32 + 8 * fq;
#pragma unroll
        for (int ai = 0; ai < 2; ++ai) { v4u rv[4][2];
#pragma unroll
            for (int m = 0; m < 4; ++m)
#pragma unroll
                for (int bj = 0; bj < 2; ++bj) rv[m][bj] = *(const GAS v4u*)(base + (size_t)(ai * 128 + m * 16) * DM + bj * 128);
#pragma unroll
            for (int m = 0; m < 4; ++m) { const float q = rsp[ai * 128 + wr * 64 + m * 16 + fr][1] * ascale; float ssq = 0.f;
#pragma unroll
                for (int bj = 0; bj < 2; ++bj) { const v4u x = rv[m][bj]; const f32x4 a0 = acc[ai][bj][m][0] * q, a1 = acc[ai][bj][m][1] * q; v4u w;
                    const f32x4 h0 = (f32x4){bflo(x.x), bfhi(x.x), bflo(x.y), bfhi(x.y)} + a0, h1 = (f32x4){bflo(x.z), bfhi(x.z), bflo(x.w), bfhi(x.w)} + a1;
                    ssq += ((h0[0] * h0[0] + h0[1] * h0[1]) + (h0[2] * h0[2] + h0[3] * h0[3])) + ((h1[0] * h1[0] + h1[1] * h1[1]) + (h1[2] * h1[2] + h1[3] * h1[3]));
                    w.x = pk2(h0[0], h0[1]); w.y = pk2(h0[2], h0[3]); w.z = pk2(h1[0], h1[1]); w.w = pk2(h1[2], h1[3]);
                    *(GAS v4u*)(base + (size_t)(ai * 128 + m * 16) * DM + bj * 128) = w; }
                ssq += __shfl_xor(ssq, 16); ssq += __shfl_xor(ssq, 32);
                if (fq == 0) ((GAS float*)SSo)[(size_t)(u.pm * 256 + ai * 128 + wr * 64 + m * 16 + fr) * 16 + u.pn * 4 + wc] = ssq; }
            asm volatile("" ::: "memory"); }
    }
};
struct EpiSwiglu {
    static constexpr bool PERM = true, AFTER_DRAIN = false, PAIR = true; bf16* ACT; int ldact;
    __device__ __forceinline__ void putpair(const Unit& u, int r, int c, const f32x4& g0, const f32x4& g1, const f32x4& u0, const f32x4& u1) const {
        f32x4 a, b;
#pragma unroll
        for (int j = 0; j < 4; ++j) { a[j] = g0[j] * sigmoidf_(g0[j]) * u0[j]; b[j] = g1[j] * sigmoidf_(g1[j]) * u1[j]; }
        *(GAS v4u*)(ACT + (size_t)(u.pm * 256 + r) * ldact + u.pn * 128 + c) = pack8(a, b); }
};
template <bool FINAL> struct EpiMoeDown {
    static constexpr bool PERM = true, AFTER_DRAIN = false, CUSTOM = true; const int* slot_tok; const float* slot_w; bf16* HB; float* out; float ascale; const int* ntp; bf16* PART;
    __device__ __forceinline__ void apply(const f32x4 (&acc)[2][2][4][2], const Unit& u, int wr, int wc, int fr, int fq) const {
        int tok[2][4]; float w[2][4]; const int s0 = u.pm * 256 + wr * 64 + fr;
        const int Tm = (*ntp) & ~63;
#pragma unroll
        for (int ai = 0; ai < 2; ++ai)
#pragma unroll
            for (int m = 0; m < 4; ++m) { tok[ai][m] = ((const GAS int*)slot_tok)[s0 + ai * 128 + m * 16]; w[ai][m] = ((const GAS float*)slot_w)[s0 + ai * 128 + m * 16] * ascale; }
        const int cb = u.pn * 256 + wc * 32 + 8 * fq;
        if (u.kp >= 0) {
            bf16* pb = PART + ((size_t)u.kp * MOE_LEFT_ROWS + (size_t)(u.pm - Tm) * 256 + wr * 64 + fr) * DM + cb;
#pragma unroll
            for (int ai = 0; ai < 2; ++ai)
#pragma unroll
                for (int m = 0; m < 4; ++m)
#pragma unroll
                    for (int bj = 0; bj < 2; ++bj) *(GAS v4u*)(pb + (size_t)(ai * 128 + m * 16) * DM + bj * 128) = pack8(acc[ai][bj][m][0] * w[ai][m], acc[ai][bj][m][1] * w[ai][m]);
            return; }
#pragma unroll
        for (int ai = 0; ai < 2; ++ai) { v4u rv[4][2];
#pragma unroll
            for (int m = 0; m < 4; ++m) { const int t = tok[ai][m] < 0 ? 0 : tok[ai][m];
#pragma unroll
                for (int bj = 0; bj < 2; ++bj) rv[m][bj] = *(const GAS v4u*)(HB + (size_t)t * DM + cb + bj * 128); }
#pragma unroll
            for (int m = 0; m < 4; ++m) { if (tok[ai][m] < 0) continue;
#pragma unroll
                for (int bj = 0; bj < 2; ++bj) { const v4u x = rv[m][bj]; const f32x4 a0 = acc[ai][bj][m][0] * w[ai][m], a1 = acc[ai][bj][m][1] * w[ai][m];
                    const f32x4 r0 = {bflo(x.x) + a0[0], bfhi(x.x) + a0[1], bflo(x.y) + a0[2], bfhi(x.y) + a0[3]}, r1 = {bflo(x.z) + a1[0], bfhi(x.z) + a1[1], bflo(x.w) + a1[2], bfhi(x.w) + a1[3]};
                    if constexpr (FINAL) { GAS f32x4* o = (GAS f32x4*)(out + (size_t)tok[ai][m] * DM + cb + bj * 128); o[0] = r0; o[1] = r1; }
                    else *(GAS v4u*)(HB + (size_t)tok[ai][m] * DM + cb + bj * 128) = pack8(r0, r1); } }
            asm volatile("" ::: "memory"); }
    }
};
struct EpiSsmS {
    static constexpr bool PERM = false, AFTER_DRAIN = true; bf16* UA; const float* aT;
    __device__ __forceinline__ void fused(const f32x4 (&acc)[2][2][4][2], const Unit& u, int wr, int wc, int fr, int fq, LAS unsigned char* lds, int wid, int lane) const {
        LAS float* T = (LAS float*)lds;
#pragma unroll
        for (int ai = 0; ai < 2; ++ai)
#pragma unroll
            for (int m = 0; m < 4; ++m) { const int r = ai * 128 + wr * 64 + m * 16 + fr;
#pragma unroll
                for (int n = 0; n < 2; ++n) *(LAS f32x4*)(T + r * 128 + wc * 32 + 16 * n + 4 * fq) = acc[ai][0][m][n]; }
        LDS_WAIT(); __builtin_amdgcn_s_barrier(); asm volatile("" ::: "memory");
        const int tid = wid * 64 + lane;
        if (tid < 64 * (256 / NCH)) { const int bl = tid >> 6, p = tid & 63, g = u.aux; const float ar = aT[(g * 64 + p) * 2], ai_ = aT[(g * 64 + p) * 2 + 1]; float sr = 0.f, si = 0.f;
            bf16* dst = UA + (size_t)(g * NROWG + u.pm * 256 + bl * NCH) * UAW;
            for (int c = 0; c < NCH; ++c) { dst[(size_t)c * UAW + p] = f2bf(sr); dst[(size_t)c * UAW + 64 + p] = f2bf(si);
                const float lr = T[(bl * NCH + c) * 128 + p], li = T[(bl * NCH + c) * 128 + 64 + p]; const float nr = ar * sr - ai_ * si + lr, ni = ar * si + ai_ * sr + li; sr = nr; si = ni; } }
        LDS_WAIT(); __builtin_amdgcn_s_barrier(); asm volatile("" ::: "memory");
    }
};

struct RmId { int off; __device__ __forceinline__ int operator()(int n) const { return off + n; } };
struct RmGU { int up; __device__ __forceinline__ int operator()(int n) const { return 256 * (n >> 7) + 128 * up + (n & 127); } };
struct KgNone { __device__ __forceinline__ float operator()(int) const { return 1.f; } };
struct KgVec { const float* g; __device__ __forceinline__ float operator()(int k) const { return ((const GAS float*)g)[k]; } };
struct KgOut { const float* gs; const float* gm; __device__ __forceinline__ float operator()(int k) const { return k < 512 ? ((const GAS float*)gs)[k] : ((const GAS float*)gm)[k - 512]; } };
template <class RowMap, class KG = KgNone> __device__ __forceinline__ void tr_matrix(const float* W, int K, int N, bf16* WT, int ldt, RowMap rm, LAS float* scr, int gw, int NGW, int lane, KG kg = KG()) { asm volatile("" : "+v"(lane));
    const int nnb = N / 32, items = (K / 64) * nnb; const int rr = lane >> 3, c4 = (lane & 7) * 4, c = lane & 7;
    int it = gw; if (it >= items) return;
    f32x4 v[8];
#pragma unroll
    for (int i = 0; i < 8; ++i) v[i] = *(const GAS f32x4*)(W + (size_t)(64 * (it / nnb) + 8 * i + rr) * N + 32 * (it % nnb) + c4);
    for (;;) {
        const int k0 = 64 * (it / nnb), n0 = 32 * (it % nnb), nx = it + NGW; const bool more = nx < items;
#pragma unroll
        for (int i = 0; i < 8; ++i) { LAS float* d = scr + (8 * i + rr) * 33 + c4; const float g_ = kg(k0 + 8 * i + rr); d[0] = v[i][0] * g_; d[1] = v[i][1] * g_; d[2] = v[i][2] * g_; d[3] = v[i][3] * g_; }
        if (more) {
#pragma unroll
            for (int i = 0; i < 8; ++i) v[i] = *(const GAS f32x4*)(W + (size_t)(64 * (nx / nnb) + 8 * i + rr) * N + 32 * (nx % nnb) + c4); }
        LDS_WAIT(); asm volatile("" ::: "memory");
#pragma unroll
        for (int j = 0; j < 4; ++j) { const int n = (lane >> 3) + 8 * j; const LAS float* sp = scr + (8 * c) * 33 + n;
            v4u o; o.x = pk2(sp[0 * 33], sp[1 * 33]); o.y = pk2(sp[2 * 33], sp[3 * 33]); o.z = pk2(sp[4 * 33], sp[5 * 33]); o.w = pk2(sp[6 * 33], sp[7 * 33]);
            *(GAS v4u*)(WT + (size_t)rm(n0 + n) * ldt + k0 + 8 * c) = o; }
        LDS_WAIT(); asm volatile("" ::: "memory");
        if (!more) break; it = nx;
    }
}
__device__ __forceinline__ void zero_bf16(bf16* p, size_t n8  , int gtid, int gthreads) { asm volatile("" : "+v"(gtid)); for (size_t i = gtid; i < n8; i += gthreads) ((v4u*)p)[i] = (v4u){0u, 0u, 0u, 0u}; }

__device__ __forceinline__ void conv_small(unsigned char* ws_, int layer, LAS float* scr, int gw, int NGW, int lane, int gtid, int gthreads) {
    unsigned char* wb = ws_ + WS_WSMALL + (size_t)layer * WSM_STRIDE;
    bf16* Win_t = (bf16*)(wb + WSM_IN); bf16* Wglu_t = (bf16*)(wb + WSM_GLU); bf16* Wq_t = (bf16*)(wb + WSM_Q); bf16* Wkv_t = (bf16*)(wb + WSM_KV); bf16* Wout_t = (bf16*)(wb + WSM_OUT);
    tr_matrix(kin(I_W_IN) + (size_t)layer * DM * DIN, DM, DIN, Win_t, DM, RmId{0}, scr, gw, NGW, lane, KgVec{kin(I_ATTN_NORM) + layer * DM});
    zero_bf16(Win_t + (size_t)DIN * DM, (size_t)(1024 - DIN) * DM / 8, gtid, gthreads);
    tr_matrix(kin(I_W_GLU) + (size_t)layer * DSSM * DSSM, DSSM, DSSM, Wglu_t, DSSM, RmId{0}, scr, gw, NGW, lane);
    tr_matrix(kin(I_W_Q_UP) + (size_t)layer * QRANK * 768, QRANK, 768, Wq_t, QRANK, RmId{0}, scr, gw, NGW, lane);
    tr_matrix(kin(I_W_KV_UP) + (size_t)layer * KVRANK * 1024, KVRANK, 1024, Wkv_t, 256, RmId{0}, scr, gw, NGW, lane);
    asm volatile("" : "+v"(gtid));
    for (int i = gtid; i < 1024 * 16; i += gthreads) ((v4u*)(Wkv_t + (size_t)(i >> 4) * 256 + 128))[i & 15] = (v4u){0u, 0u, 0u, 0u};
    tr_matrix(kin(I_W_OUT) + (size_t)layer * DM * DM, DM, DM, Wout_t, DM, RmId{0}, scr, gw, NGW, lane, KgOut{kin(I_SSM_OUT_NORM) + layer * DSSM, kin(I_MLA_OUT_NORM) + layer * DSSM});
}
__device__ __forceinline__ void conv_dense(unsigned char* ws_, LAS float* scr, int gw, int NGW, int lane) {
    bf16* Wgu = (bf16*)(ws_ + WS_BIGW + BW_DGU); bf16* Wd = (bf16*)(ws_ + WS_BIGW + BW_DD);
    tr_matrix(kin(I_DW_GATE), DM, FFD, Wgu, DM, RmGU{0}, scr, gw, NGW, lane, KgVec{kin(I_FFN_NORM)});
    tr_matrix(kin(I_DW_UP), DM, FFD, Wgu, DM, RmGU{1}, scr, gw, NGW, lane, KgVec{kin(I_FFN_NORM)});
    tr_matrix(kin(I_DW_DOWN), FFD, DM, Wd, FFD, RmId{0}, scr, gw, NGW, lane);
}
__device__ __forceinline__ void conv_moe(unsigned char* ws_, LAS float* scr, int gw, int NGW, int lane) {
    bf16* Wgu = (bf16*)(ws_ + WS_BIGW + BW_MGU); bf16* Wd = (bf16*)(ws_ + WS_BIGW + BW_MD);
    for (int e = 0; e < NE; ++e) {
        tr_matrix(kin(I_MW_GATE) + (size_t)e * DM * FFE, DM, FFE, Wgu + (size_t)e * 2 * FFE * DM, DM, RmGU{0}, scr, gw, NGW, lane);
        tr_matrix(kin(I_MW_UP) + (size_t)e * DM * FFE, DM, FFE, Wgu + (size_t)e * 2 * FFE * DM, DM, RmGU{1}, scr, gw, NGW, lane);
        tr_matrix(kin(I_MW_DOWN) + (size_t)e * FFE * DM, FFE, DM, Wd + (size_t)e * DM * FFE, FFE, RmId{0}, scr, gw, NGW, lane);
    }
}
__device__ __forceinline__ void rms_row(const float* xrow, const float* g, bf16* orow, int lane) {
    const GAS f32x4* xr = (const GAS f32x4*)xrow + lane; const GAS f32x4* gr = (const GAS f32x4*)g + lane; f32x4 v[4]; float s = 0.f;
#pragma unroll
    for (int j = 0; j < 4; ++j) { v[j] = xr[64 * j]; s += (v[j][0] * v[j][0] + v[j][1] * v[j][1]) + (v[j][2] * v[j][2] + v[j][3] * v[j][3]); }
    const float rstd = 1.f / sqrtf(wave_sum(s) * (1.f / DM) + EPS);
    GAS v2u* o8 = (GAS v2u*)orow + lane;
#pragma unroll
    for (int j = 0; j < 4; ++j) { const f32x4 gg = gr[64 * j]; v2u w; w.x = pk2(v[j][0] * rstd * gg[0], v[j][1] * rstd * gg[1]); w.y = pk2(v[j][2] * rstd * gg[2], v[j][3] * rstd * gg[3]); o8[64 * j] = w; }
}
__device__ __forceinline__ void rms_row_b(const bf16* xrow, const float* g, bf16* orow, int lane) {
    const v4u a = *((const GAS v4u*)xrow + lane), b = *((const GAS v4u*)xrow + 64 + lane);
    float v[16] = {bflo(a.x), bfhi(a.x), bflo(a.y), bfhi(a.y), bflo(a.z), bfhi(a.z), bflo(a.w), bfhi(a.w), bflo(b.x), bfhi(b.x), bflo(b.y), bfhi(b.y), bflo(b.z), bfhi(b.z), bflo(b.w), bfhi(b.w)}; float s = 0.f;
#pragma unroll
    for (int j = 0; j < 16; ++j) s += v[j] * v[j];
    const float rstd = 1.f / sqrtf(wave_sum(s) * (1.f / DM) + EPS);
    const f32x4 g0 = *((const GAS f32x4*)g + 2 * lane), g1 = *((const GAS f32x4*)g + 2 * lane + 1), g2 = *((const GAS f32x4*)g + 128 + 2 * lane), g3 = *((const GAS f32x4*)g + 128 + 2 * lane + 1);
    v4u w; w.x = pk2(v[0] * rstd * g0[0], v[1] * rstd * g0[1]); w.y = pk2(v[2] * rstd * g0[2], v[3] * rstd * g0[3]); w.z = pk2(v[4] * rstd * g1[0], v[5] * rstd * g1[1]); w.w = pk2(v[6] * rstd * g1[2], v[7] * rstd * g1[3]);
    *((GAS v4u*)orow + lane) = w;
    w.x = pk2(v[8] * rstd * g2[0], v[9] * rstd * g2[1]); w.y = pk2(v[10] * rstd * g2[2], v[11] * rstd * g2[3]); w.z = pk2(v[12] * rstd * g3[0], v[13] * rstd * g3[1]); w.w = pk2(v[14] * rstd * g3[2], v[15] * rstd * g3[3]);
    *((GAS v4u*)orow + 64 + lane) = w;
}
__device__ __forceinline__ void ph_rmsnorm_b(const bf16* HB, const float* g, bf16* Z, int gw, int NGW, int lane) { asm volatile("" : "+v"(lane)); for (int m = gw; m < M; m += NGW) rms_row_b(HB + (size_t)m * DM, g, Z + (size_t)m * DM, lane); }
__device__ __forceinline__ void ph_x2hb(const float* x, bf16* HB, float* SSo, int gw, int NGW, int lane) { asm volatile("" : "+v"(lane));
    for (int m = gw; m < M; m += NGW) { const GAS f32x4* xr = (const GAS f32x4*)(x + (size_t)m * DM) + lane; f32x4 v[4]; float s = 0.f;
#pragma unroll
        for (int j = 0; j < 4; ++j) { v[j] = xr[64 * j]; s += (v[j][0] * v[j][0] + v[j][1] * v[j][1]) + (v[j][2] * v[j][2] + v[j][3] * v[j][3]); }
        s = wave_sum(s);
        GAS v2u* h8 = (GAS v2u*)(HB + (size_t)m * DM) + lane;
#pragma unroll
        for (int j = 0; j < 4; ++j) { v2u hw; hw.x = pk2(v[j][0], v[j][1]); hw.y = pk2(v[j][2], v[j][3]); h8[64 * j] = hw; }
        if (lane < 4) ((GAS f32x4*)(SSo + (size_t)m * 16))[lane] = (f32x4){lane == 0 ? s : 0.f, 0.f, 0.f, 0.f}; }
}
__device__ __forceinline__ void ph_rmsnorm(const float* h, const float* g, bf16* Z, int gw, int NGW, int lane) { asm volatile("" : "+v"(lane)); for (int m = gw; m < M; m += NGW) rms_row(h + (size_t)m * DM, g, Z + (size_t)m * DM, lane); }
__device__ __forceinline__ void ph_latnorm(const bf16* PL, const float* gq, const float* gkv, bf16* LAT, int gw, int NGW, int lane) { asm volatile("" : "+v"(lane));
    constexpr int R = 4;
    const f32x4 g4 = *((const GAS f32x4*)gq + lane); const f32x2 g2 = *((const GAS f32x2*)gkv + lane);
    for (int mb = gw * R; mb < M; mb += NGW * R) { v2u qa[R]; unsigned ka[R];
#pragma unroll
        for (int r = 0; r < R; ++r) { qa[r] = *((const GAS v2u*)(PL + (size_t)(mb + r) * 512) + lane); ka[r] = *((const GAS unsigned*)(PL + (size_t)(mb + r) * 512 + 256) + lane); }
#pragma unroll
        for (int r = 0; r < R; ++r) { const int m = mb + r;
            const float q0 = bflo(qa[r].x), q1 = bfhi(qa[r].x), q2 = bflo(qa[r].y), q3 = bfhi(qa[r].y), k0 = bflo(ka[r]), k1 = bfhi(ka[r]);
            const float rq = 1.f / sqrtf(wave_sum(q0 * q0 + q1 * q1 + q2 * q2 + q3 * q3) * (1.f / 256) + EPS), rk = 1.f / sqrtf(wave_sum(k0 * k0 + k1 * k1) * (1.f / 128) + EPS);
            v2u w; w.x = pk2(q0 * rq * g4[0], q1 * rq * g4[1]); w.y = pk2(q2 * rq * g4[2], q3 * rq * g4[3]); *((GAS v2u*)(LAT + (size_t)m * 512) + lane) = w;
            *((GAS unsigned*)(LAT + (size_t)m * 512 + 256) + lane) = pk2(k0 * rk * g2[0], k1 * rk * g2[1]); *((GAS unsigned*)(LAT + (size_t)m * 512 + 384) + lane) = 0u; } }
}
constexpr float QSCALE = 0.10206207261596575f * 1.4426950408889634f;
__device__ __forceinline__ void ph_qkprep(bf16* QR, const bf16* KVR, const bf16* PL, bf16* KN, const float* qg, const float* kg, int gw, int NGW, int lane) { asm volatile("" : "+v"(lane));
    const int hd = lane >> 3, sub = lane & 7;
    float gq[12], gk[12];
#pragma unroll
    for (int j = 0; j < 8; ++j) { gq[j] = ((const GAS float*)qg)[sub * 8 + j]; gk[j] = ((const GAS float*)kg)[sub * 8 + j]; }
#pragma unroll
    for (int j = 0; j < 2; ++j) { gq[8 + j] = ((const GAS float*)qg)[64 + sub * 2 + j]; gq[10 + j] = ((const GAS float*)qg)[80 + sub * 2 + j]; gk[8 + j] = ((const GAS float*)kg)[64 + sub * 2 + j]; gk[10 + j] = ((const GAS float*)kg)[80 + sub * 2 + j]; }
    const float ir0 = exp2f(-(float)(sub * 2) * (13.287712379549449f / 16.f)) * 0.15915494309189535f, ir1 = exp2f(-(float)(sub * 2 + 1) * (13.287712379549449f / 16.f)) * 0.15915494309189535f;
    constexpr int R = 4;
    for (int mb = gw * R; mb < M; mb += NGW * R) { v4u qn[R], kn[R]; unsigned qx1[R], qx2[R], kx1[R], kx2[R];
#pragma unroll
        for (int r = 0; r < R; ++r) { const int m = mb + r; const bf16* qp = QR + (size_t)m * 768 + hd * 96; const bf16* kp = KVR + (size_t)m * 1024 + hd * 128; const bf16* rp = PL + (size_t)m * 512 + 384;
            qn[r] = *(const GAS v4u*)(qp + sub * 8); qx1[r] = *(const GAS unsigned*)(qp + 64 + sub * 2); qx2[r] = *(const GAS unsigned*)(qp + 80 + sub * 2);
            kn[r] = *(const GAS v4u*)(kp + sub * 8); kx1[r] = *(const GAS unsigned*)(rp + sub * 2); kx2[r] = *(const GAS unsigned*)(rp + 16 + sub * 2); }
#pragma unroll
        for (int r = 0; r < R; ++r) { const int m = mb + r; const int pos = m & (SEQ - 1);
            const float a0 = __builtin_amdgcn_fractf((float)pos * ir0), a1 = __builtin_amdgcn_fractf((float)pos * ir1);
            const float s0 = __builtin_amdgcn_sinf(a0), c0 = __builtin_amdgcn_cosf(a0), s1 = __builtin_amdgcn_sinf(a1), c1 = __builtin_amdgcn_cosf(a1);
            float q[12] = {bflo(qn[r].x), bfhi(qn[r].x), bflo(qn[r].y), bfhi(qn[r].y), bflo(qn[r].z), bfhi(qn[r].z), bflo(qn[r].w), bfhi(qn[r].w), bflo(qx1[r]), bfhi(qx1[r]), bflo(qx2[r]), bfhi(qx2[r])};
            float k[12] = {bflo(kn[r].x), bfhi(kn[r].x), bflo(kn[r].y), bfhi(kn[r].y), bflo(kn[r].z), bfhi(kn[r].z), bflo(kn[r].w), bfhi(kn[r].w), bflo(kx1[r]), bfhi(kx1[r]), bflo(kx2[r]), bfhi(kx2[r])};
            float sq = 0.f, sk = 0.f;
#pragma unroll
            for (int j = 0; j < 12; ++j) { sq += q[j] * q[j]; sk += k[j] * k[j]; }
            sq += __shfl_xor(sq, 1); sq += __shfl_xor(sq, 2); sq += __shfl_xor(sq, 4); sk += __shfl_xor(sk, 1); sk += __shfl_xor(sk, 2); sk += __shfl_xor(sk, 4);
            const float rq = QSCALE / sqrtf(sq * (1.f / 96) + EPS), rk = 1.f / sqrtf(sk * (1.f / 96) + EPS);
#pragma unroll
            for (int j = 0; j < 12; ++j) { q[j] *= rq * gq[j]; k[j] *= rk * gk[j]; }
            const float qa0 = q[8] * c0 - q[10] * s0, qb0 = q[8] * s0 + q[10] * c0, qa1 = q[9] * c1 - q[11] * s1, qb1 = q[9] * s1 + q[11] * c1;
            const float ka0 = k[8] * c0 - k[10] * s0, kb0 = k[8] * s0 + k[10] * c0, ka1 = k[9] * c1 - k[11] * s1, kb1 = k[9] * s1 + k[11] * c1;
            bf16* qp = QR + (size_t)m * 768 + hd * 96; bf16* ko = KN + (size_t)m * 768 + hd * 96;
            v4u w; w.x = pk2(q[0], q[1]); w.y = pk2(q[2], q[3]); w.z = pk2(q[4], q[5]); w.w = pk2(q[6], q[7]);
            *(GAS v4u*)(qp + sub * 8) = w; *(GAS unsigned*)(qp + 64 + sub * 2) = pk2(qa0, qa1); *(GAS unsigned*)(qp + 80 + sub * 2) = pk2(qb0, qb1);
            w.x = pk2(k[0], k[1]); w.y = pk2(k[2], k[3]); w.z = pk2(k[4], k[5]); w.w = pk2(k[6], k[7]);
            *(GAS v4u*)(ko + sub * 8) = w; *(GAS unsigned*)(ko + 64 + sub * 2) = pk2(ka0, ka1); *(GAS unsigned*)(ko + 80 + sub * 2) = pk2(kb0, kb1); } }
}
__device__ __forceinline__ void ph_outnorm(bf16* MIX, const float* gs, const float* gm, int gw, int NGW, int lane) { asm volatile("" : "+v"(lane));
    for (int m = gw; m < M; m += NGW) { v4u* rp = (v4u*)(MIX + (size_t)m * 1024) + 2 * lane;
        const v4u a = rp[0], b = rp[1]; float v[16] = {bflo(a.x), bfhi(a.x), bflo(a.y), bfhi(a.y), bflo(a.z), bfhi(a.z), bflo(a.w), bfhi(a.w), bflo(b.x), bfhi(b.x), bflo(b.y), bfhi(b.y), bflo(b.z), bfhi(b.z), bflo(b.w), bfhi(b.w)}; float s = 0.f;
#pragma unroll
        for (int j = 0; j < 16; ++j) s += v[j] * v[j];
#pragma unroll
        for (int o = 1; o < 32; o <<= 1) s += __shfl_xor(s, o);
        const float rstd = 1.f / sqrtf(s * (1.f / 512) + EPS); const float* g = (lane < 32 ? gs : gm) + (lane & 31) * 16;
#pragma unroll
        for (int j = 0; j < 16; ++j) v[j] *= rstd * g[j];
        v4u w; w.x = pk2(v[0], v[1]); w.y = pk2(v[2], v[3]); w.z = pk2(v[4], v[5]); w.w = pk2(v[6], v[7]); rp[0] = w;
        w.x = pk2(v[8], v[9]); w.y = pk2(v[10], v[11]); w.z = pk2(v[12], v[13]); w.w = pk2(v[14], v[15]); rp[1] = w; }
}
__device__ __forceinline__ void ph_norm_route(const bf16* HB, const float* g, const float* Wr, bf16* Z, v4u* route, int gw, int NGW, int lane) { asm volatile("" : "+v"(lane));
    float gg[16], wg[16][8];
#pragma unroll
    for (int j = 0; j < 4; ++j) { const f32x4 g4 = *((const GAS f32x4*)g + 64 * j + lane);
#pragma unroll
        for (int q = 0; q < 4; ++q) { gg[4 * j + q] = g4[q]; const GAS f32x4* wr = (const GAS f32x4*)(Wr + (size_t)(256 * j + 4 * lane + q) * 8); const f32x4 wa = wr[0], wb = wr[1];
#pragma unroll
            for (int e = 0; e < 4; ++e) { wg[4 * j + q][e] = wa[e] * g4[q]; wg[4 * j + q][4 + e] = wb[e] * g4[q]; } } }
    constexpr int R = 2;
    for (int mb = gw * R; mb < M; mb += NGW * R) { v2u x[R][4];
#pragma unroll
        for (int r = 0; r < R; ++r)
#pragma unroll
            for (int j = 0; j < 4; ++j) x[r][j] = *((const GAS v2u*)(HB + (size_t)(mb + r) * DM) + 64 * j + lane);
#pragma unroll
        for (int r = 0; r < R; ++r) { const int m = mb + r; float v[16]; float s = 0.f;
#pragma unroll
            for (int j = 0; j < 4; ++j) { v[4 * j] = bflo(x[r][j].x); v[4 * j + 1] = bfhi(x[r][j].x); v[4 * j + 2] = bflo(x[r][j].y); v[4 * j + 3] = bfhi(x[r][j].y); }
#pragma unroll
            for (int i = 0; i < 16; ++i) s += v[i] * v[i];
            const float rstd = 1.f / sqrtf(wave_sum(s) * (1.f / DM) + EPS);
            float lg[8] = {0.f, 0.f, 0.f, 0.f, 0.f, 0.f, 0.f, 0.f};
#pragma unroll
            for (int i = 0; i < 16; ++i)
#pragma unroll
                for (int e = 0; e < 8; ++e) lg[e] += v[i] * wg[i][e];
#pragma unroll
            for (int j = 0; j < 4; ++j) { v2u w; w.x = pk2(v[4 * j] * rstd * gg[4 * j], v[4 * j + 1] * rstd * gg[4 * j + 1]); w.y = pk2(v[4 * j + 2] * rstd * gg[4 * j + 2], v[4 * j + 3] * rstd * gg[4 * j + 3]); *((GAS v2u*)(Z + (size_t)m * DM) + 64 * j + lane) = w; }
#pragma unroll
            for (int e = 0; e < 8; ++e) lg[e] = wave_sum(lg[e]) * rstd;
            int e0 = 0; float v0 = lg[0];
#pragma unroll
            for (int e = 1; e < 8; ++e) if (lg[e] > v0) { v0 = lg[e]; e0 = e; }
            int e1 = -1; float v1 = -3.0e38f;
#pragma unroll
            for (int e = 0; e < 8; ++e) if (e != e0 && lg[e] > v1) { v1 = lg[e]; e1 = e; }
            const float w1 = 1.f / (1.f + expf(v0 - v1)), w0 = 1.f - w1;
            if (lane == 0) { ((GAS v2u*)route)[m] = (v2u){(unsigned)e0, (unsigned)e1}; ((GAS f32x2*)((unsigned char*)route + 256 * 1024))[m] = (f32x2){w0, w1}; } } }
}
__device__ __forceinline__ void ph_route_sort(const v4u* route, unsigned char* rt, LAS unsigned char* lds, int tid) { asm volatile("" : "+v"(tid));
    int* slot_tok = (int*)(rt + RT_SLOT_TOK); float* slot_w = (float*)(rt + RT_SLOT_W); int* tile_e = (int*)(rt + RT_TILE_E); int* ntl = (int*)(rt + RT_NTILES);
    const v2u* re = (const v2u*)route; const f32x2* rw = (const f32x2*)((const unsigned char*)route + 256 * 1024);
    LAS int* wtot = (LAS int*)lds;
    LAS int* wbase = wtot + 128;
    LAS int* etot = wbase + 128;
    const int lane = tid & 63, w = tid >> 6;
    int c[16];
#pragma unroll
    for (int j = 0; j < 16; ++j) c[j] = 0;
    for (int i = 0; i < 64; ++i) { const v2u r = re[w * 4096 + i * 64 + lane];
#pragma unroll
        for (int j = 0; j < 8; ++j) { c[j] += __popcll(__ballot(r.x == (unsigned)j)); c[8 + j] += __popcll(__ballot(r.y == (unsigned)j)); } }
    if (lane == 0) {
#pragma unroll
        for (int j = 0; j < 16; ++j) wtot[w * 16 + j] = c[j]; }
    __syncthreads();
    if (tid < 16) { int s = 0; for (int ww = 0; ww < 8; ++ww) { wbase[ww * 16 + tid] = s; s += wtot[ww * 16 + tid]; } etot[tid] = s; }
    __syncthreads();
    if (tid < 2) { int off = 0; for (int e = 0; e < 8; ++e) { const int n = etot[tid * 8 + e]; const int pad = (n + 255) & ~255; etot[16 + tid * 8 + e] = off;
            for (int t = off / 256; t < (off + pad) / 256; ++t) tile_e[tid * MOE_TILES + t] = e; off += pad; } ntl[tid] = off / 256; }
    __syncthreads();
    for (int j = 0; j < 16; ++j) { const int n = etot[j], off = etot[16 + j], pad = (n + 255) & ~255, k = j >> 3; for (int s = off + n + tid; s < off + pad; s += 512) { slot_tok[k * MOE_SLOTS + s] = -1; slot_w[k * MOE_SLOTS + s] = 0.f; } }
#pragma unroll
    for (int j = 0; j < 16; ++j) c[j] = wbase[w * 16 + j] + etot[16 + j];
    const unsigned long long ltmask = (1ull << lane) - 1ull;
    for (int i = 0; i < 64; ++i) { const int m = w * 4096 + i * 64 + lane; const v2u r = re[m]; const f32x2 wv = rw[m]; int s0 = 0, s1 = 0;
#pragma unroll
        for (int j = 0; j < 8; ++j) { const unsigned long long b0 = __ballot(r.x == (unsigned)j), b1 = __ballot(r.y == (unsigned)j);
            if (r.x == (unsigned)j) s0 = c[j] + __popcll(b0 & ltmask); if (r.y == (unsigned)j) s1 = c[8 + j] + __popcll(b1 & ltmask);
            c[j] += __popcll(b0); c[8 + j] += __popcll(b1); }
        slot_tok[s0] = m; slot_w[s0] = wv[0]; slot_tok[MOE_SLOTS + s1] = m; slot_w[MOE_SLOTS + s1] = wv[1]; }
}
__device__ __forceinline__ void ph_ssm_prep(unsigned char* ws_, int layer, int g, int part, LAS unsigned char* lds, int tid) { asm volatile("" : "+v"(tid));
    LAS float* apr = (LAS float*)lds;
    LAS float* api = apr + 64 * TP1;
    LAS float* bbr = api + 64 * TP1;
    LAS float* bbi = bbr + 1024;
    LAS float* ccr = bbi + 1024;
    LAS float* cci = ccr + 1024;
    LAS float* kt = cci + 1024;
    constexpr int BAND = TCH / 8;
    const float* A_re = kin(I_A_RE) + (size_t)(layer * NG + g) * NP; const float* A_im = kin(I_A_IM) + (size_t)(layer * NG + g) * NP;
    const float step = expf(kin(I_LOG_STEP)[layer * NG + g]);
    const float* B_re = kin(I_B_RE) + (size_t)(layer * NG + g) * NP * GH; const float* B_im = kin(I_B_IM) + (size_t)(layer * NG + g) * NP * GH;
    const float* C_re = kin(I_C_RE) + (size_t)(layer * NG + g) * GH * NP; const float* C_im = kin(I_C_IM) + (size_t)(layer * NG + g) * GH * NP;
    const float* Dv = kin(I_D) + (size_t)(layer * NG + g) * GH;
    for (int i = tid; i < 64 * TP1; i += 512) { const int p = i / TP1, tau = i % TP1; const float e = expf(A_re[p] * step * (float)tau); float sn, cs; sincosf(A_im[p] * step * (float)tau, &sn, &cs); apr[i] = e * cs; api[i] = e * sn; }
    for (int i = tid; i < 1024; i += 512) { const int p = i >> 4; const float lr = A_re[p], li = A_im[p]; const float e = expf(lr * step); float sn, cs; sincosf(li * step, &sn, &cs);
        const float nr = e * cs - 1.f, ni = e * sn, den = lr * lr + li * li, sr = (nr * lr + ni * li) / den, si = (ni * lr - nr * li) / den;
        const float br = B_re[i], bi = B_im[i]; bbr[i] = br * sr - bi * si; bbi[i] = br * si + bi * sr; ccr[i] = C_re[i]; cci[i] = C_im[i]; }
    __syncthreads();
    for (int i = tid; i < BAND * 256; i += 512) { const int tau = BAND * part + (i >> 8), h = (i >> 4) & 15, h2 = i & 15; float s = 0.f;
        for (int p = 0; p < 64; ++p) { const float cr = ccr[h * 64 + p], ci = cci[h * 64 + p], ar = apr[p * TP1 + tau], ai = api[p * TP1 + tau], br = bbr[p * 16 + h2], bi = bbi[p * 16 + h2];
            const float xr = cr * ar - ci * ai, xi = cr * ai + ci * ar; s += xr * br - xi * bi; }
        if (tau == 0 && h == h2) s += Dv[h];
        kt[i] = s; }
    if (part == 0 && tid < 64) { float* aT = (float*)(ws_ + WS_APOW) + (size_t)(g * 64 + tid) * 2; aT[0] = apr[tid * TP1 + TCH]; aT[1] = api[tid * TP1 + TCH]; }
    __syncthreads();
    bf16* Mg = (bf16*)(ws_ + WS_BIGW + BW_MAUG) + (size_t)g * NYC * UAW;
    { const int t0 = BAND * part;
      for (int i = tid; i < BAND * TCH * 32; i += 512) { const int tl = i / (TCH * 32), t = (i >> 5) % TCH, h = (i >> 1) & 15, hf = i & 1, tau = t0 + tl, sft = t - tau; if (sft < 0) continue;
          const LAS f32x4* src = (const LAS f32x4*)(kt + (tl << 8) + h * 16 + hf * 8); const f32x4 x = src[0], y = src[1];
          v4u w; w.x = pk2(x[0], x[1]); w.y = pk2(x[2], x[3]); w.z = pk2(y[0], y[1]); w.w = pk2(y[2], y[3]);
          *(GAS v4u*)(Mg + (size_t)(t * 16 + h) * UAW + 128 + sft * 16 + hf * 8) = w; } }
    for (int i = tid; i < (NYC / 8) * (UAW / 8); i += 512) { const int n = part * (NYC / 8) + i / (UAW / 8), k0 = (i % (UAW / 8)) * 8, t = n >> 4, h = n & 15; float v[8];
        if (k0 >= 128) { if (((k0 - 128) >> 4) <= t) continue;
#pragma unroll
            for (int j = 0; j < 8; ++j) v[j] = 0.f; }
        else {
#pragma unroll
            for (int j = 0; j < 8; ++j) { const int k = k0 + j, p = k & 63; const float cr = ccr[h * 64 + p], ci = cci[h * 64 + p], ar = apr[p * TP1 + t + 1], ai = api[p * TP1 + t + 1];
                v[j] = (k < 64) ? (cr * ar - ci * ai) : -(cr * ai + ci * ar); } }
        v4u w; w.x = pk2(v[0], v[1]); w.y = pk2(v[2], v[3]); w.z = pk2(v[4], v[5]); w.w = pk2(v[6], v[7]); *(GAS v4u*)(Mg + (size_t)n * UAW + k0) = w; }
    bf16* Wg = (bf16*)(ws_ + WS_BIGW + BW_WST) + (size_t)g * 256 * NYC;
    for (int i = tid; i < 32 * (NYC / 8); i += 512) { const int n = part * 32 + i / (NYC / 8), k0 = (i % (NYC / 8)) * 8, s = k0 >> 4, h2 = k0 & 15; float v[8];
        if (n < 128) { const int p = n & 63; const float ar = apr[p * TP1 + TCH - 1 - s], ai = api[p * TP1 + TCH - 1 - s];
#pragma unroll
            for (int j = 0; j < 8; ++j) { const float br = bbr[p * 16 + h2 + j], bi = bbi[p * 16 + h2 + j]; v[j] = (n < 64) ? (ar * br - ai * bi) : (ar * bi + ai * br); } }
        else {
#pragma unroll
            for (int j = 0; j < 8; ++j) v[j] = 0.f; }
        v4u w; w.x = pk2(v[0], v[1]); w.y = pk2(v[2], v[3]); w.z = pk2(v[4], v[5]); w.w = pk2(v[6], v[7]); *(GAS v4u*)(Wg + (size_t)n * NYC + k0) = w; }
    __syncthreads();
}
template <bool FINAL> __device__ __forceinline__ void ph_moe_reduce(const int* slot_tok, const int* ntp, const bf16* PART, bf16* HB, float* out, int gw, int NGW, int lane) { asm volatile("" : "+v"(lane));
    const int T = *ntp, Tm = T & ~63, nrow = (T - Tm) * 256;
    for (int r = gw; r < nrow; r += NGW) { const int tok = ((const GAS int*)slot_tok)[Tm * 256 + r]; if (tok < 0) continue;
#pragma unroll
        for (int hf = 0; hf < 2; ++hf) { const v4u h = *((const GAS v4u*)(HB + (size_t)tok * DM) + hf * 64 + lane);
            float v[8] = {bflo(h.x), bfhi(h.x), bflo(h.y), bfhi(h.y), bflo(h.z), bfhi(h.z), bflo(h.w), bfhi(h.w)};
#pragma unroll
            for (int kp = 0; kp < KSPLIT; ++kp) { const v4u p = *((const GAS v4u*)(PART + ((size_t)kp * MOE_LEFT_ROWS + r) * DM) + hf * 64 + lane);
                v[0] += bflo(p.x); v[1] += bfhi(p.x); v[2] += bflo(p.y); v[3] += bfhi(p.y); v[4] += bflo(p.z); v[5] += bfhi(p.z); v[6] += bflo(p.w); v[7] += bfhi(p.w); }
            if constexpr (FINAL) { GAS f32x4* o = (GAS f32x4*)(out + (size_t)tok * DM) + hf * 128 + 2 * lane; o[0] = (f32x4){v[0], v[1], v[2], v[3]}; o[1] = (f32x4){v[4], v[5], v[6], v[7]}; }
            else { v4u w; w.x = pk2(v[0], v[1]); w.y = pk2(v[2], v[3]); w.z = pk2(v[4], v[5]); w.w = pk2(v[6], v[7]); *((GAS v4u*)(HB + (size_t)tok * DM) + hf * 64 + lane) = w; } } }
}

namespace att {
typedef float f32x16 __attribute__((ext_vector_type(16)));
typedef short s16x4 __attribute__((ext_vector_type(4)));
constexpr int SLOTK = 12288, SLOTV = 8192, LDS_K = 0, LDS_V = 2 * SLOTK, LDS_WS = LDS_V + 2 * SLOTV, LDS_OST = LDS_WS + 8 * 256, LDS_BYTES = LDS_OST + 8 * 4096;
__device__ __forceinline__ int crow(int r, int hi) { return (r & 3) + 8 * (r >> 2) + 4 * hi; }
__device__ __forceinline__ void glds16(const void* gsrc, unsigned lds_dst) { unsigned keep;
    asm volatile("s_mov_b32 %0, m0\n\ts_mov_b32 m0, %2\n\ts_nop 0\n\tglobal_load_lds_dwordx4 %1, off\n\ts_mov_b32 m0, %0" : "=&s"(keep) : "v"(gsrc), "s"(lds_dst) : "memory"); }
#define ATT_WAIT_BAR() asm volatile("s_waitcnt vmcnt(0) lgkmcnt(0)\n\ts_barrier" ::: "memory")
#define ATT_SBAR() __builtin_amdgcn_sched_barrier(0)
__device__ __forceinline__ float max3f(float a, float b, float c) { return __builtin_fmaxf(__builtin_fmaxf(a, b), c); }
__device__ __forceinline__ float rowmax32(const f32x16& p0, const f32x16& p1) {
    float a = max3f(p0[0], p0[1], p1[0]), b = max3f(p0[2], p0[3], p1[1]); a = max3f(a, p1[2], p1[3]);
#pragma unroll
    for (int r = 4; r < 16; r += 4) { a = max3f(a, p0[r], p0[r + 1]); b = max3f(b, p0[r + 2], p0[r + 3]); a = max3f(a, p1[r], p1[r + 1]); b = max3f(b, p1[r + 2], p1[r + 3]); }
    const float m = fmaxf(a, b);
    auto rr = __builtin_amdgcn_permlane32_swap(__float_as_uint(m), __float_as_uint(m), false, false);
    return fmaxf(__uint_as_float(rr[0]), __uint_as_float(rr[1]));
}
__device__ __forceinline__ void pv(f32x16* o, int vb, bf16x8 pa0, bf16x8 pa1, bf16x8 pa2, bf16x8 pa3) {
#pragma unroll
    for (int d0 = 0; d0 < 2; ++d0) { s16x4 lo[4], hi[4];
#pragma unroll
        for (int ks = 0; ks < 4; ++ks) {
            asm volatile("ds_read_b64_tr_b16 %0,%1 offset:%c2" : "=&v"(lo[ks]) : "v"(vb), "i"(d0 * 4096 + ks * 1024) : "memory");
            asm volatile("ds_read_b64_tr_b16 %0,%1 offset:%c2" : "=&v"(hi[ks]) : "v"(vb), "i"(d0 * 4096 + ks * 1024 + 512) : "memory"); }
        asm volatile("s_waitcnt lgkmcnt(0)" ::: "memory"); ATT_SBAR();
#define ATT_PK(k) (bf16x8){lo[k][0], lo[k][1], lo[k][2], lo[k][3], hi[k][0], hi[k][1], hi[k][2], hi[k][3]}
        o[d0] = __builtin_amdgcn_mfma_f32_32x32x16_bf16(pa0, ATT_PK(0), o[d0], 0, 0, 0);
        o[d0] = __builtin_amdgcn_mfma_f32_32x32x16_bf16(pa1, ATT_PK(1), o[d0], 0, 0, 0);
        o[d0] = __builtin_amdgcn_mfma_f32_32x32x16_bf16(pa2, ATT_PK(2), o[d0], 0, 0, 0);
        o[d0] = __builtin_amdgcn_mfma_f32_32x32x16_bf16(pa3, ATT_PK(3), o[d0], 0, 0, 0);
#undef ATT_PK
    }
}
__device__ __forceinline__ void attn_unit(int b, int h, int qb, const bf16* QN, const bf16* KN, const bf16* KVR, bf16* MIX, float* SS, LAS unsigned char* shm) {
    int tid = threadIdx.x; asm volatile("" : "+v"(tid));
    const int lane = tid & 63, r32 = lane & 31, hi = lane >> 5, wid = __builtin_amdgcn_readfirstlane(tid >> 6);
    const long rowbase = (long)b * SEQ; const int q0 = qb * 256;
    const unsigned lds0 = (unsigned)(uintptr_t)shm;
    LAS float* wsf = (LAS float*)(shm + LDS_WS) + wid * 64;
    const bf16* ksrc0 = KN + (rowbase + lane) * 768 + h * 96 + wid * 8;
    const bf16* ksrc1 = ksrc0 + 64;
    const bf16* vsrc = KVR + (rowbase + 16 * (wid & 3) + (lane >> 2)) * 1024 + h * 128 + 64 + (wid >> 2) * 32 + (lane & 3) * 8;
    const unsigned kdst0 = lds0 + LDS_K + wid * 1024, kdst1 = lds0 + LDS_K + (8 + wid) * 1024, vdst = lds0 + LDS_V + wid * 1024;
#define ATT_DMA(t, s) do { glds16(ksrc0 + (long)(t) * 64 * 768, (unsigned)__builtin_amdgcn_readfirstlane(kdst0 + (s) * SLOTK)); \
        if (wid < 4) glds16(ksrc1 + (long)(t) * 64 * 768, (unsigned)__builtin_amdgcn_readfirstlane(kdst1 + (s) * SLOTK)); \
        glds16(vsrc + (long)(t) * 64 * 1024, (unsigned)__builtin_amdgcn_readfirstlane(vdst + (s) * SLOTV)); } while (0)
    const int vb0 = (int)(lds0 + LDS_V) + ((lane >> 4) & 1) * 32 + (lane & 3) * 8 + (4 * hi + ((lane & 15) >> 2)) * 64;
    const int NT = 4 * qb + 4, jmax = 4 * qb + (wid >> 1);
    ATT_DMA(0, 0);
    bf16x8 qr[6];
    const bf16* Qw = QN + (rowbase + q0 + wid * 32 + r32) * 768 + h * 96 + hi * 8;
#pragma unroll
    for (int d0 = 0; d0 < 6; ++d0) qr[d0] = *(const bf16x8*)(Qw + d0 * 16);
    float mhat = 0.f, l_reg = 0.f; f32x16 o[2]; f32x16 negm;
#pragma unroll
    for (int r = 0; r < 16; ++r) { o[0][r] = 0.f; o[1][r] = 0.f; negm[r] = 0.f; }
    constexpr float THRL = 8.f;
    for (int j = 0; j < NT; ++j) {
        ATT_WAIT_BAR();
        const int s = j & 1;
        if (j + 1 < NT) ATT_DMA(j + 1, s ^ 1);
        if (j <= jmax) {
            const LAS unsigned char* kb = shm + LDS_K + s * SLOTK + hi * 1024 + r32 * 16;
            f32x16 p0 = negm, p1 = negm;
#pragma unroll
            for (int d0 = 0; d0 < 6; ++d0) { const bf16x8 k0 = *(const LAS bf16x8*)(kb + d0 * 2048), k1 = *(const LAS bf16x8*)(kb + d0 * 2048 + 512);
                p0 = __builtin_amdgcn_mfma_f32_32x32x16_bf16(k0, qr[d0], p0, 0, 0, 0); p1 = __builtin_amdgcn_mfma_f32_32x32x16_bf16(k1, qr[d0], p1, 0, 0, 0); }
            const float rm = rowmax32(p0, p1);
            if (__any(rm > THRL) || j == 0) {
                const float dl = (j == 0) ? rm : fmaxf(rm, 0.f); mhat += dl;
#pragma unroll
                for (int r = 0; r < 16; ++r) { p0[r] -= dl; p1[r] -= dl; negm[r] = -mhat; }
                const float f = __builtin_amdgcn_exp2f(-dl); l_reg *= f;
                if (hi == 0) wsf[r32] = f;
                asm volatile("s_waitcnt lgkmcnt(0)" ::: "memory");
#pragma unroll
                for (int r = 0; r < 16; ++r) { const float g = wsf[crow(r, hi)]; o[0][r] *= g; o[1][r] *= g; }
            }
            float sacc = 0.f;
#pragma unroll
            for (int r = 0; r < 16; ++r) { p0[r] = __builtin_amdgcn_exp2f(p0[r]); p1[r] = __builtin_amdgcn_exp2f(p1[r]); sacc += p0[r] + p1[r]; }
            l_reg += sacc;
            v4u pw0, pw1, pw2, pw3;
            pw0 = (v4u){pk2(p0[0], p0[1]), pk2(p0[2], p0[3]), pk2(p0[4], p0[5]), pk2(p0[6], p0[7])}; pw1 = (v4u){pk2(p0[8], p0[9]), pk2(p0[10], p0[11]), pk2(p0[12], p0[13]), pk2(p0[14], p0[15])};
            pw2 = (v4u){pk2(p1[0], p1[1]), pk2(p1[2], p1[3]), pk2(p1[4], p1[5]), pk2(p1[6], p1[7])}; pw3 = (v4u){pk2(p1[8], p1[9]), pk2(p1[10], p1[11]), pk2(p1[12], p1[13]), pk2(p1[14], p1[15])};
            ATT_SBAR();
            pv(o, vb0 + s * SLOTV, __builtin_bit_cast(bf16x8, pw0), __builtin_bit_cast(bf16x8, pw1), __builtin_bit_cast(bf16x8, pw2), __builtin_bit_cast(bf16x8, pw3));
        }
    }
    { auto rr = __builtin_amdgcn_permlane32_swap(__float_as_uint(l_reg), __float_as_uint(l_reg), false, false); l_reg = __uint_as_float(rr[0]) + __uint_as_float(rr[1]); }
    if (hi == 0) wsf[32 + r32] = l_reg;
    asm volatile("s_waitcnt lgkmcnt(0)" ::: "memory");
    float rli[16];
#pragma unroll
    for (int r = 0; r < 16; ++r) rli[r] = __builtin_amdgcn_rcpf(wsf[32 + crow(r, hi)]);
    bf16* Ow = MIX + (rowbase + q0 + wid * 32) * 1024 + 512 + h * 64;
    { LAS bf16* stg = (LAS bf16*)(shm + LDS_OST) + wid * 2048;
#pragma unroll
      for (int r = 0; r < 16; ++r) { const int orow = crow(r, hi);
#pragma unroll
          for (int d0 = 0; d0 < 2; ++d0) stg[orow * 64 + d0 * 32 + r32] = f2bf(o[d0][r] * rli[r]); }
      asm volatile("s_waitcnt lgkmcnt(0)" ::: "memory");
#pragma unroll
      for (int i = 0; i < 4; ++i) { const int row = i * 8 + (lane >> 3), ch = lane & 7; const v4u v = *(const LAS v4u*)(stg + row * 64 + ch * 8); *(v4u*)(Ow + (long)row * 1024 + ch * 8) = v;
          float ss = (bflo(v.x) * bflo(v.x) + bfhi(v.x) * bfhi(v.x)) + (bflo(v.y) * bflo(v.y) + bfhi(v.y) * bfhi(v.y)) + (bflo(v.z) * bflo(v.z) + bfhi(v.z) * bfhi(v.z)) + (bflo(v.w) * bflo(v.w) + bfhi(v.w) * bfhi(v.w));
          ss += __shfl_xor(ss, 1); ss += __shfl_xor(ss, 2); ss += __shfl_xor(ss, 4);
          if (ch == 0) ((GAS float*)SS)[(rowbase + q0 + wid * 32 + row) * 16 + 8 + h] = ss; } }
    ATT_WAIT_BAR();
#undef ATT_DMA
}
__device__ __forceinline__ void attn_phase(const bf16* QN, const bf16* KN, const bf16* KVR, bf16* MIX, float* SS, LAS unsigned char* lds, int vcu, int G) {
#pragma unroll 1
    for (int v = vcu; v < 256; v += G) {
        const int bh = v >> 2, s = v & 3;
#pragma unroll 1
        for (int i = 0; i < 4; ++i) { const int qb = (i == 0) ? s : (i == 1) ? 7 - s : (i == 2) ? 8 + s : 15 - s; attn_unit(bh >> 3, bh & 7, qb, QN, KN, KVR, MIX, SS, lds); } }
}
}
#define XB_TMO      128
#define XB_XCNT(j)  (256  + 64 * (j))
#define XB_XSUB(j)  (1280 + 64 * (j))
#define XB_XGEN(j)  (2304 + 64 * (j))
#define XB_TOP      3328
#define XB_TOPGEN   3392
#define XCD_BAR_WORDS 3456
#define XB_SPIN_CAP (1u << 18)
__device__ __forceinline__ unsigned xb_ld(unsigned* p)              { return __hip_atomic_load(p, __ATOMIC_RELAXED, __HIP_MEMORY_SCOPE_AGENT); }
__device__ __forceinline__ unsigned xb_add(unsigned* p, unsigned v) { return __hip_atomic_fetch_add(p, v, __ATOMIC_RELAXED, __HIP_MEMORY_SCOPE_AGENT); }
__device__ __forceinline__ unsigned xb_xcc_id() { return (unsigned)__builtin_amdgcn_s_getreg((3 << 11) | 20) & 0xFu; }
#define XB_SPIN(cond, bar) do { unsigned _sp = 0; while (cond) { __builtin_amdgcn_s_sleep(1); \
    if ((++_sp & 255u) == 0u) { if (xb_ld(&(bar)[XB_TMO])) break; if (_sp > XB_SPIN_CAP) { atomicAdd(&(bar)[XB_TMO], 1u); break; } } } } while (0)
struct XcdBarrier { unsigned* bar; unsigned x; volatile LAS unsigned* st; };
__device__ __forceinline__ XcdBarrier xcd_barrier_post(unsigned* bar, volatile LAS unsigned* st) {
    XcdBarrier b; b.bar = bar; b.x = xb_xcc_id(); b.st = st;
    if (threadIdx.x == 0) (void)xb_add(&bar[XB_XCNT(b.x)], 1u);
    return b;
}
__device__ __forceinline__ void xcd_barrier_complete(unsigned* bar, unsigned x, unsigned& nloc, unsigned& nx) {
    const unsigned G = gridDim.x * gridDim.y * gridDim.z;
    unsigned sum, cnt, mine, sp = 0u;
    for (;;) {
        sum = 0u; cnt = 0u; mine = 0u;
#pragma unroll
        for (unsigned j = 0; j < 16; ++j) { const unsigned c = xb_ld(&bar[XB_XCNT(j)]); sum += c; cnt += (c > 0u) ? 1u : 0u; mine = (j == x) ? c : mine; }
        if (sum == G) break;
        __builtin_amdgcn_s_sleep(1);
        if ((++sp & 255u) == 0u) { if (xb_ld(&bar[XB_TMO])) break; if (sp > XB_SPIN_CAP) { atomicAdd(&bar[XB_TMO], 1u); break; } }
    }
    nloc = mine > 0u ? mine : 1u; nx = cnt > 0u ? cnt : 1u;
}
__device__ __forceinline__ void xcd_barrier(const XcdBarrier& b) {
    asm volatile("s_waitcnt vmcnt(0)" ::: "memory");
    __syncthreads();
    if (threadIdx.x == 0) {
        unsigned* bar = b.bar; asm volatile("" : "+s"(bar));
        __builtin_amdgcn_s_waitcnt(0);
        unsigned nloc = b.st[0], nx = b.st[1];
        if (nloc == 0u) { xcd_barrier_complete(bar, b.x, nloc, nx); b.st[0] = nloc; b.st[1] = nx; }
        const unsigned old = xb_add(&bar[XB_XSUB(b.x)], 1u);
        const unsigned gen = old / nloc;
        if (old + 1u == (gen + 1u) * nloc) {
            __builtin_amdgcn_fence(__ATOMIC_RELEASE, "agent");
            asm volatile("s_waitcnt vmcnt(0)" ::: "memory");
            const unsigned og = xb_add(&bar[XB_TOP], 1u);
            const unsigned tg = og / nx;
            if (og + 1u == (tg + 1u) * nx) xb_add(&bar[XB_TOPGEN], 1u);
            else XB_SPIN(xb_ld(&bar[XB_TOPGEN]) == tg, bar);
            __builtin_amdgcn_fence(__ATOMIC_ACQUIRE, "agent");
            xb_add(&bar[XB_XGEN(b.x)], 1u);
            asm volatile("s_waitcnt vmcnt(0)" ::: "memory");
        } else {
            XB_SPIN(xb_ld(&bar[XB_XGEN(b.x)]) == gen, bar);
            __builtin_amdgcn_fence(__ATOMIC_ACQUIRE, "agent");
            asm volatile("s_waitcnt vmcnt(0)" ::: "memory");
        }
    }
    __syncthreads();
}

constexpr int RING_BYTES = 131072, MISC_OFF = RING_BYTES + 320, LDS_BYTES = 147456;
enum { PH_PREP = 0, PH_NORM1, PH_INPROJ, PH_SSMS, PH_SSMY, PH_GLU, PH_LATNORM, PH_QUP, PH_KVUP, PH_QKPREP, PH_ATTN, PH_OUTNORM, PH_OUTPROJ, PH_NORM2, PH_F0, PH_F1, PH_F2, PH_F3, PH_F4, PH_PER_LAYER = 32 };
struct Args { Params P; int ph_lo, ph_hi; unsigned skip_mask; int pad; };

struct LArgs { unsigned char* ws; float* outp; int G, bx, vcu, pad; };
#ifndef REPMASK0
#define REPMASK0 0x0
#define REPMASK1 0x0
#endif
#define REPS(k) (((((unsigned)(layer == 0 ? REPMASK0 : REPMASK1)) >> (k)) & 1u) ? 2 : 1)
#define RUN(k, ...) do { { const float rep_scale = 1.f; (void)rep_scale; __VA_ARGS__; } if constexpr (REPS(k) > 1) { const float rep_scale = 0.f; (void)rep_scale; __syncthreads(); __VA_ARGS__; } } while (0)
#define BAR() xcd_barrier(bar)
template <int layer> __device__ __forceinline__ void run_layer(const LArgs a, const XcdBarrier bar, LAS unsigned char* lds) {
    unsigned char* const ws = a.ws; float* const outp = a.outp; const int G = a.G, bx = a.bx, vcu = a.vcu;
    const int tid = threadIdx.x, lane = tid & 63, wave = __builtin_amdgcn_readfirstlane(tid >> 6);
    const int gw = vcu * 8 + wave, NGW = G * 8, gtid = bx * 512 + tid, gthreads = G * 512;
    bf16* HB = (bf16*)(ws + WS_HB); bf16* Z = (bf16*)outp; bf16* LAT = (bf16*)outp; bf16* KN = (bf16*)outp; bf16* MIX = (bf16*)(ws + WS_MIX); bf16* PL = (bf16*)(ws + WS_PL);
    bf16* UA = (bf16*)(ws + WS_UAUG); bf16* YG = (bf16*)(ws + WS_YG); bf16* KVR = (bf16*)(ws + WS_KVRAW); bf16* QR = (bf16*)(ws + WS_QRAW);
    bf16* ACTD = (bf16*)(ws + WS_ACTD); bf16* ACTM = (bf16*)(ws + WS_ACTM);
    LAS float* scr = (LAS float*)(lds + wave * 16384);
    unsigned char* wsm = ws + WS_WSMALL + (size_t)layer * WSM_STRIDE;
    RUN(0, { for (int j = bx; j < 256; j += G) ph_ssm_prep(ws, layer, j & 31, j >> 5, lds, tid);
             conv_small(ws, layer, scr, gw, NGW, lane, gtid, gthreads);
             if constexpr (layer == 0) conv_dense(ws, scr, gw, NGW, lane);
             if constexpr (layer == 0) ph_x2hb(kin(I_X), HB, (float*)(ws + WS_SS3), gw, NGW, lane); });
    BAR();
    RUN(1, { DenseSched S{(const char*)HB, (const char*)(wsm + WSM_IN), DM * 2, DM * 2, M / 256, 4, DM / 64, G, bx}; EpiInProjRs E{UA, PL, (const float*)(ws + WS_SS3), lds}; pg8::gemm_phase(lds, S, E); });
    BAR();
    RUN(2, { { SsmSSched S{(const char*)UA, (const char*)(ws + WS_BIGW + BW_WST), UAW * 2, NYC * 2, G, bx}; EpiSsmS E{UA, (const float*)(ws + WS_APOW)}; pg8::gemm_phase<EpiSsmS, SsmSSched, false, true>(lds, S, E); }
             ph_latnorm(PL, kin(I_Q_NORM) + layer * QRANK, kin(I_KV_NORM) + layer * KVRANK, LAT, gw, NGW, lane); });
    BAR();
    RUN(3, { { SsmYSched S{(const char*)UA, (const char*)(ws + WS_BIGW + BW_MAUG), UAW * 2, UAW * 2, G, bx}; EpiSsmY E{YG}; pg8::gemm_phase(lds, S, E); }
             { DenseSched S{(const char*)LAT, (const char*)(wsm + WSM_Q), 512 * 2, QRANK * 2, M / 256, 3, 4, G, bx}; EpiBf16 E{QR, 768}; pg8::gemm_phase(lds, S, E); }
             { DenseSched S{(const char*)(LAT + 256), (const char*)(wsm + WSM_KV), 512 * 2, 256 * 2, M / 256, 4, 4, G, bx}; EpiBf16 E{KVR, 1024}; pg8::gemm_phase(lds, S, E); } });
    BAR();
    RUN(4, { { DenseSched S{(const char*)YG, (const char*)(wsm + WSM_GLU), DSSM * 2, DSSM * 2, M / 256, 2, DSSM / 64, G, bx}; EpiGlu E{YG, kin(I_B_GLU) + layer * DSSM, MIX, (float*)(ws + WS_SS)}; pg8::gemm_phase(lds, S, E); }
             if (rep_scale == 1.f) ph_qkprep(QR, KVR, PL, KN, kin(I_Q_GAIN) + layer * DQK, kin(I_K_GAIN) + layer * DQK, gw, NGW, lane); });
    BAR();
    RUN(5, att::attn_phase(QR, KN, KVR, MIX, (float*)(ws + WS_SS), lds, vcu, G));
    BAR();
    RUN(7, { DenseSched S{(const char*)MIX, (const char*)(wsm + WSM_OUT), DM * 2, DM * 2, M / 256, 4, DM / 64, G, bx}; EpiOutProj E{HB, (const float*)(ws + WS_SS), rep_scale, lds, (float*)(ws + WS_SS2)}; pg8::gemm_phase(lds, S, E); });
    BAR();
    if constexpr (layer == 0) {
        RUN(9, { DenseSched S{(const char*)HB, (const char*)(ws + WS_BIGW + BW_DGU), DM * 2, DM * 2, M / 256, 22, DM / 64, G, bx}; EpiSwigluRs E{ACTD, FFD, (const float*)(ws + WS_SS2), lds}; pg8::gemm_phase(lds, S, E); });
        BAR();
        RUN(10, { DenseSched S{(const char*)ACTD, (const char*)(ws + WS_BIGW + BW_DD), FFD * 2, FFD * 2, M / 256, 4, FFD / 64, G, bx}; EpiResid E{HB, rep_scale, (float*)(ws + WS_SS3)}; pg8::gemm_phase(lds, S, E); });
        BAR();
    } else {
        unsigned char* rt = ws + WS_ROUTE;
        RUN(8, { ph_norm_route(HB, kin(I_FFN_NORM) + layer * DM, kin(I_MW_ROUTER), Z, (v4u*)rt, gw, NGW, lane); });
        BAR();
        RUN(9, { if (bx == G - 1) { ph_route_sort((const v4u*)rt, rt, lds, tid); __syncthreads(); } conv_moe(ws, scr, gw, NGW, lane); });
        BAR();
        bf16* PART0 = (bf16*)((unsigned char*)outp + 64 * MiB); bf16* PART1 = (bf16*)(ws + WS_BIGW);
#pragma unroll 1
        for (int k = 0; k < 2; ++k) {
            const int* tile_e = (const int*)(rt + RT_TILE_E) + k * MOE_TILES; const int* slot_tok = (const int*)(rt + RT_SLOT_TOK) + k * MOE_SLOTS; const float* slot_w = (const float*)(rt + RT_SLOT_W) + k * MOE_SLOTS; const int* ntl = (const int*)(rt + RT_NTILES) + k;
            if (k == 1) ph_moe_reduce<false>((const int*)(rt + RT_SLOT_TOK), (const int*)(rt + RT_NTILES), PART0, HB, outp, gw, NGW, lane);
            RUN(10, { MoeSched S{(const char*)Z, (const char*)(ws + WS_BIGW + BW_MGU), DM * 2, DM * 2, (size_t)2 * FFE * DM * 2, 28, DM / 64, G, bx, tile_e, slot_tok, ntl}; EpiSwiglu E{ACTM, FFE}; pg8::gemm_phase(lds, S, E); });
            BAR();
            if (k == 0) RUN(11, { MoeDownSched S{(const char*)ACTM, (const char*)(ws + WS_BIGW + BW_MD), FFE * 2, FFE * 2, (size_t)DM * FFE * 2, G, bx, tile_e, ntl}; EpiMoeDown<false> E{slot_tok, slot_w, HB, outp, rep_scale, ntl, PART0}; pg8::gemm_phase(lds, S, E); });
            else RUN(12, { MoeDownSched S{(const char*)ACTM, (const char*)(ws + WS_BIGW + BW_MD), FFE * 2, FFE * 2, (size_t)DM * FFE * 2, G, bx, tile_e, ntl}; EpiMoeDown<true> E{slot_tok, slot_w, HB, outp, 1.f, ntl, PART1}; pg8::gemm_phase(lds, S, E); });
            BAR();
            if (k == 1) ph_moe_reduce<true>(slot_tok, ntl, PART1, HB, outp, gw, NGW, lane);
        }
    }
}
__global__ void __launch_bounds__(512, 2) fwd(Args args) {
    extern __shared__ __attribute__((aligned(16))) unsigned char lds_raw[];
    LAS unsigned char* lds = (LAS unsigned char*)lds_raw;
    unsigned char* const ws = args.P.ws; float* const outp = args.P.out;
    const int tid = threadIdx.x, lane = tid & 63, wave = __builtin_amdgcn_readfirstlane(tid >> 6);
    const int G = gridDim.x, bx = blockIdx.x; const int vcu = (G % 8 == 0) ? (bx % 8) * (G / 8) + bx / 8 : bx;
    const int gw = vcu * 8 + wave, NGW = G * 8, gtid = bx * 512 + tid, gthreads = G * 512;
    volatile LAS unsigned* MISC = (volatile LAS unsigned*)(lds + MISC_OFF);
    for (int u = tid; u < (LDS_BYTES - RING_BYTES) / 4; u += 512) ((LAS unsigned*)(lds + RING_BYTES))[u] = 0u;
    __syncthreads();
    unsigned* ctl = (unsigned*)(ws + WS_CTL);
    XcdBarrier bar = xcd_barrier_post(ctl + CW_BAR, MISC + 8);

    LArgs la; la.ws = ws; la.outp = outp; la.G = G; la.bx = bx; la.vcu = vcu; la.pad = 0;
    run_layer<0>(la, bar, lds);
    run_layer<1>(la, bar, lds);
}
static void launch_fwd(const Params& P, int lo, int hi, unsigned skip, int grid, hipStream_t st) {
    Args a{}; a.P = P; a.ph_lo = lo; a.ph_hi = hi; a.skip_mask = skip; a.pad = 0;
    hipLaunchKernelGGL(fwd, dim3(grid), dim3(512), LDS_BYTES, st, a);
}
extern "C" void kernel_launch(void* const* d_in, const int* in_sizes, int n_in, void* d_out, int out_size, void* d_ws, size_t ws_size, hipStream_t stream) {
    static int grid = 0;
    if (grid == 0) {
        if (n_in != 30 || out_size != M * DM || ws_size < WS_END) { fprintf(stderr, "kernel_launch: unexpected shapes: n_in %d out %d ws %zu (need %zu)\n", n_in, out_size, ws_size, (size_t)WS_END); grid = -1; return; }
        int dev = 0, cus = 0;
        if (hipGetDevice(&dev) != hipSuccess || hipDeviceGetAttribute(&cus, hipDeviceAttributeMultiprocessorCount, dev) != hipSuccess) { grid = -1; return; }
        if (hipFuncSetAttribute((const void*)fwd, hipFuncAttributeMaxDynamicSharedMemorySize, LDS_BYTES) != hipSuccess) { fprintf(stderr, "kernel_launch: hipFuncSetAttribute failed\n"); grid = -1; return; }
        (void)hipGetLastError();
        grid = cus;
    }
    if (grid < 0) return;
    Params P{};
    for (int i = 0; i < 30; ++i) P.in[i] = (const float*)d_in[i];
    P.out = (float*)d_out; P.ws = (unsigned char*)d_ws;
    unsigned char* ws = P.ws;
    (void)hipMemsetAsync(ws + WS_CTL, 0, CTL_ZERO_BYTES, stream);
    launch_fwd(P, 0, DEPTH * PH_PER_LAYER, 0, grid, stream);
}
```

```cpp
#include <hip/hip_runtime.h>
#include <cstdio>
#include <cstdint>

constexpr int NB = 8, SEQ = 4096, DM = 1024, M = NB * SEQ, DEPTH = 2;
#ifndef SSM_TCH
#define SSM_TCH 32
#endif
constexpr int DSSM = 512, NG = 32, GH = 16, NP = 64, TCH = SSM_TCH, NCH = SEQ / TCH;
constexpr int NROWG = NB * NCH, NYC = TCH * 16, SSM_RT = NROWG / 256, SSM_CT = NYC / 256, TP1 = TCH + 1;
constexpr int NHEAD = 8, DV = 64, DNOPE = 64, DROPE = 32, DQK = 96, QRANK = 256, KVRANK = 128;
constexpr int DIN = 928, FFD = 2816, NE = 8, FFE = 3584;
constexpr float EPS = 1e-6f;
constexpr int UAW = 128 + NYC;
constexpr int MOE_SLOTS = 34816;
constexpr int MOE_TILES = MOE_SLOTS / 256;

constexpr size_t MiB = 1u << 20;
constexpr size_t WS_CTL = 0, CTL_ZERO_BYTES = 64 * 1024;
constexpr size_t WS_WSMALL = 1 * MiB;
constexpr size_t WSM_IN = 0, WSM_GLU = 2 * MiB, WSM_Q = 2 * MiB + 512 * 1024, WSM_KV = 3 * MiB, WSM_OUT = 3 * MiB + 512 * 1024, WSM_STRIDE = 6 * MiB;
constexpr size_t WS_APOW = 13 * MiB;
constexpr size_t WS_ROUTE = 14 * MiB;
constexpr size_t RT_SLOT_TOK = 512 * 1024, RT_SLOT_W = RT_SLOT_TOK + 2 * MOE_SLOTS * 4, RT_TILE_E = RT_SLOT_W + 2 * MOE_SLOTS * 4, RT_NTILES = RT_TILE_E + 2 * MOE_TILES * 4;
constexpr size_t WS_SS = 16 * MiB;
constexpr size_t WS_SS2 = 126 * MiB, WS_SS3 = 124 * MiB;
constexpr size_t WS_BIGW = 19 * MiB;
constexpr size_t BW_MAUG = 0, BW_WST = 72 * MiB, BW_DGU = 88 * MiB, BW_DD = 99 * MiB;
constexpr size_t BW_MGU = 0, BW_MD = 112 * MiB;
constexpr size_t WS_HB = 195 * MiB;
constexpr size_t WS_MIX = 259 * MiB;
constexpr size_t WS_PL = 323 * MiB;
constexpr size_t WS_UAUG = 355 * MiB;
constexpr size_t WS_YG = 395 * MiB;
constexpr size_t WS_KVRAW = 128 * MiB;
constexpr size_t WS_QRAW = 427 * MiB;
constexpr size_t WS_ACTD = 323 * MiB;
constexpr size_t WS_ACTM = 259 * MiB;
constexpr size_t WS_END = 511 * MiB;
static_assert(WS_ACTM + (size_t)MOE_SLOTS * FFE * 2 <= WS_END && WS_ACTD + (size_t)M * FFD * 2 <= WS_END && WS_QRAW + (size_t)M * 768 * 2 <= WS_END, "ws map");
static_assert(WS_BIGW + BW_MD + (size_t)NE * DM * FFE * 2 <= WS_HB && WS_UAUG + (size_t)NG * NROWG * UAW * 2 <= WS_YG, "ws map 2");
static_assert(RT_NTILES + 64 <= 5 * MiB, "route map");

constexpr int CW_BAR = 4096;

#define GAS __attribute__((address_space(1)))
#define LAS __attribute__((address_space(3)))
typedef unsigned short bf16;
typedef unsigned v4u __attribute__((ext_vector_type(4)));
typedef unsigned v2u __attribute__((ext_vector_type(2)));
typedef float f32x4 __attribute__((ext_vector_type(4)));
typedef float f32x2 __attribute__((ext_vector_type(2)));
typedef short bf16x8 __attribute__((ext_vector_type(8)));
typedef __bf16 bf16x2_t __attribute__((ext_vector_type(2)));
#define LDS_WAIT() asm volatile("s_waitcnt lgkmcnt(0)" ::: "memory")
#define VM_WAIT() asm volatile("s_waitcnt vmcnt(0)" ::: "memory")
__device__ __forceinline__ unsigned pk2(float lo, float hi) { f32x2 v = {lo, hi}; bf16x2_t b = __builtin_convertvector(v, bf16x2_t); return __builtin_bit_cast(unsigned, b); }
__device__ __forceinline__ bf16 f2bf(float f) { return (bf16)(pk2(f, 0.f) & 0xffffu); }
__device__ __forceinline__ float bf2f(bf16 b) { return __builtin_bit_cast(float, (unsigned)b << 16); }
__device__ __forceinline__ float bflo(unsigned w) { return __builtin_bit_cast(float, w << 16); }
__device__ __forceinline__ float bfhi(unsigned w) { return __builtin_bit_cast(float, w & 0xffff0000u); }
__device__ __forceinline__ float wave_sum(float v) {
#pragma unroll
    for (int o = 1; o < 64; o <<= 1) v += __shfl_xor(v, o);
    return v;
}
__device__ __forceinline__ float sigmoidf_(float x) { return __builtin_amdgcn_rcpf(1.f + __builtin_amdgcn_exp2f(-1.4426950408889634f * x)); }
__device__ __forceinline__ float gelu_tanh(float x) { const float u = 0.7978845608028654f * (x + 0.044715f * x * x * x); return x * sigmoidf_(2.f * u); }

struct Params { const float* in[30]; float* out; unsigned char* ws; };
__device__ __forceinline__ const float* kin(int i) { const float* const* ka = (const float* const*)__builtin_amdgcn_kernarg_segment_ptr(); asm volatile("" : "+s"(ka)); return ka[i]; }
enum { I_X = 0, I_ATTN_NORM, I_W_IN, I_A_RE, I_A_IM, I_LOG_STEP, I_B_RE, I_B_IM, I_C_RE, I_C_IM, I_D, I_W_GLU, I_B_GLU, I_Q_NORM, I_W_Q_UP, I_KV_NORM, I_W_KV_UP,
       I_Q_GAIN, I_K_GAIN, I_SSM_OUT_NORM, I_MLA_OUT_NORM, I_W_OUT, I_FFN_NORM, I_DW_GATE, I_DW_UP, I_DW_DOWN, I_MW_ROUTER, I_MW_GATE, I_MW_UP, I_MW_DOWN };

#ifndef NAIVE
#define NAIVE 0
#endif
#ifndef FAST_GEMM
#define FAST_GEMM 1
#endif
namespace pg8 {
constexpr int BM = 256, BK = 64, HALF = 128, HTB = HALF * BK * 2, STAGE_BYTES = 8 * HTB, NXCD = 8, WGM = 8;
__host__ __device__ __forceinline__ int lds_byte(int r, int c) { const int st = (r >> 4) * 2 + (c >> 5), rr = r & 15, cc = c & 31, ob = rr * 64 + cc * 2; return st * 1024 + (ob ^ (((ob >> 9) & 1) << 5)); }
__host__ __device__ __forceinline__ void stage_rc(int b, int& R, int& C) { const int st = b / 1024, sb = b % 1024, swz = sb ^ (((sb >> 9) & 1) << 5); R = (st >> 1) * 16 + swz / 64; C = (st & 1) * 32 + (swz % 64) / 2; }
__host__ __device__ __forceinline__ int perm32(int rho) { const int n = rho >> 4, i = rho & 15; return 8 * (i >> 2) + 4 * n + (i & 3); }

struct Unit { int pm, pn, aux, kp, seq; };

__device__ __forceinline__ bool static_unit(int i, int G, int c, int nM, int nN, Unit& u) {
    const int nwg = nM * nN; const long L = (long)i * G + c; if (L >= nwg) return false;
    int wgid = (int)L; { const int q = nwg / NXCD, r = nwg % NXCD, xcd = wgid % NXCD, off = wgid / NXCD; wgid = (xcd < r ? xcd * (q + 1) : r * (q + 1) + (xcd - r) * q) + off; }
    const int nig = WGM * nN, gid = wgid / nig, fm = gid * WGM, gsz = (nM - fm) < WGM ? (nM - fm) : WGM;
    u.pm = fm + ((wgid % nig) % gsz); u.pn = (wgid % nig) / gsz; u.aux = 0; u.kp = -1; return true;
}

template <class T, class = void> struct has_mid { static constexpr bool value = false; };
template <class T> struct has_mid<T, decltype((void)T::MID_T)> { static constexpr bool value = true; };
template <class T, class = void> struct has_begin { static constexpr bool value = false; };
template <class T> struct has_begin<T, decltype((void)T::BEGIN)> { static constexpr bool value = true; };
template <class T, class = void> struct has_pair { static constexpr bool value = false; };
template <class T> struct has_pair<T, decltype((void)T::PAIR)> { static constexpr bool value = true; };
template <class T, class = void> struct has_custom { static constexpr bool value = false; };
template <class T> struct has_custom<T, decltype((void)T::CUSTOM)> { static constexpr bool value = true; };
template <class Epi> __device__ __forceinline__ void epi_apply(const Epi& E, const f32x4 (&acc)[2][2][4][2], const Unit& u, int wr, int wc, int fr, int fq) {
    if constexpr (has_custom<Epi>::value) E.apply(acc, u, wr, wc, fr, fq);
    else {
#pragma unroll
    for (int ai = 0; ai < 2; ++ai)
#pragma unroll
        for (int m = 0; m < 4; ++m) { const int r = ai * HALF + wr * 64 + m * 16 + fr;
            if constexpr (has_pair<Epi>::value) E.putpair(u, r, wc * 32 + 8 * fq, acc[ai][0][m][0], acc[ai][0][m][1], acc[ai][1][m][0], acc[ai][1][m][1]);
            else {
#pragma unroll
            for (int bj = 0; bj < 2; ++bj) {
                if constexpr (Epi::PERM) E.put8(u, r, bj * HALF + wc * 32 + 8 * fq, acc[ai][bj][m][0], acc[ai][bj][m][1]);
                else { E.put4(u, r, bj * HALF + wc * 32 + 4 * fq, acc[ai][bj][m][0]); E.put4(u, r, bj * HALF + wc * 32 + 16 + 4 * fq, acc[ai][bj][m][1]); } } }
            asm volatile("" ::: "memory"); }
    }
}

template <class Epi, class Sched, bool ALIGN_EPI = true, bool SP2 = true>
__device__ __forceinline__ void gemm_phase(LAS unsigned char* lds, const Sched& S, const Epi& E) {
    int tid = threadIdx.x; asm volatile("" : "+v"(tid));
    const int wid = __builtin_amdgcn_readfirstlane(tid >> 6), lane = tid & 63, wr = wid >> 2, wc = wid & 3, fr = lane & 15, fq = lane >> 4;
    int RA[2], CA2[2]; unsigned voffB[2], voA0[2], voA1[2], nvA0[2], nvA1[2];
    const unsigned lda = S.lda, ldb = S.ldb;
#pragma unroll
    for (int i = 0; i < 2; ++i) { int R, C; stage_rc(tid * 16 + i * 8192, R, C); const int Rb = Epi::PERM ? ((R & ~31) + perm32(R & 31)) : R;
        RA[i] = R; CA2[i] = C * 2; voffB[i] = (unsigned)Rb * ldb + (unsigned)C * 2u; voA0[i] = (unsigned)R * lda + (unsigned)C * 2u; voA1[i] = (unsigned)(R + HALF) * lda + (unsigned)C * 2u; nvA0[i] = voA0[i]; nvA1[i] = voA1[i]; }
    const size_t kstep = (size_t)(BK * 2);
    const size_t hstepB = (size_t)HALF * ldb;
    const unsigned ldsw = (unsigned)wid * 1024u;
    const int aoff = lds_byte(wr * 64 + fr, fq * 8), boff = lds_byte(wc * 32 + fr, fq * 8);
#define PG8_SA(b, h) (((b) * 2 + (h)) * HTB)
#define PG8_SB(b, h) ((4 + (b) * 2 + (h)) * HTB)
#define PG8_STAGE(bufoff, gbase, voff) do { _Pragma("unroll") for (int _i = 0; _i < 2; ++_i) \
        __builtin_amdgcn_global_load_lds((const unsigned*)((const char*)(gbase) + (voff)[_i]), (LAS unsigned*)(lds + (bufoff) + ldsw + _i * 8192), 16, 0, 0); } while (0)
#define PG8_LDA(dst, b, h) do { _Pragma("unroll") for (int m = 0; m < 4; ++m) _Pragma("unroll") for (int k = 0; k < 2; ++k) dst[m][k] = *(const LAS bf16x8*)(lds + PG8_SA(b, h) + aoff + m * 2048 + k * 1024); } while (0)
#define PG8_LDB(dst, b, h) do { _Pragma("unroll") for (int n = 0; n < 2; ++n) _Pragma("unroll") for (int k = 0; k < 2; ++k) dst[n][k] = *(const LAS bf16x8*)(lds + PG8_SB(b, h) + boff + n * 2048 + k * 1024); } while (0)
#define PG8_MMA(ai, bj, At, Bt) do { __builtin_amdgcn_s_setprio(1); _Pragma("unroll") for (int m = 0; m < 4; ++m) _Pragma("unroll") for (int n = 0; n < 2; ++n) _Pragma("unroll") for (int k = 0; k < 2; ++k) \
        acc[ai][bj][m][n] = __builtin_amdgcn_mfma_f32_16x16x32_bf16(Bt[n][k], At[m][k], acc[ai][bj][m][n], 0, 0, 0); __builtin_amdgcn_s_setprio(0); } while (0)
#define PG8_WAIT_V(n) asm volatile("s_waitcnt vmcnt(" #n ")" ::: "memory")
#define PG8_WAIT_L(n) asm volatile("s_waitcnt lgkmcnt(" #n ")" ::: "memory")
#define PG8_BAR __builtin_amdgcn_s_barrier()
#define PG8_SCHED __builtin_amdgcn_sched_barrier(0)
    Unit cur, nxt; int ui = 0;
    if (!S.next(0, cur)) return;
    cur.seq = 0;
    if constexpr (Sched::GATHER) {
#pragma unroll
        for (int i = 0; i < 2; ++i) { voA0[i] = S.a_rowoff(cur, RA[i]) + (unsigned)CA2[i]; voA1[i] = S.a_rowoff(cur, RA[i] + HALF) + (unsigned)CA2[i]; }
    }
    f32x4 acc[2][2][4][2];
#pragma unroll
    for (int a = 0; a < 2; ++a)
#pragma unroll
        for (int b = 0; b < 2; ++b)
#pragma unroll
            for (int m = 0; m < 4; ++m)
#pragma unroll
                for (int n = 0; n < 2; ++n) acc[a][b][m][n] = (f32x4){0.f, 0.f, 0.f, 0.f};
    bf16x8 At[4][2], B0[2][2], B1[2][2];
    const char* cA = S.a_base(cur); const char* cB = S.b_base(cur);
    if constexpr (SP2) {
        PG8_STAGE(PG8_SB(0, 0), cB, voffB); PG8_STAGE(PG8_SB(0, 1), cB + hstepB, voffB); PG8_STAGE(PG8_SA(0, 0), cA, voA0); PG8_STAGE(PG8_SA(0, 1), cA, voA1);
        if (wr == 1) PG8_BAR;
        PG8_WAIT_V(2); PG8_BAR;
        PG8_STAGE(PG8_SB(1, 0), cB + kstep, voffB); PG8_STAGE(PG8_SA(1, 0), cA + kstep, voA0); PG8_STAGE(PG8_SB(1, 1), cB + hstepB + kstep, voffB);
        PG8_WAIT_V(6); PG8_BAR;
    } else {
        PG8_STAGE(PG8_SB(0, 0), cB, voffB); PG8_STAGE(PG8_SA(0, 0), cA, voA0); PG8_STAGE(PG8_SB(0, 1), cB + hstepB, voffB); PG8_STAGE(PG8_SA(0, 1), cA, voA1);
        if (wr == 1) PG8_BAR;
        PG8_WAIT_V(4); PG8_BAR;
        PG8_STAGE(PG8_SB(1, 0), cB + kstep, voffB); PG8_STAGE(PG8_SA(1, 0), cA + kstep, voA0); PG8_STAGE(PG8_SB(1, 1), cB + hstepB + kstep, voffB);
        PG8_WAIT_V(6); PG8_BAR;
    }
    for (;;) {
        const bool has_next = S.next(ui + 1, nxt);
        const char* nA = has_next ? S.a_base(nxt) : cA; const char* nB = has_next ? S.b_base(nxt) : cB;
        if constexpr (Sched::GATHER) {
            if (has_next) {
#pragma unroll
                for (int i = 0; i < 2; ++i) { nvA0[i] = S.a_rowoff(nxt, RA[i]) + (unsigned)CA2[i]; nvA1[i] = S.a_rowoff(nxt, RA[i] + HALF) + (unsigned)CA2[i]; }
            } else {
#pragma unroll
                for (int i = 0; i < 2; ++i) { nvA0[i] = voA0[i]; nvA1[i] = voA1[i]; }
            }
        }
        if constexpr (has_begin<Epi>::value) E.unit_begin(cur, lds, tid);
        const int nt = S.nt(cur);
        for (int t = 0; t < nt; t += 2) {
            const bool last = (t == nt - 2);
            if constexpr (has_mid<Epi>::value) { if (t == Epi::MID_T) E.mid(acc, cur, wr, fr, lds); }
            const char* a1 = cA + (size_t)(t + 1) * kstep;
            const char* a2 = last ? nA : cA + (size_t)(t + 2) * kstep; const char* b2 = last ? nB : cB + (size_t)(t + 2) * kstep;
            const char* a3 = a2 + kstep; const char* b3 = b2 + kstep;
            unsigned w0[2], w1[2];
            if constexpr (Sched::GATHER) {
#pragma unroll
                for (int i = 0; i < 2; ++i) { w0[i] = last ? nvA0[i] : voA0[i]; w1[i] = last ? nvA1[i] : voA1[i]; }
            } else {
#pragma unroll
                for (int i = 0; i < 2; ++i) { w0[i] = voA0[i]; w1[i] = voA1[i]; }
            }
            if constexpr (SP2) {
            PG8_LDB(B0, 0, 0); PG8_LDB(B1, 0, 1); PG8_SCHED; PG8_LDA(At, 0, 0); PG8_STAGE(PG8_SA(1, 1), a1, voA1);
            PG8_WAIT_V(8); PG8_WAIT_L(0); PG8_BAR; PG8_MMA(0, 0, At, B0); PG8_MMA(0, 1, At, B1); PG8_BAR; PG8_SCHED;
            PG8_LDA(At, 0, 1); PG8_STAGE(PG8_SB(0, 0), b2, voffB); PG8_STAGE(PG8_SB(0, 1), b2 + hstepB, voffB); PG8_STAGE(PG8_SA(0, 0), a2, w0);
            PG8_WAIT_V(8); PG8_WAIT_L(0); PG8_BAR; PG8_MMA(1, 0, At, B0); PG8_MMA(1, 1, At, B1); PG8_BAR; PG8_SCHED;
            PG8_LDB(B0, 1, 0); PG8_LDB(B1, 1, 1); PG8_SCHED; PG8_LDA(At, 1, 0); PG8_STAGE(PG8_SA(0, 1), a2, w1);
            PG8_WAIT_V(8); PG8_WAIT_L(0); PG8_BAR; PG8_MMA(0, 0, At, B0); PG8_MMA(0, 1, At, B1); PG8_BAR; PG8_SCHED;
            PG8_LDA(At, 1, 1); PG8_STAGE(PG8_SB(1, 0), b3, voffB); PG8_STAGE(PG8_SB(1, 1), b3 + hstepB, voffB); PG8_STAGE(PG8_SA(1, 0), a3, w0);
            PG8_WAIT_V(8); PG8_WAIT_L(0); PG8_BAR; PG8_MMA(1, 0, At, B0); PG8_MMA(1, 1, At, B1); PG8_BAR; PG8_SCHED;
            } else {
            PG8_LDB(B0, 0, 0); PG8_SCHED; PG8_LDA(At, 0, 0); PG8_STAGE(PG8_SA(1, 1), a1, voA1);
            PG8_WAIT_L(8); PG8_BAR; PG8_WAIT_L(0); PG8_MMA(0, 0, At, B0); PG8_BAR; PG8_SCHED;
            PG8_LDB(B1, 0, 1); PG8_STAGE(PG8_SB(0, 0), b2, voffB);
            PG8_BAR; PG8_WAIT_L(0); PG8_MMA(0, 1, At, B1); PG8_BAR;
            PG8_LDA(At, 0, 1); PG8_STAGE(PG8_SA(0, 0), a2, w0);
            PG8_BAR; PG8_WAIT_L(0); PG8_MMA(1, 0, At, B0); PG8_BAR; PG8_SCHED;
            PG8_STAGE(PG8_SB(0, 1), b2 + hstepB, voffB);
            PG8_WAIT_V(6); PG8_BAR; PG8_MMA(1, 1, At, B1); PG8_BAR;
            PG8_LDB(B0, 1, 0); PG8_SCHED; PG8_LDA(At, 1, 0); PG8_STAGE(PG8_SA(0, 1), a2, w1);
            PG8_WAIT_L(8); PG8_BAR; PG8_WAIT_L(0); PG8_MMA(0, 0, At, B0); PG8_BAR; PG8_SCHED;
            PG8_LDB(B1, 1, 1); PG8_STAGE(PG8_SB(1, 0), b3, voffB);
            PG8_BAR; PG8_WAIT_L(0); PG8_MMA(0, 1, At, B1); PG8_BAR;
            PG8_LDA(At, 1, 1); PG8_STAGE(PG8_SA(1, 0), a3, w0);
            PG8_BAR; PG8_WAIT_L(0); PG8_MMA(1, 0, At, B0); PG8_BAR; PG8_SCHED;
            PG8_STAGE(PG8_SB(1, 1), b3 + hstepB, voffB);
            PG8_WAIT_V(6); PG8_BAR; PG8_MMA(1, 1, At, B1); PG8_BAR;
            }
        }
        if constexpr (ALIGN_EPI) { if (wr == 0) PG8_BAR; }
        if constexpr (!Epi::AFTER_DRAIN) { int fr_ = fr, fq_ = fq; asm volatile("" : "+v"(fr_), "+v"(fq_));
            epi_apply(E, acc, cur, wr, wc, fr_, fq_); }
        if (!has_next) break;
#pragma unroll
        for (int a = 0; a < 2; ++a)
#pragma unroll
            for (int b = 0; b < 2; ++b)
#pragma unroll
                for (int m = 0; m < 4; ++m)
#pragma unroll
                    for (int n = 0; n < 2; ++n) acc[a][b][m][n] = (f32x4){0.f, 0.f, 0.f, 0.f};
        cur = nxt; cA = nA; cB = nB; ++ui; cur.seq = ui;
        if constexpr (Sched::GATHER) {
#pragma unroll
            for (int i = 0; i < 2; ++i) { voA0[i] = nvA0[i]; voA1[i] = nvA1[i]; }
        }
        if constexpr (ALIGN_EPI) { if (wr == 1) PG8_BAR; }
    }
    PG8_WAIT_V(0);
    if constexpr (!ALIGN_EPI) { if (wr == 0) PG8_BAR; }
    PG8_BAR;
    if constexpr (Epi::AFTER_DRAIN) { int fr_ = fr, fq_ = fq, lane_ = lane; asm volatile("" : "+v"(fr_), "+v"(fq_), "+v"(lane_)); E.fused(acc, cur, wr, wc, fr_, fq_, lds, wid, lane_); }
#undef PG8_SA
#undef PG8_SB
#undef PG8_STAGE
#undef PG8_LDA
#undef PG8_LDB
#undef PG8_MMA
#undef PG8_WAIT_V
#undef PG8_WAIT_L
#undef PG8_BAR
#undef PG8_SCHED
}
}
using pg8::Unit;

struct DenseSched {
    static constexpr bool GATHER = false;
    const char* A; const char* Bt; unsigned lda, ldb; int nM, nN, ntk, G, c;
    __device__ __forceinline__ bool next(int i, Unit& u) const { return pg8::static_unit(i, G, c, nM, nN, u); }
    __device__ __forceinline__ int nt(const Unit&) const { return ntk; }
    __device__ __forceinline__ const char* a_base(const Unit& u) const { return A + (size_t)u.pm * 256 * lda; }
    __device__ __forceinline__ const char* b_base(const Unit& u) const { return Bt + (size_t)u.pn * 256 * ldb; }
    __device__ __forceinline__ unsigned a_rowoff(const Unit&, int) const { return 0; }
};
struct SsmSSched {
    static constexpr bool GATHER = false;
    const char* U; const char* W; unsigned lda, ldb; int G, c;
    __device__ __forceinline__ bool next(int i, Unit& u) const { const int L = i * G + c; if (L >= NG * SSM_RT) return false; u.aux = L / SSM_RT; u.pm = L % SSM_RT; u.pn = 0; u.kp = -1; return true; }
    __device__ __forceinline__ int nt(const Unit&) const { return NYC / 64; }
    __device__ __forceinline__ const char* a_base(const Unit& u) const { return U + ((size_t)(u.aux * NROWG + u.pm * 256) * UAW + 128) * 2; }
    __device__ __forceinline__ const char* b_base(const Unit& u) const { return W + (size_t)u.aux * 256 * NYC * 2; }
    __device__ __forceinline__ unsigned a_rowoff(const Unit&, int) const { return 0; }
};
struct SsmYSched {
    static constexpr bool GATHER = false;
    const char* U; const char* W; unsigned lda, ldb; int G, c;
    __device__ __forceinline__ bool next(int i, Unit& u) const { const int L = i * G + c; if (L >= NG * SSM_RT * SSM_CT) return false; const int rem = L % (NG * SSM_RT);
        u.pn = SSM_CT - 1 - L / (NG * SSM_RT); u.aux = rem / SSM_RT; u.pm = rem % SSM_RT; u.kp = -1; return true; }
    __device__ __forceinline__ int nt(const Unit& u) const { return 2 + 4 * (u.pn + 1); }
    __device__ __forceinline__ const char* a_base(const Unit& u) const { return U + (size_t)(u.aux * NROWG + u.pm * 256) * UAW * 2; }
    __device__ __forceinline__ const char* b_base(const Unit& u) const { return W + (size_t)(u.aux * NYC + u.pn * 256) * UAW * 2; }
    __device__ __forceinline__ unsigned a_rowoff(const Unit&, int) const { return 0; }
};
struct MoeSched {
    static constexpr bool GATHER = true;
    const char* A; const char* Bt; unsigned lda, ldb; size_t bstride; int nN, ntk, G, c;
    const int* tile_e; const int* slot_tok; const int* ntp;
    __device__ __forceinline__ bool next(int i, Unit& u) const { const int ntiles = *ntp; if (!pg8::static_unit(i, G, c, ntiles, nN, u)) return false; u.aux = tile_e[u.pm]; return true; }
    __device__ __forceinline__ int nt(const Unit&) const { return ntk; }
    __device__ __forceinline__ const char* a_base(const Unit&) const { return A; }
    __device__ __forceinline__ const char* b_base(const Unit& u) const { return Bt + (size_t)u.aux * bstride + (size_t)u.pn * 256 * ldb; }
    __device__ __forceinline__ unsigned a_rowoff(const Unit& u, int r) const { const int s = u.pm * 256 + r; if (slot_tok) { int t = slot_tok[s]; t = t < 0 ? 0 : t; return (unsigned)t * lda; } return (unsigned)s * lda; }
};

constexpr int KSPLIT = 7, MOE_LEFT_ROWS = 2048;
struct MoeDownSched {
    static constexpr bool GATHER = false;
    const char* A; const char* Bt; unsigned lda, ldb; size_t bstride; int G, c; const int* tile_e; const int* ntp;
    __device__ __forceinline__ bool next(int i, Unit& u) const { const int T = *ntp, Tm = T & ~63, nmain = Tm * 4, nmini = (T - Tm) * 4 * KSPLIT;
        const int nr = nmain > c ? (nmain - c + G - 1) / G : 0;
        if (i < nr) { pg8::static_unit(i, G, c, Tm, 4, u); u.aux = tile_e[u.pm]; return true; }
        const int j = (i - nr) * G + c; if (j >= nmini) return false;
        u.pm = Tm + j / (4 * KSPLIT); u.pn = (j / KSPLIT) & 3; u.kp = j % KSPLIT; u.aux = tile_e[u.pm]; return true; }
    __device__ __forceinline__ int nt(const Unit& u) const { return u.kp < 0 ? FFE / 64 : FFE / 64 / KSPLIT; }
    __device__ __forceinline__ const char* a_base(const Unit& u) const { return A + (size_t)u.pm * 256 * lda + (u.kp < 0 ? (size_t)0 : (size_t)u.kp * (FFE / KSPLIT) * 2); }
    __device__ __forceinline__ const char* b_base(const Unit& u) const { return Bt + (size_t)u.aux * bstride + (size_t)u.pn * 256 * ldb + (u.kp < 0 ? (size_t)0 : (size_t)u.kp * (FFE / KSPLIT) * 2); }
    __device__ __forceinline__ unsigned a_rowoff(const Unit&, int) const { return 0; }
};
static_assert((FFE / 64) % (2 * KSPLIT) == 0 && FFE / 64 / KSPLIT >= 4, "K-split parts: an even number of K-tiles, >= 4");

__device__ __forceinline__ v4u pack8(const f32x4& a, const f32x4& b) { v4u w; w.x = pk2(a[0], a[1]); w.y = pk2(a[2], a[3]); w.z = pk2(b[0], b[1]); w.w = pk2(b[2], b[3]); return w; }
struct EpiInProj {
    static constexpr bool PERM = true, AFTER_DRAIN = false; bf16* UA; bf16* PL;
    __device__ __forceinline__ void put8(const Unit& u, int r, int c, const f32x4& v0, const f32x4& v1) const {
        const int m = u.pm * 256 + r, col = u.pn * 256 + c; bf16* dst;
        if (col < 512) { const int g = col >> 4, hc = col & 15, b = m >> 12, l = m & 4095; dst = UA + ((size_t)(g * NROWG + b * NCH + l / TCH) * UAW + 128 + (l % TCH) * 16 + hc); }
        else dst = PL + (size_t)m * 512 + (col - 512);
        *(GAS v4u*)dst = pack8(v0, v1); }
};
struct EpiBf16 {
    static constexpr bool PERM = true, AFTER_DRAIN = false; bf16* O; int ldc;
    __device__ __forceinline__ void put8(const Unit& u, int r, int c, const f32x4& v0, const f32x4& v1) const { *(GAS v4u*)(O + (size_t)(u.pm * 256 + r) * ldc + u.pn * 256 + c) = pack8(v0, v1); }
};
constexpr int RS_OFF = pg8::STAGE_BYTES + 1024;
__device__ __forceinline__ void rs_begin(const float* SSp, const Unit& u, LAS unsigned char* lds, int tid) {
    if (tid < 256) { const GAS f32x4* p = (const GAS f32x4*)(SSp + (size_t)(u.pm * 256 + tid) * 16); const f32x4 a = p[0], b = p[1], c = p[2], d = p[3];
        const float ss = ((a[0] + a[1]) + (a[2] + a[3])) + ((b[0] + b[1]) + (b[2] + b[3])) + ((c[0] + c[1]) + (c[2] + c[3])) + ((d[0] + d[1]) + (d[2] + d[3]));
        ((LAS float*)(lds + RS_OFF + (u.seq & 1) * 2048))[tid] = 1.f / sqrtf(ss * (1.f / DM) + EPS); }
}
struct EpiInProjRs {
    static constexpr bool PERM = true, AFTER_DRAIN = false, BEGIN = true; bf16* UA; bf16* PL; const float* SSp; LAS unsigned char* L;
    __device__ __forceinline__ void unit_begin(const Unit& u, LAS unsigned char* lds, int tid) const { rs_begin(SSp, u, lds, tid); }
    __device__ __forceinline__ void put8(const Unit& u, int r, int c, const f32x4& v0, const f32x4& v1) const {
        const float q = ((const LAS float*)(L + RS_OFF + (u.seq & 1) * 2048))[r];
        const int m = u.pm * 256 + r, col = u.pn * 256 + c; bf16* dst;
        if (col < 512) { const int g = col >> 4, hc = col & 15, b = m >> 12, l = m & 4095; dst = UA + ((size_t)(g * NROWG + b * NCH + l / TCH) * UAW + 128 + (l % TCH) * 16 + hc); }
        else dst = PL + (size_t)m * 512 + (col - 512);
        *(GAS v4u*)dst = pack8(v0 * q, v1 * q); }
};
struct EpiSwigluRs {
    static constexpr bool PERM = true, AFTER_DRAIN = false, PAIR = true, BEGIN = true; bf16* ACT; int ldact; const float* SSp; LAS unsigned char* L;
    __device__ __forceinline__ void unit_begin(const Unit& u, LAS unsigned char* lds, int tid) const { rs_begin(SSp, u, lds, tid); }
    __device__ __forceinline__ void putpair(const Unit& u, int r, int c, const f32x4& g0_, const f32x4& g1_, const f32x4& u0_, const f32x4& u1_) const {
        const float q = ((const LAS float*)(L + RS_OFF + (u.seq & 1) * 2048))[r];
        const f32x4 g0 = g0_ * q, g1 = g1_ * q, u0 = u0_ * q, u1 = u1_ * q; f32x4 a, b;
#pragma unroll
        for (int j = 0; j < 4; ++j) { a[j] = g0[j] * sigmoidf_(g0[j]) * u0[j]; b[j] = g1[j] * sigmoidf_(g1[j]) * u1[j]; }
        *(GAS v4u*)(ACT + (size_t)(u.pm * 256 + r) * ldact + u.pn * 128 + c) = pack8(a, b); }
};
struct EpiGlu {
    static constexpr bool PERM = true, AFTER_DRAIN = false, CUSTOM = true; const bf16* YG; const float* bias; bf16* MIX; float* SS;
    __device__ __forceinline__ void apply(const f32x4 (&acc)[2][2][4][2], const Unit& u, int wr, int wc, int fr, int fq) const {
#pragma unroll
        for (int ai = 0; ai < 2; ++ai)
#pragma unroll
            for (int mi = 0; mi < 4; ++mi) { const int m = u.pm * 256 + ai * 128 + wr * 64 + mi * 16 + fr; float ssq = 0.f;
#pragma unroll
                for (int bj = 0; bj < 2; ++bj) { const int col = u.pn * 256 + bj * 128 + wc * 32 + 8 * fq; const f32x4& v0 = acc[ai][bj][mi][0]; const f32x4& v1 = acc[ai][bj][mi][1];
                    const v4u yw = *(const GAS v4u*)(YG + (size_t)m * 512 + col); const f32x4 b0 = *(const GAS f32x4*)(bias + col), b1 = *(const GAS f32x4*)(bias + col + 4);
                    f32x4 o0, o1; o0[0] = bflo(yw.x) * sigmoidf_(v0[0] + b0[0]); o0[1] = bfhi(yw.x) * sigmoidf_(v0[1] + b0[1]); o0[2] = bflo(yw.y) * sigmoidf_(v0[2] + b0[2]); o0[3] = bfhi(yw.y) * sigmoidf_(v0[3] + b0[3]);
                    o1[0] = bflo(yw.z) * sigmoidf_(v1[0] + b1[0]); o1[1] = bfhi(yw.z) * sigmoidf_(v1[1] + b1[1]); o1[2] = bflo(yw.w) * sigmoidf_(v1[2] + b1[2]); o1[3] = bfhi(yw.w) * sigmoidf_(v1[3] + b1[3]);
                    ssq += (o0[0] * o0[0] + o0[1] * o0[1]) + (o0[2] * o0[2] + o0[3] * o0[3]) + (o1[0] * o1[0] + o1[1] * o1[1]) + (o1[2] * o1[2] + o1[3] * o1[3]);
                    *(GAS v4u*)(MIX + (size_t)m * 1024 + col) = pack8(o0, o1); }
                ssq += __shfl_xor(ssq, 16); ssq += __shfl_xor(ssq, 32);
                if (fq == 0) ((GAS float*)SS)[(size_t)m * 16 + u.pn * 4 + wc] = ssq;
                asm volatile("" ::: "memory"); }
    }
};
struct EpiSsmY {
    static constexpr bool PERM = true, AFTER_DRAIN = false; bf16* YG;
    __device__ __forceinline__ void put8(const Unit& u, int r, int c, const f32x4& v0, const f32x4& v1) const {
        const int rr = u.pm * 256 + r, n = u.pn * 256 + c, tok = (rr / NCH) * SEQ + (rr % NCH) * TCH + (n >> 4);
        f32x4 a, b;
#pragma unroll
        for (int j = 0; j < 4; ++j) { a[j] = gelu_tanh(v0[j]); b[j] = gelu_tanh(v1[j]); }
        *(GAS v4u*)(YG + (size_t)tok * 512 + u.aux * 16 + (n & 15)) = pack8(a, b); }
};
struct EpiResid {
    static constexpr bool PERM = true, AFTER_DRAIN = false, CUSTOM = true; bf16* HB; float ascale; float* SSo;
    __device__ __forceinline__ void apply(const f32x4 (&acc)[2][2][4][2], const Unit& u, int wr, int wc, int fr, int fq) const {
        bf16* base = HB + (size_t)(u.pm * 256 + wr * 64 + fr) * DM + u.pn * 256 + wc * 32 + 8 * fq;
#pragma unroll
        for (int ai = 0; ai < 2; ++ai) { v4u rv[4][2];
#pragma unroll
            for (int m = 0; m < 4; ++m)
#pragma unroll
                for (int bj = 0; bj < 2; ++bj) rv[m][bj] = *(const GAS v4u*)(base + (size_t)(ai * 128 + m * 16) * DM + bj * 128);
#pragma unroll
            for (int m = 0; m < 4; ++m) { float ssq = 0.f;
#pragma unroll
                for (int bj = 0; bj < 2; ++bj) { const v4u x = rv[m][bj]; const f32x4 a0 = acc[ai][bj][m][0] * ascale, a1 = acc[ai][bj][m][1] * ascale; v4u w;
                    const f32x4 h0 = (f32x4){bflo(x.x), bfhi(x.x), bflo(x.y), bfhi(x.y)} + a0, h1 = (f32x4){bflo(x.z), bfhi(x.z), bflo(x.w), bfhi(x.w)} + a1;
                    ssq += ((h0[0] * h0[0] + h0[1] * h0[1]) + (h0[2] * h0[2] + h0[3] * h0[3])) + ((h1[0] * h1[0] + h1[1] * h1[1]) + (h1[2] * h1[2] + h1[3] * h1[3]));
                    w.x = pk2(h0[0], h0[1]); w.y = pk2(h0[2], h0[3]); w.z = pk2(h1[0], h1[1]); w.w = pk2(h1[2], h1[3]);
                    *(GAS v4u*)(base + (size_t)(ai * 128 + m * 16) * DM + bj * 128) = w; }
                ssq += __shfl_xor(ssq, 16); ssq += __shfl_xor(ssq, 32);
                if (fq == 0) ((GAS float*)SSo)[(size_t)(u.pm * 256 + ai * 128 + wr * 64 + m * 16 + fr) * 16 + u.pn * 4 + wc] = ssq; }
            asm volatile("" ::: "memory"); }
    }
};
struct EpiOutProj {
    static constexpr bool PERM = true, AFTER_DRAIN = false, CUSTOM = true, BEGIN = true; static constexpr int MID_T = 8; bf16* HB; const float* SS; float ascale; LAS unsigned char* L; float* SSo;
    __device__ __forceinline__ void unit_begin(const Unit& u, LAS unsigned char* lds, int tid) const {
        if (tid < 256) { const GAS f32x4* p = (const GAS f32x4*)(SS + (size_t)(u.pm * 256 + tid) * 16); const f32x4 a = p[0], b = p[1], c = p[2], d = p[3];
            const float ss = (a[0] + a[1]) + (a[2] + a[3]) + (b[0] + b[1]) + (b[2] + b[3]), sm = (c[0] + c[1]) + (c[2] + c[3]) + (d[0] + d[1]) + (d[2] + d[3]);
            const float rs = 1.f / sqrtf(ss * (1.f / 512) + EPS), rm = 1.f / sqrtf(sm * (1.f / 512) + EPS);
            ((LAS f32x2*)(lds + RS_OFF + (u.seq & 1) * 2048))[tid] = (f32x2){rs / rm, rm}; }
    }
    __device__ __forceinline__ void mid(f32x4 (&acc)[2][2][4][2], const Unit& u, int wr, int fr, LAS unsigned char* lds) const {
        const LAS f32x2* rsp = (const LAS f32x2*)(lds + RS_OFF + (u.seq & 1) * 2048);
#pragma unroll
        for (int ai = 0; ai < 2; ++ai)
#pragma unroll
            for (int m = 0; m < 4; ++m) { const float q = rsp[ai * 128 + wr * 64 + m * 16 + fr][0];
#pragma unroll
                for (int bj = 0; bj < 2; ++bj)
#pragma unroll
                    for (int n = 0; n < 2; ++n) acc[ai][bj][m][n] *= q; }
    }
    __device__ __forceinline__ void apply(const f32x4 (&acc)[2][2][4][2], const Unit& u, int wr, int wc, int fr, int fq) const {
        const LAS f32x2* rsp = (const LAS f32x2*)(L + RS_OFF + (u.seq & 1) * 2048);
        bf16* base = HB + (size_t)(u.pm * 256 + wr * 64 + fr) * DM + u.pn * 256 + wc * 32 + 8 * fq;
#pragma unroll
        for (int ai = 0; ai < 2; ++ai) { v4u rv[4][2];
#pragma unroll
            for (int m = 0; m < 4; ++m)
#pragma unroll
                for (int bj = 0; bj < 2; ++bj) rv[m][bj] = *(const GAS v4u*)(base + (size_t)(ai * 128 + m * 16) * DM + bj * 128);
#pragma unroll
            for (int m = 0; m < 4; ++m) { const float q = rsp[ai * 128 + wr * 64 + m * 16 + fr][1] * ascale; float ssq = 0.f;
#pragma unroll
                for (int bj = 0; bj < 2; ++bj) { const v4u x = rv[m][bj]; const f32x4 a0 = acc[ai][bj][m][0] * q, a1 = acc[ai][bj][m][1] * q; v4u w;
                    const f32x4 h0 = (f32x4){bflo(x.x), bfhi(x.x), bflo(x.y), bfhi(x.y)} + a0, h1 = (f32x4){bflo(x.z), bfhi(x.z), bflo(x.w), bfhi(x.w)} + a1;
                    ssq += ((h0[0] * h0[0] + h0[1] * h0[1]) + (h0[2] * h0[2] + h0[3] * h0[3])) + ((h1[0] * h1[0] + h1[1] * h1[1]) + (h1[2] * h1[2] + h1[3] * h1[3]));
                    w.x = pk2(h0[0], h0[1]); w.y = pk2(h0[2], h0[3]); w.z = pk2(h1[0], h1[1]); w.w = pk2(h1[2], h1[3]);
                    *(GAS v4u*)(base + (size_t)(ai * 128 + m * 16) * DM + bj * 128) = w; }
                ssq += __shfl_xor(ssq, 16); ssq += __shfl_xor(ssq, 32);
                if (fq == 0) ((GAS float*)SSo)[(size_t)(u.pm * 256 + ai * 128 + wr * 64 + m * 16 + fr) * 16 + u.pn * 4 + wc] = ssq; }
            asm volatile("" ::: "memory"); }
    }
};
struct EpiSwiglu {
    static constexpr bool PERM = true, AFTER_DRAIN = false, PAIR = true; bf16* ACT; int ldact;
    __device__ __forceinline__ void putpair(const Unit& u, int r, int c, const f32x4& g0, const f32x4& g1, const f32x4& u0, const f32x4& u1) const {
        f32x4 a, b;
#pragma unroll
        for (int j = 0; j < 4; ++j) { a[j] = g0[j] * sigmoidf_(g0[j]) * u0[j]; b[j] = g1[j] * sigmoidf_(g1[j]) * u1[j]; }
        *(GAS v4u*)(ACT + (size_t)(u.pm * 256 + r) * ldact + u.pn * 128 + c) = pack8(a, b); }
};
template <bool FINAL> struct EpiMoeDown {
    static constexpr bool PERM = true, AFTER_DRAIN = false, CUSTOM = true; const int* slot_tok; const float* slot_w; bf16* HB; float* out; float ascale; const int* ntp; bf16* PART;
    __device__ __forceinline__ void apply(const f32x4 (&acc)[2][2][4][2], const Unit& u, int wr, int wc, int fr, int fq) const {
        int tok[2][4]; float w[2][4]; const int s0 = u.pm * 256 + wr * 64 + fr;
        const int Tm = (*ntp) & ~63;
#pragma unroll
        for (int ai = 0; ai < 2; ++ai)
#pragma unroll
            for (int m = 0; m < 4; ++m) { tok[ai][m] = ((const GAS int*)slot_tok)[s0 + ai * 128 + m * 16]; w[ai][m] = ((const GAS float*)slot_w)[s0 + ai * 128 + m * 16] * ascale; }
        const int cb = u.pn * 256 + wc * 32 + 8 * fq;
        if (u.kp >= 0) {
            bf16* pb = PART + ((size_t)u.kp * MOE_LEFT_ROWS + (size_t)(u.pm - Tm) * 256 + wr * 64 + fr) * DM + cb;
#pragma unroll
            for (int ai = 0; ai < 2; ++ai)
#pragma unroll
                for (int m = 0; m < 4; ++m)
#pragma unroll
                    for (int bj = 0; bj < 2; ++bj) *(GAS v4u*)(pb + (size_t)(ai * 128 + m * 16) * DM + bj * 128) = pack8(acc[ai][bj][m][0] * w[ai][m], acc[ai][bj][m][1] * w[ai][m]);
            return; }
#pragma unroll
        for (int ai = 0; ai < 2; ++ai) { v4u rv[4][2];
#pragma unroll
            for (int m = 0; m < 4; ++m) { const int t = tok[ai][m] < 0 ? 0 : tok[ai][m];
#pragma unroll
                for (int bj = 0; bj < 2; ++bj) rv[m][bj] = *(const GAS v4u*)(HB + (size_t)t * DM + cb + bj * 128); }
#pragma unroll
            for (int m = 0; m < 4; ++m) { if (tok[ai][m] < 0) continue;
#pragma unroll
                for (int bj = 0; bj < 2; ++bj) { const v4u x = rv[m][bj]; const f32x4 a0 = acc[ai][bj][m][0] * w[ai][m], a1 = acc[ai][bj][m][1] * w[ai][m];
                    const f32x4 r0 = {bflo(x.x) + a0[0], bfhi(x.x) + a0[1], bflo(x.y) + a0[2], bfhi(x.y) + a0[3]}, r1 = {bflo(x.z) + a1[0], bfhi(x.z) + a1[1], bflo(x.w) + a1[2], bfhi(x.w) + a1[3]};
                    if constexpr (FINAL) { GAS f32x4* o = (GAS f32x4*)(out + (size_t)tok[ai][m] * DM + cb + bj * 128); o[0] = r0; o[1] = r1; }
                    else *(GAS v4u*)(HB + (size_t)tok[ai][m] * DM + cb + bj * 128) = pack8(r0, r1); } }
            asm volatile("" ::: "memory"); }
    }
};
struct EpiSsmS {
    static constexpr bool PERM = false, AFTER_DRAIN = true; bf16* UA; const float* aT;
    __device__ __forceinline__ void fused(const f32x4 (&acc)[2][2][4][2], const Unit& u, int wr, int wc, int fr, int fq, LAS unsigned char* lds, int wid, int lane) const {
        LAS float* T = (LAS float*)lds;
#pragma unroll
        for (int ai = 0; ai < 2; ++ai)
#pragma unroll
            for (int m = 0; m < 4; ++m) { const int r = ai * 128 + wr * 64 + m * 16 + fr;
#pragma unroll
                for (int n = 0; n < 2; ++n) *(LAS f32x4*)(T + r * 128 + wc * 32 + 16 * n + 4 * fq) = acc[ai][0][m][n]; }
        LDS_WAIT(); __builtin_amdgcn_s_barrier(); asm volatile("" ::: "memory");
        const int tid = wid * 64 + lane;
        if (tid < 64 * (256 / NCH)) { const int bl = tid >> 6, p = tid & 63, g = u.aux; const float ar = aT[(g * 64 + p) * 2], ai_ = aT[(g * 64 + p) * 2 + 1]; float sr = 0.f, si = 0.f;
            bf16* dst = UA + (size_t)(g * NROWG + u.pm * 256 + bl * NCH) * UAW;
            for (int c = 0; c < NCH; ++c) { dst[(size_t)c * UAW + p] = f2bf(sr); dst[(size_t)c * UAW + 64 + p] = f2bf(si);
                const float lr = T[(bl * NCH + c) * 128 + p], li = T[(bl * NCH + c) * 128 + 64 + p]; const float nr = ar * sr - ai_ * si + lr, ni = ar * si + ai_ * sr + li; sr = nr; si = ni; } }
        LDS_WAIT(); __builtin_amdgcn_s_barrier(); asm volatile("" ::: "memory");
    }
};

struct RmId { int off; __device__ __forceinline__ int operator()(int n) const { return off + n; } };
struct RmGU { int up; __device__ __forceinline__ int operator()(int n) const { return 256 * (n >> 7) + 128 * up + (n & 127); } };
struct KgNone { __device__ __forceinline__ float operator()(int) const { return 1.f; } };
struct KgVec { const float* g; __device__ __forceinline__ float operator()(int k) const { return ((const GAS float*)g)[k]; } };
struct KgOut { const float* gs; const float* gm; __device__ __forceinline__ float operator()(int k) const { return k < 512 ? ((const GAS float*)gs)[k] : ((const GAS float*)gm)[k - 512]; } };
template <class RowMap, class KG = KgNone> __device__ __forceinline__ void tr_matrix(const float* W, int K, int N, bf16* WT, int ldt, RowMap rm, LAS float* scr, int gw, int NGW, int lane, KG kg = KG()) { asm volatile("" : "+v"(lane));
    const int nnb = N / 32, items = (K / 64) * nnb; const int rr = lane >> 3, c4 = (lane & 7) * 4, c = lane & 7;
    int it = gw; if (it >= items) return;
    f32x4 v[8];
#pragma unroll
    for (int i = 0; i < 8; ++i) v[i] = *(const GAS f32x4*)(W + (size_t)(64 * (it / nnb) + 8 * i + rr) * N + 32 * (it % nnb) + c4);
    for (;;) {
        const int k0 = 64 * (it / nnb), n0 = 32 * (it % nnb), nx = it + NGW; const bool more = nx < items;
#pragma unroll
        for (int i = 0; i < 8; ++i) { LAS float* d = scr + (8 * i + rr) * 33 + c4; const float g_ = kg(k0 + 8 * i + rr); d[0] = v[i][0] * g_; d[1] = v[i][1] * g_; d[2] = v[i][2] * g_; d[3] = v[i][3] * g_; }
        if (more) {
#pragma unroll
            for (int i = 0; i < 8; ++i) v[i] = *(const GAS f32x4*)(W + (size_t)(64 * (nx / nnb) + 8 * i + rr) * N + 32 * (nx % nnb) + c4); }
        LDS_WAIT(); asm volatile("" ::: "memory");
#pragma unroll
        for (int j = 0; j < 4; ++j) { const int n = (lane >> 3) + 8 * j; const LAS float* sp = scr + (8 * c) * 33 + n;
            v4u o; o.x = pk2(sp[0 * 33], sp[1 * 33]); o.y = pk2(sp[2 * 33], sp[3 * 33]); o.z = pk2(sp[4 * 33], sp[5 * 33]); o.w = pk2(sp[6 * 33], sp[7 * 33]);
            *(GAS v4u*)(WT + (size_t)rm(n0 + n) * ldt + k0 + 8 * c) = o; }
        LDS_WAIT(); asm volatile("" ::: "memory");
        if (!more) break; it = nx;
    }
}
__device__ __forceinline__ void zero_bf16(bf16* p, size_t n8  , int gtid, int gthreads) { asm volatile("" : "+v"(gtid)); for (size_t i = gtid; i < n8; i += gthreads) ((v4u*)p)[i] = (v4u){0u, 0u, 0u, 0u}; }

__device__ __forceinline__ void conv_small(unsigned char* ws_, int layer, LAS float* scr, int gw, int NGW, int lane, int gtid, int gthreads) {
    unsigned char* wb = ws_ + WS_WSMALL + (size_t)layer * WSM_STRIDE;
    bf16* Win_t = (bf16*)(wb + WSM_IN); bf16* Wglu_t = (bf16*)(wb + WSM_GLU); bf16* Wq_t = (bf16*)(wb + WSM_Q); bf16* Wkv_t = (bf16*)(wb + WSM_KV); bf16* Wout_t = (bf16*)(wb + WSM_OUT);
    tr_matrix(kin(I_W_IN) + (size_t)layer * DM * DIN, DM, DIN, Win_t, DM, RmId{0}, scr, gw, NGW, lane, KgVec{kin(I_ATTN_NORM) + layer * DM});
    zero_bf16(Win_t + (size_t)DIN * DM, (size_t)(1024 - DIN) * DM / 8, gtid, gthreads);
    tr_matrix(kin(I_W_GLU) + (size_t)layer * DSSM * DSSM, DSSM, DSSM, Wglu_t, DSSM, RmId{0}, scr, gw, NGW, lane);
    tr_matrix(kin(I_W_Q_UP) + (size_t)layer * QRANK * 768, QRANK, 768, Wq_t, QRANK, RmId{0}, scr, gw, NGW, lane);
    tr_matrix(kin(I_W_KV_UP) + (size_t)layer * KVRANK * 1024, KVRANK, 1024, Wkv_t, 256, RmId{0}, scr, gw, NGW, lane);
    asm volatile("" : "+v"(gtid));
    for (int i = gtid; i < 1024 * 16; i += gthreads) ((v4u*)(Wkv_t + (size_t)(i >> 4) * 256 + 128))[i & 15] = (v4u){0u, 0u, 0u, 0u};
    tr_matrix(kin(I_W_OUT) + (size_t)layer * DM * DM, DM, DM, Wout_t, DM, RmId{0}, scr, gw, NGW, lane, KgOut{kin(I_SSM_OUT_NORM) + layer * DSSM, kin(I_MLA_OUT_NORM) + layer * DSSM});
}
__device__ __forceinline__ void conv_dense(unsigned char* ws_, LAS float* scr, int gw, int NGW, int lane) {
    bf16* Wgu = (bf16*)(ws_ + WS_BIGW + BW_DGU); bf16* Wd = (bf16*)(ws_ + WS_BIGW + BW_DD);
    tr_matrix(kin(I_DW_GATE), DM, FFD, Wgu, DM, RmGU{0}, scr, gw, NGW, lane, KgVec{kin(I_FFN_NORM)});
    tr_matrix(kin(I_DW_UP), DM, FFD, Wgu, DM, RmGU{1}, scr, gw, NGW, lane, KgVec{kin(I_FFN_NORM)});
    tr_matrix(kin(I_DW_DOWN), FFD, DM, Wd, FFD, RmId{0}, scr, gw, NGW, lane);
}
__device__ __forceinline__ void conv_moe(unsigned char* ws_, LAS float* scr, int gw, int NGW, int lane) {
    bf16* Wgu = (bf16*)(ws_ + WS_BIGW + BW_MGU); bf16* Wd = (bf16*)(ws_ + WS_BIGW + BW_MD);
    for (int e = 0; e < NE; ++e) {
        tr_matrix(kin(I_MW_GATE) + (size_t)e * DM * FFE, DM, FFE, Wgu + (size_t)e * 2 * FFE * DM, DM, RmGU{0}, scr, gw, NGW, lane);
        tr_matrix(kin(I_MW_UP) + (size_t)e * DM * FFE, DM, FFE, Wgu + (size_t)e * 2 * FFE * DM, DM, RmGU{1}, scr, gw, NGW, lane);
        tr_matrix(kin(I_MW_DOWN) + (size_t)e * FFE * DM, FFE, DM, Wd + (size_t)e * DM * FFE, FFE, RmId{0}, scr, gw, NGW, lane);
    }
}
__device__ __forceinline__ void rms_row(const float* xrow, const float* g, bf16* orow, int lane) {
    const GAS f32x4* xr = (const GAS f32x4*)xrow + lane; const GAS f32x4* gr = (const GAS f32x4*)g + lane; f32x4 v[4]; float s = 0.f;
#pragma unroll
    for (int j = 0; j < 4; ++j) { v[j] = xr[64 * j]; s += (v[j][0] * v[j][0] + v[j][1] * v[j][1]) + (v[j][2] * v[j][2] + v[j][3] * v[j][3]); }
    const float rstd = 1.f / sqrtf(wave_sum(s) * (1.f / DM) + EPS);
    GAS v2u* o8 = (GAS v2u*)orow + lane;
#pragma unroll
    for (int j = 0; j < 4; ++j) { const f32x4 gg = gr[64 * j]; v2u w; w.x = pk2(v[j][0] * rstd * gg[0], v[j][1] * rstd * gg[1]); w.y = pk2(v[j][2] * rstd * gg[2], v[j][3] * rstd * gg[3]); o8[64 * j] = w; }
}
__device__ __forceinline__ void rms_row_b(const bf16* xrow, const float* g, bf16* orow, int lane) {
    const v4u a = *((const GAS v4u*)xrow + lane), b = *((const GAS v4u*)xrow + 64 + lane);
    float v[16] = {bflo(a.x), bfhi(a.x), bflo(a.y), bfhi(a.y), bflo(a.z), bfhi(a.z), bflo(a.w), bfhi(a.w), bflo(b.x), bfhi(b.x), bflo(b.y), bfhi(b.y), bflo(b.z), bfhi(b.z), bflo(b.w), bfhi(b.w)}; float s = 0.f;
#pragma unroll
    for (int j = 0; j < 16; ++j) s += v[j] * v[j];
    const float rstd = 1.f / sqrtf(wave_sum(s) * (1.f / DM) + EPS);
    const f32x4 g0 = *((const GAS f32x4*)g + 2 * lane), g1 = *((const GAS f32x4*)g + 2 * lane + 1), g2 = *((const GAS f32x4*)g + 128 + 2 * lane), g3 = *((const GAS f32x4*)g + 128 + 2 * lane + 1);
    v4u w; w.x = pk2(v[0] * rstd * g0[0], v[1] * rstd * g0[1]); w.y = pk2(v[2] * rstd * g0[2], v[3] * rstd * g0[3]); w.z = pk2(v[4] * rstd * g1[0], v[5] * rstd * g1[1]); w.w = pk2(v[6] * rstd * g1[2], v[7] * rstd * g1[3]);
    *((GAS v4u*)orow + lane) = w;
    w.x = pk2(v[8] * rstd * g2[0], v[9] * rstd * g2[1]); w.y = pk2(v[10] * rstd * g2[2], v[11] * rstd * g2[3]); w.z = pk2(v[12] * rstd * g3[0], v[13] * rstd * g3[1]); w.w = pk2(v[14] * rstd * g3[2], v[15] * rstd * g3[3]);
    *((GAS v4u*)orow + 64 + lane) = w;
}
__device__ __forceinline__ void ph_rmsnorm_b(const bf16* HB, const float* g, bf16* Z, int gw, int NGW, int lane) { asm volatile("" : "+v"(lane)); for (int m = gw; m < M; m += NGW) rms_row_b(HB + (size_t)m * DM, g, Z + (size_t)m * DM, lane); }
__device__ __forceinline__ void ph_x2hb(const float* x, bf16* HB, float* SSo, int gw, int NGW, int lane) { asm volatile("" : "+v"(lane));
    constexpr int R = 2;
    for (int mb = gw * R; mb < M; mb += NGW * R) { f32x4 v[R][4];
#pragma unroll
        for (int r = 0; r < R; ++r)
#pragma unroll
            for (int j = 0; j < 4; ++j) v[r][j] = *((const GAS f32x4*)(x + (size_t)(mb + r) * DM) + 64 * j + lane);
#pragma unroll
        for (int r = 0; r < R; ++r) { const int m = mb + r; float s = 0.f;
#pragma unroll
            for (int j = 0; j < 4; ++j) s += (v[r][j][0] * v[r][j][0] + v[r][j][1] * v[r][j][1]) + (v[r][j][2] * v[r][j][2] + v[r][j][3] * v[r][j][3]);
            s = wave_sum(s);
            GAS v2u* h8 = (GAS v2u*)(HB + (size_t)m * DM) + lane;
#pragma unroll
            for (int j = 0; j < 4; ++j) { v2u hw; hw.x = pk2(v[r][j][0], v[r][j][1]); hw.y = pk2(v[r][j][2], v[r][j][3]); h8[64 * j] = hw; }
            if (lane < 4) ((GAS f32x4*)(SSo + (size_t)m * 16))[lane] = (f32x4){lane == 0 ? s : 0.f, 0.f, 0.f, 0.f}; } }
}
__device__ __forceinline__ void ph_rmsnorm(const float* h, const float* g, bf16* Z, int gw, int NGW, int lane) { asm volatile("" : "+v"(lane)); for (int m = gw; m < M; m += NGW) rms_row(h + (size_t)m * DM, g, Z + (size_t)m * DM, lane); }
__device__ __forceinline__ void ph_latnorm(const bf16* PL, const float* gq, const float* gkv, bf16* LAT, int gw, int NGW, int lane) { asm volatile("" : "+v"(lane));
    constexpr int R = 8;
    const f32x4 g4 = *((const GAS f32x4*)gq + lane); const f32x2 g2 = *((const GAS f32x2*)gkv + lane);
    for (int mb = gw * R; mb < M; mb += NGW * R) { v2u qa[R]; unsigned ka[R];
#pragma unroll
        for (int r = 0; r < R; ++r) { qa[r] = *((const GAS v2u*)(PL + (size_t)(mb + r) * 512) + lane); ka[r] = *((const GAS unsigned*)(PL + (size_t)(mb + r) * 512 + 256) + lane); }
#pragma unroll
        for (int r = 0; r < R; ++r) { const int m = mb + r;
            const float q0 = bflo(qa[r].x), q1 = bfhi(qa[r].x), q2 = bflo(qa[r].y), q3 = bfhi(qa[r].y), k0 = bflo(ka[r]), k1 = bfhi(ka[r]);
            const float rq = 1.f / sqrtf(wave_sum(q0 * q0 + q1 * q1 + q2 * q2 + q3 * q3) * (1.f / 256) + EPS), rk = 1.f / sqrtf(wave_sum(k0 * k0 + k1 * k1) * (1.f / 128) + EPS);
            v2u w; w.x = pk2(q0 * rq * g4[0], q1 * rq * g4[1]); w.y = pk2(q2 * rq * g4[2], q3 * rq * g4[3]); *((GAS v2u*)(LAT + (size_t)m * 512) + lane) = w;
            *((GAS unsigned*)(LAT + (size_t)m * 512 + 256) + lane) = pk2(k0 * rk * g2[0], k1 * rk * g2[1]); *((GAS unsigned*)(LAT + (size_t)m * 512 + 384) + lane) = 0u; } }
}
constexpr float QSCALE = 0.10206207261596575f * 1.4426950408889634f;
__device__ __forceinline__ void ph_qkprep(const bf16* KVR, const bf16* PL, bf16* KN, const float* kg, int gw, int NGW, int lane) { asm volatile("" : "+v"(lane));
    const int hd = lane >> 3, sub = lane & 7;
    float gk[12];
#pragma unroll
    for (int j = 0; j < 8; ++j) gk[j] = ((const GAS float*)kg)[sub * 8 + j];
#pragma unroll
    for (int j = 0; j < 2; ++j) { gk[8 + j] = ((const GAS float*)kg)[64 + sub * 2 + j]; gk[10 + j] = ((const GAS float*)kg)[80 + sub * 2 + j]; }
    const float ir0 = exp2f(-(float)(sub * 2) * (13.287712379549449f / 16.f)) * 0.15915494309189535f, ir1 = exp2f(-(float)(sub * 2 + 1) * (13.287712379549449f / 16.f)) * 0.15915494309189535f;
    constexpr int R = 8;
    for (int mb = gw * R; mb < M; mb += NGW * R) { v4u kn[R]; unsigned kx1[R], kx2[R];
#pragma unroll
        for (int r = 0; r < R; ++r) { const int m = mb + r; const bf16* kp = KVR + (size_t)m * 1024 + hd * 128; const bf16* rp = PL + (size_t)m * 512 + 384;
            kn[r] = *(const GAS v4u*)(kp + sub * 8); kx1[r] = *(const GAS unsigned*)(rp + sub * 2); kx2[r] = *(const GAS unsigned*)(rp + 16 + sub * 2); }
#pragma unroll
        for (int r = 0; r < R; ++r) { const int m = mb + r; const int pos = m & (SEQ - 1);
            const float a0 = __builtin_amdgcn_fractf((float)pos * ir0), a1 = __builtin_amdgcn_fractf((float)pos * ir1);
            const float s0 = __builtin_amdgcn_sinf(a0), c0 = __builtin_amdgcn_cosf(a0), s1 = __builtin_amdgcn_sinf(a1), c1 = __builtin_amdgcn_cosf(a1);
            float k[12] = {bflo(kn[r].x), bfhi(kn[r].x), bflo(kn[r].y), bfhi(kn[r].y), bflo(kn[r].z), bfhi(kn[r].z), bflo(kn[r].w), bfhi(kn[r].w), bflo(kx1[r]), bfhi(kx1[r]), bflo(kx2[r]), bfhi(kx2[r])};
            float sk = 0.f;
#pragma unroll
            for (int j = 0; j < 12; ++j) sk += k[j] * k[j];
            sk += __shfl_xor(sk, 1); sk += __shfl_xor(sk, 2); sk += __shfl_xor(sk, 4);
            const float rk = 1.f / sqrtf(sk * (1.f / 96) + EPS);
#pragma unroll
            for (int j = 0; j < 12; ++j) k[j] *= rk * gk[j];
            const float ka0 = k[8] * c0 - k[10] * s0, kb0 = k[8] * s0 + k[10] * c0, ka1 = k[9] * c1 - k[11] * s1, kb1 = k[9] * s1 + k[11] * c1;
            bf16* ko = KN + (size_t)m * 768 + hd * 96; v4u w;
            w.x = pk2(k[0], k[1]); w.y = pk2(k[2], k[3]); w.z = pk2(k[4], k[5]); w.w = pk2(k[6], k[7]);
            *(GAS v4u*)(ko + sub * 8) = w; *(GAS unsigned*)(ko + 64 + sub * 2) = pk2(ka0, ka1); *(GAS unsigned*)(ko + 80 + sub * 2) = pk2(kb0, kb1); } }
}
__device__ __forceinline__ void ph_outnorm(bf16* MIX, const float* gs, const float* gm, int gw, int NGW, int lane) { asm volatile("" : "+v"(lane));
    for (int m = gw; m < M; m += NGW) { v4u* rp = (v4u*)(MIX + (size_t)m * 1024) + 2 * lane;
        const v4u a = rp[0], b = rp[1]; float v[16] = {bflo(a.x), bfhi(a.x), bflo(a.y), bfhi(a.y), bflo(a.z), bfhi(a.z), bflo(a.w), bfhi(a.w), bflo(b.x), bfhi(b.x), bflo(b.y), bfhi(b.y), bflo(b.z), bfhi(b.z), bflo(b.w), bfhi(b.w)}; float s = 0.f;
#pragma unroll
        for (int j = 0; j < 16; ++j) s += v[j] * v[j];
#pragma unroll
        for (int o = 1; o < 32; o <<= 1) s += __shfl_xor(s, o);
        const float rstd = 1.f / sqrtf(s * (1.f / 512) + EPS); const float* g = (lane < 32 ? gs : gm) + (lane & 31) * 16;
#pragma unroll
        for (int j = 0; j < 16; ++j) v[j] *= rstd * g[j];
        v4u w; w.x = pk2(v[0], v[1]); w.y = pk2(v[2], v[3]); w.z = pk2(v[4], v[5]); w.w = pk2(v[6], v[7]); rp[0] = w;
        w.x = pk2(v[8], v[9]); w.y = pk2(v[10], v[11]); w.z = pk2(v[12], v[13]); w.w = pk2(v[14], v[15]); rp[1] = w; }
}
__device__ __forceinline__ void ph_norm_route(const bf16* HB, const float* g, const float* Wr, bf16* Z, v4u* route, int gw, int NGW, int lane) { asm volatile("" : "+v"(lane));
    float gg[16], wg[16][8];
#pragma unroll
    for (int j = 0; j < 4; ++j) { const f32x4 g4 = *((const GAS f32x4*)g + 64 * j + lane);
#pragma unroll
        for (int q = 0; q < 4; ++q) { gg[4 * j + q] = g4[q]; const GAS f32x4* wr = (const GAS f32x4*)(Wr + (size_t)(256 * j + 4 * lane + q) * 8); const f32x4 wa = wr[0], wb = wr[1];
#pragma unroll
            for (int e = 0; e < 4; ++e) { wg[4 * j + q][e] = wa[e] * g4[q]; wg[4 * j + q][4 + e] = wb[e] * g4[q]; } } }
    constexpr int R = 4;
    for (int mb = gw * R; mb < M; mb += NGW * R) { v2u x[R][4];
#pragma unroll
        for (int r = 0; r < R; ++r)
#pragma unroll
            for (int j = 0; j < 4; ++j) x[r][j] = *((const GAS v2u*)(HB + (size_t)(mb + r) * DM) + 64 * j + lane);
#pragma unroll
        for (int r = 0; r < R; ++r) { const int m = mb + r; float v[16]; float s = 0.f;
#pragma unroll
            for (int j = 0; j < 4; ++j) { v[4 * j] = bflo(x[r][j].x); v[4 * j + 1] = bfhi(x[r][j].x); v[4 * j + 2] = bflo(x[r][j].y); v[4 * j + 3] = bfhi(x[r][j].y); }
#pragma unroll
            for (int i = 0; i < 16; ++i) s += v[i] * v[i];
            const float rstd = 1.f / sqrtf(wave_sum(s) * (1.f / DM) + EPS);
            float lg[8] = {0.f, 0.f, 0.f, 0.f, 0.f, 0.f, 0.f, 0.f};
#pragma unroll
            for (int i = 0; i < 16; ++i)
#pragma unroll
                for (int e = 0; e < 8; ++e) lg[e] += v[i] * wg[i][e];
#pragma unroll
            for (int j = 0; j < 4; ++j) { v2u w; w.x = pk2(v[4 * j] * rstd * gg[4 * j], v[4 * j + 1] * rstd * gg[4 * j + 1]); w.y = pk2(v[4 * j + 2] * rstd * gg[4 * j + 2], v[4 * j + 3] * rstd * gg[4 * j + 3]); *((GAS v2u*)(Z + (size_t)m * DM) + 64 * j + lane) = w; }
            {
              const bool b5 = (lane & 32) != 0, b4 = (lane & 16) != 0, b3 = (lane & 8) != 0; float a4[4], a2[2];
#pragma unroll
              for (int e = 0; e < 4; ++e) a4[e] = (b5 ? lg[e + 4] : lg[e]) + __shfl_xor(b5 ? lg[e] : lg[e + 4], 32);
#pragma unroll
              for (int e = 0; e < 2; ++e) a2[e] = (b4 ? a4[e + 2] : a4[e]) + __shfl_xor(b4 ? a4[e] : a4[e + 2], 16);
              float c1 = (b3 ? a2[1] : a2[0]) + __shfl_xor(b3 ? a2[0] : a2[1], 8);
              c1 += __shfl_xor(c1, 4); c1 += __shfl_xor(c1, 2); c1 += __shfl_xor(c1, 1);
#pragma unroll
              for (int e = 0; e < 8; ++e) lg[e] = __builtin_bit_cast(float, __builtin_amdgcn_readlane(__builtin_bit_cast(int, c1), 8 * e)) * rstd; }
            int e0 = 0; float v0 = lg[0];
#pragma unroll
            for (int e = 1; e < 8; ++e) if (lg[e] > v0) { v0 = lg[e]; e0 = e; }
            int e1 = -1; float v1 = -3.0e38f;
#pragma unroll
            for (int e = 0; e < 8; ++e) if (e != e0 && lg[e] > v1) { v1 = lg[e]; e1 = e; }
            const float w1 = 1.f / (1.f + expf(v0 - v1)), w0 = 1.f - w1;
            if (lane == 0) { ((GAS v2u*)route)[m] = (v2u){(unsigned)e0, (unsigned)e1}; ((GAS f32x2*)((unsigned char*)route + 256 * 1024))[m] = (f32x2){w0, w1}; } } }
}
__device__ __forceinline__ void ph_route_sort(const v4u* route, unsigned char* rt, LAS unsigned char* lds, int tid) { asm volatile("" : "+v"(tid));
    int* slot_tok = (int*)(rt + RT_SLOT_TOK); float* slot_w = (float*)(rt + RT_SLOT_W); int* tile_e = (int*)(rt + RT_TILE_E); int* ntl = (int*)(rt + RT_NTILES);
    const v2u* re = (const v2u*)route; const f32x2* rw = (const f32x2*)((const unsigned char*)route + 256 * 1024);
    LAS int* wtot = (LAS int*)lds;
    LAS int* wbase = wtot + 128;
    LAS int* etot = wbase + 128;
    const int lane = tid & 63, w = tid >> 6;
    int c[16];
#pragma unroll
    for (int j = 0; j < 16; ++j) c[j] = 0;
    for (int i = 0; i < 64; ++i) { const v2u r = re[w * 4096 + i * 64 + lane];
#pragma unroll
        for (int j = 0; j < 8; ++j) { c[j] += __popcll(__ballot(r.x == (unsigned)j)); c[8 + j] += __popcll(__ballot(r.y == (unsigned)j)); } }
    if (lane == 0) {
#pragma unroll
        for (int j = 0; j < 16; ++j) wtot[w * 16 + j] = c[j]; }
    __syncthreads();
    if (tid < 16) { int s = 0; for (int ww = 0; ww < 8; ++ww) { wbase[ww * 16 + tid] = s; s += wtot[ww * 16 + tid]; } etot[tid] = s; }
    __syncthreads();
    if (tid < 2) { int off = 0; for (int e = 0; e < 8; ++e) { const int n = etot[tid * 8 + e]; const int pad = (n + 255) & ~255; etot[16 + tid * 8 + e] = off;
            for (int t = off / 256; t < (off + pad) / 256; ++t) tile_e[tid * MOE_TILES + t] = e; off += pad; } ntl[tid] = off / 256; }
    __syncthreads();
    for (int j = 0; j < 16; ++j) { const int n = etot[j], off = etot[16 + j], pad = (n + 255) & ~255, k = j >> 3; for (int s = off + n + tid; s < off + pad; s += 512) { slot_tok[k * MOE_SLOTS + s] = -1; slot_w[k * MOE_SLOTS + s] = 0.f; } }
#pragma unroll
    for (int j = 0; j < 16; ++j) c[j] = wbase[w * 16 + j] + etot[16 + j];
    const unsigned long long ltmask = (1ull << lane) - 1ull;
    for (int i = 0; i < 64; ++i) { const int m = w * 4096 + i * 64 + lane; const v2u r = re[m]; const f32x2 wv = rw[m]; int s0 = 0, s1 = 0;
#pragma unroll
        for (int j = 0; j < 8; ++j) { const unsigned long long b0 = __ballot(r.x == (unsigned)j), b1 = __ballot(r.y == (unsigned)j);
            if (r.x == (unsigned)j) s0 = c[j] + __popcll(b0 & ltmask); if (r.y == (unsigned)j) s1 = c[8 + j] + __popcll(b1 & ltmask);
            c[j] += __popcll(b0); c[8 + j] += __popcll(b1); }
        slot_tok[s0] = m; slot_w[s0] = wv[0]; slot_tok[MOE_SLOTS + s1] = m; slot_w[MOE_SLOTS + s1] = wv[1]; }
}
__device__ __forceinline__ void ph_ssm_prep(unsigned char* ws_, int layer, int g, int part, LAS unsigned char* lds, int tid) { asm volatile("" : "+v"(tid));
    LAS float* apr = (LAS float*)lds;
    LAS float* api = apr + 64 * TP1;
    LAS float* bbr = api + 64 * TP1;
    LAS float* bbi = bbr + 1024;
    LAS float* ccr = bbi + 1024;
    LAS float* cci = ccr + 1024;
    LAS float* kt = cci + 1024;
    constexpr int BAND = TCH / 8;
    const float* A_re = kin(I_A_RE) + (size_t)(layer * NG + g) * NP; const float* A_im = kin(I_A_IM) + (size_t)(layer * NG + g) * NP;
    const float step = expf(kin(I_LOG_STEP)[layer * NG + g]);
    const float* B_re = kin(I_B_RE) + (size_t)(layer * NG + g) * NP * GH; const float* B_im = kin(I_B_IM) + (size_t)(layer * NG + g) * NP * GH;
    const float* C_re = kin(I_C_RE) + (size_t)(layer * NG + g) * GH * NP; const float* C_im = kin(I_C_IM) + (size_t)(layer * NG + g) * GH * NP;
    const float* Dv = kin(I_D) + (size_t)(layer * NG + g) * GH;
    for (int i = tid; i < 64 * TP1; i += 512) { const int p = i / TP1, tau = i % TP1; const float e = expf(A_re[p] * step * (float)tau); float sn, cs; sincosf(A_im[p] * step * (float)tau, &sn, &cs); apr[i] = e * cs; api[i] = e * sn; }
    for (int i = tid; i < 1024; i += 512) { const int p = i >> 4; const float lr = A_re[p], li = A_im[p]; const float e = expf(lr * step); float sn, cs; sincosf(li * step, &sn, &cs);
        const float nr = e * cs - 1.f, ni = e * sn, den = lr * lr + li * li, sr = (nr * lr + ni * li) / den, si = (ni * lr - nr * li) / den;
        const float br = B_re[i], bi = B_im[i]; bbr[i] = br * sr - bi * si; bbi[i] = br * si + bi * sr; ccr[i] = C_re[i]; cci[i] = C_im[i]; }
    __syncthreads();
    for (int i = tid; i < BAND * 256; i += 512) { const int tau = BAND * part + (i >> 8), h = (i >> 4) & 15, h2 = i & 15; float s = 0.f;
        for (int p = 0; p < 64; ++p) { const float cr = ccr[h * 64 + p], ci = cci[h * 64 + p], ar = apr[p * TP1 + tau], ai = api[p * TP1 + tau], br = bbr[p * 16 + h2], bi = bbi[p * 16 + h2];
            const float xr = cr * ar - ci * ai, xi = cr * ai + ci * ar; s += xr * br - xi * bi; }
        if (tau == 0 && h == h2) s += Dv[h];
        kt[i] = s; }
    if (part == 0 && tid < 64) { float* aT = (float*)(ws_ + WS_APOW) + (size_t)(g * 64 + tid) * 2; aT[0] = apr[tid * TP1 + TCH]; aT[1] = api[tid * TP1 + TCH]; }
    __syncthreads();
    bf16* Mg = (bf16*)(ws_ + WS_BIGW + BW_MAUG) + (size_t)g * NYC * UAW;
    { const int t0 = BAND * part;
      for (int i = tid; i < BAND * TCH * 32; i += 512) { const int tl = i / (TCH * 32), t = (i >> 5) % TCH, h = (i >> 1) & 15, hf = i & 1, tau = t0 + tl, sft = t - tau; if (sft < 0) continue;
          const LAS f32x4* src = (const LAS f32x4*)(kt + (tl << 8) + h * 16 + hf * 8); const f32x4 x = src[0], y = src[1];
          v4u w; w.x = pk2(x[0], x[1]); w.y = pk2(x[2], x[3]); w.z = pk2(y[0], y[1]); w.w = pk2(y[2], y[3]);
          *(GAS v4u*)(Mg + (size_t)(t * 16 + h) * UAW + 128 + sft * 16 + hf * 8) = w; } }
    for (int i = tid; i < (NYC / 8) * (UAW / 8); i += 512) { const int n = part * (NYC / 8) + i / (UAW / 8), k0 = (i % (UAW / 8)) * 8, t = n >> 4, h = n & 15; float v[8];
        if (k0 >= 128) { if (((k0 - 128) >> 4) <= t) continue;
#pragma unroll
            for (int j = 0; j < 8; ++j) v[j] = 0.f; }
        else {
#pragma unroll
            for (int j = 0; j < 8; ++j) { const int k = k0 + j, p = k & 63; const float cr = ccr[h * 64 + p], ci = cci[h * 64 + p], ar = apr[p * TP1 + t + 1], ai = api[p * TP1 + t + 1];
                v[j] = (k < 64) ? (cr * ar - ci * ai) : -(cr * ai + ci * ar); } }
        v4u w; w.x = pk2(v[0], v[1]); w.y = pk2(v[2], v[3]); w.z = pk2(v[4], v[5]); w.w = pk2(v[6], v[7]); *(GAS v4u*)(Mg + (size_t)n * UAW + k0) = w; }
    bf16* Wg = (bf16*)(ws_ + WS_BIGW + BW_WST) + (size_t)g * 256 * NYC;
    for (int i = tid; i < 32 * (NYC / 8); i += 512) { const int n = part * 32 + i / (NYC / 8), k0 = (i % (NYC / 8)) * 8, s = k0 >> 4, h2 = k0 & 15; float v[8];
        if (n < 128) { const int p = n & 63; const float ar = apr[p * TP1 + TCH - 1 - s], ai = api[p * TP1 + TCH - 1 - s];
#pragma unroll
            for (int j = 0; j < 8; ++j) { const float br = bbr[p * 16 + h2 + j], bi = bbi[p * 16 + h2 + j]; v[j] = (n < 64) ? (ar * br - ai * bi) : (ar * bi + ai * br); } }
        else {
#pragma unroll
            for (int j = 0; j < 8; ++j) v[j] = 0.f; }
        v4u w; w.x = pk2(v[0], v[1]); w.y = pk2(v[2], v[3]); w.z = pk2(v[4], v[5]); w.w = pk2(v[6], v[7]); *(GAS v4u*)(Wg + (size_t)n * NYC + k0) = w; }
    __syncthreads();
}
template <bool FINAL> __device__ __forceinline__ void ph_moe_reduce(const int* slot_tok, const int* ntp, const bf16* PART, bf16* HB, float* out, int gw, int NGW, int lane) { asm volatile("" : "+v"(lane));
    const int T = *ntp, Tm = T & ~63, nrow = (T - Tm) * 256;
    for (int r = gw; r < nrow; r += NGW) { const int tok = ((const GAS int*)slot_tok)[Tm * 256 + r]; if (tok < 0) continue;
#pragma unroll
        for (int hf = 0; hf < 2; ++hf) { const v4u h = *((const GAS v4u*)(HB + (size_t)tok * DM) + hf * 64 + lane);
            float v[8] = {bflo(h.x), bfhi(h.x), bflo(h.y), bfhi(h.y), bflo(h.z), bfhi(h.z), bflo(h.w), bfhi(h.w)};
#pragma unroll
            for (int kp = 0; kp < KSPLIT; ++kp) { const v4u p = *((const GAS v4u*)(PART + ((size_t)kp * MOE_LEFT_ROWS + r) * DM) + hf * 64 + lane);
                v[0] += bflo(p.x); v[1] += bfhi(p.x); v[2] += bflo(p.y); v[3] += bfhi(p.y); v[4] += bflo(p.z); v[5] += bfhi(p.z); v[6] += bflo(p.w); v[7] += bfhi(p.w); }
            if constexpr (FINAL) { GAS f32x4* o = (GAS f32x4*)(out + (size_t)tok * DM) + hf * 128 + 2 * lane; o[0] = (f32x4){v[0], v[1], v[2], v[3]}; o[1] = (f32x4){v[4], v[5], v[6], v[7]}; }
            else { v4u w; w.x = pk2(v[0], v[1]); w.y = pk2(v[2], v[3]); w.z = pk2(v[4], v[5]); w.w = pk2(v[6], v[7]); *((GAS v4u*)(HB + (size_t)tok * DM) + hf * 64 + lane) = w; } } }
}

namespace att {
typedef float f32x16 __attribute__((ext_vector_type(16)));
typedef short s16x4 __attribute__((ext_vector_type(4)));
constexpr int SLOTK = 12288, SLOTV = 8192, LDS_K = 0, LDS_V = 2 * SLOTK, LDS_WS = LDS_V + 2 * SLOTV, LDS_OST = LDS_WS + 8 * 256, LDS_BYTES = LDS_OST + 8 * 4096;
__device__ __forceinline__ int crow(int r, int hi) { return (r & 3) + 8 * (r >> 2) + 4 * hi; }
__device__ __forceinline__ void glds16(const void* gsrc, unsigned lds_dst) { unsigned keep;
    asm volatile("s_mov_b32 %0, m0\n\ts_mov_b32 m0, %2\n\ts_nop 0\n\tglobal_load_lds_dwordx4 %1, off\n\ts_mov_b32 m0, %0" : "=&s"(keep) : "v"(gsrc), "s"(lds_dst) : "memory"); }
#define ATT_WAIT_BAR() asm volatile("s_waitcnt vmcnt(0) lgkmcnt(0)\n\ts_barrier" ::: "memory")
#define ATT_SBAR() __builtin_amdgcn_sched_barrier(0)
__device__ __forceinline__ float max3f(float a, float b, float c) { return __builtin_fmaxf(__builtin_fmaxf(a, b), c); }
__device__ __forceinline__ float rowmax32(const f32x16& p0, const f32x16& p1) {
    float a = max3f(p0[0], p0[1], p1[0]), b = max3f(p0[2], p0[3], p1[1]); a = max3f(a, p1[2], p1[3]);
#pragma unroll
    for (int r = 4; r < 16; r += 4) { a = max3f(a, p0[r], p0[r + 1]); b = max3f(b, p0[r + 2], p0[r + 3]); a = max3f(a, p1[r], p1[r + 1]); b = max3f(b, p1[r + 2], p1[r + 3]); }
    const float m = fmaxf(a, b);
    auto rr = __builtin_amdgcn_permlane32_swap(__float_as_uint(m), __float_as_uint(m), false, false);
    return fmaxf(__uint_as_float(rr[0]), __uint_as_float(rr[1]));
}
__device__ __forceinline__ void pv(f32x16* o, int vb, bf16x8 pa0, bf16x8 pa1, bf16x8 pa2, bf16x8 pa3) {
#pragma unroll
    for (int d0 = 0; d0 < 2; ++d0) { s16x4 lo[4], hi[4];
#pragma unroll
        for (int ks = 0; ks < 4; ++ks) {
            asm volatile("ds_read_b64_tr_b16 %0,%1 offset:%c2" : "=&v"(lo[ks]) : "v"(vb), "i"(d0 * 4096 + ks * 1024) : "memory");
            asm volatile("ds_read_b64_tr_b16 %0,%1 offset:%c2" : "=&v"(hi[ks]) : "v"(vb), "i"(d0 * 4096 + ks * 1024 + 512) : "memory"); }
        asm volatile("s_waitcnt lgkmcnt(0)" ::: "memory"); ATT_SBAR();
#define ATT_PK(k) (bf16x8){lo[k][0], lo[k][1], lo[k][2], lo[k][3], hi[k][0], hi[k][1], hi[k][2], hi[k][3]}
        o[d0] = __builtin_amdgcn_mfma_f32_32x32x16_bf16(pa0, ATT_PK(0), o[d0], 0, 0, 0);
        o[d0] = __builtin_amdgcn_mfma_f32_32x32x16_bf16(pa1, ATT_PK(1), o[d0], 0, 0, 0);
        o[d0] = __builtin_amdgcn_mfma_f32_32x32x16_bf16(pa2, ATT_PK(2), o[d0], 0, 0, 0);
        o[d0] = __builtin_amdgcn_mfma_f32_32x32x16_bf16(pa3, ATT_PK(3), o[d0], 0, 0, 0);
#undef ATT_PK
    }
}
__device__ __forceinline__ void attn_unit(int b, int h, int qb, const bf16* QN, const bf16* KN, const bf16* KVR, bf16* MIX, float* SS, const float* qg, LAS unsigned char* shm) {
    int tid = threadIdx.x; asm volatile("" : "+v"(tid));
    const int lane = tid & 63, r32 = lane & 31, hi = lane >> 5, wid = __builtin_amdgcn_readfirstlane(tid >> 6);
    const long rowbase = (long)b * SEQ; const int q0 = qb * 256;
    const unsigned lds0 = (unsigned)(uintptr_t)shm;
    LAS float* wsf = (LAS float*)(shm + LDS_WS) + wid * 64;
    const bf16* ksrc0 = KN + (rowbase + lane) * 768 + h * 96 + wid * 8;
    const bf16* ksrc1 = ksrc0 + 64;
    const bf16* vsrc = KVR + (rowbase + 16 * (wid & 3) + (lane >> 2)) * 1024 + h * 128 + 64 + (wid >> 2) * 32 + (lane & 3) * 8;
    const unsigned kdst0 = lds0 + LDS_K + wid * 1024, kdst1 = lds0 + LDS_K + (8 + wid) * 1024, vdst = lds0 + LDS_V + wid * 1024;
#define ATT_DMA(t, s) do { glds16(ksrc0 + (long)(t) * 64 * 768, (unsigned)__builtin_amdgcn_readfirstlane(kdst0 + (s) * SLOTK)); \
        if (wid < 4) glds16(ksrc1 + (long)(t) * 64 * 768, (unsigned)__builtin_amdgcn_readfirstlane(kdst1 + (s) * SLOTK)); \
        glds16(vsrc + (long)(t) * 64 * 1024, (unsigned)__builtin_amdgcn_readfirstlane(vdst + (s) * SLOTV)); } while (0)
    const int vb0 = (int)(lds0 + LDS_V) + ((lane >> 4) & 1) * 32 + (lane & 3) * 8 + (4 * hi + ((lane & 15) >> 2)) * 64;
    const int NT = 4 * qb + 4, jmax = 4 * qb + (wid >> 1);
    ATT_DMA(0, 0);
    bf16x8 qr[6];
    {
      const bf16* Qw = QN + (rowbase + q0 + wid * 32 + r32) * 768 + h * 96 + hi * 8; v4u qw[6];
#pragma unroll
      for (int d0 = 0; d0 < 6; ++d0) qw[d0] = *(const GAS v4u*)(Qw + d0 * 16);
      f32x4 gA[6], gB[6];
#pragma unroll
      for (int d0 = 0; d0 < 6; ++d0) { gA[d0] = *(const GAS f32x4*)(qg + d0 * 16 + hi * 8); gB[d0] = *(const GAS f32x4*)(qg + d0 * 16 + hi * 8 + 4); }
      float qf[6][8]; float ss = 0.f;
#pragma unroll
      for (int d0 = 0; d0 < 6; ++d0) { qf[d0][0] = bflo(qw[d0].x); qf[d0][1] = bfhi(qw[d0].x); qf[d0][2] = bflo(qw[d0].y); qf[d0][3] = bfhi(qw[d0].y); qf[d0][4] = bflo(qw[d0].z); qf[d0][5] = bfhi(qw[d0].z); qf[d0][6] = bflo(qw[d0].w); qf[d0][7] = bfhi(qw[d0].w);
#pragma unroll
          for (int j = 0; j < 8; ++j) ss += qf[d0][j] * qf[d0][j]; }
      { auto rr = __builtin_amdgcn_permlane32_swap(__float_as_uint(ss), __float_as_uint(ss), false, false); ss = __uint_as_float(rr[0]) + __uint_as_float(rr[1]); }
      const float rq = QSCALE / sqrtf(ss * (1.f / 96) + EPS);
#pragma unroll
      for (int d0 = 0; d0 < 6; ++d0)
#pragma unroll
          for (int j = 0; j < 8; ++j) qf[d0][j] *= rq * (j < 4 ? gA[d0][j] : gB[d0][j - 4]);
      const float posf = (float)(q0 + wid * 32 + r32);
#pragma unroll
      for (int j = 0; j < 8; ++j) { const float ir = exp2f(-(float)(hi * 8 + j) * (13.287712379549449f / 16.f)) * 0.15915494309189535f;
          const float a = __builtin_amdgcn_fractf(posf * ir), sn = __builtin_amdgcn_sinf(a), cs = __builtin_amdgcn_cosf(a);
          const float x1 = qf[4][j], x2 = qf[5][j]; qf[4][j] = x1 * cs - x2 * sn; qf[5][j] = x1 * sn + x2 * cs; }
#pragma unroll
      for (int d0 = 0; d0 < 6; ++d0) { v4u w; w.x = pk2(qf[d0][0], qf[d0][1]); w.y = pk2(qf[d0][2], qf[d0][3]); w.z = pk2(qf[d0][4], qf[d0][5]); w.w = pk2(qf[d0][6], qf[d0][7]); qr[d0] = __builtin_bit_cast(bf16x8, w); } }
    float mhat = 0.f, l_reg = 0.f; f32x16 o[2]; f32x16 negm;
#pragma unroll
    for (int r = 0; r < 16; ++r) { o[0][r] = 0.f; o[1][r] = 0.f; negm[r] = 0.f; }
    constexpr float THRL = 8.f;
    for (int j = 0; j < NT; ++j) {
        ATT_WAIT_BAR();
        const int s = j & 1;
        if (j + 1 < NT) ATT_DMA(j + 1, s ^ 1);
        if (j <= jmax) {
            const LAS unsigned char* kb = shm + LDS_K + s * SLOTK + hi * 1024 + r32 * 16;
            f32x16 p0 = negm, p1 = negm;
#pragma unroll
            for (int d0 = 0; d0 < 6; ++d0) { const bf16x8 k0 = *(const LAS bf16x8*)(kb + d0 * 2048), k1 = *(const LAS bf16x8*)(kb + d0 * 2048 + 512);
                p0 = __builtin_amdgcn_mfma_f32_32x32x16_bf16(k0, qr[d0], p0, 0, 0, 0); p1 = __builtin_amdgcn_mfma_f32_32x32x16_bf16(k1, qr[d0], p1, 0, 0, 0); }
            const float rm = rowmax32(p0, p1);
            if (__any(rm > THRL) || j == 0) {
                const float dl = (j == 0) ? rm : fmaxf(rm, 0.f); mhat += dl;
#pragma unroll
                for (int r = 0; r < 16; ++r) { p0[r] -= dl; p1[r] -= dl; negm[r] = -mhat; }
                const float f = __builtin_amdgcn_exp2f(-dl); l_reg *= f;
                if (hi == 0) wsf[r32] = f;
                asm volatile("s_waitcnt lgkmcnt(0)" ::: "memory");
#pragma unroll
                for (int r = 0; r < 16; ++r) { const float g = wsf[crow(r, hi)]; o[0][r] *= g; o[1][r] *= g; }
            }
            float sacc = 0.f;
#pragma unroll
            for (int r = 0; r < 16; ++r) { p0[r] = __builtin_amdgcn_exp2f(p0[r]); p1[r] = __builtin_amdgcn_exp2f(p1[r]); sacc += p0[r] + p1[r]; }
            l_reg += sacc;
            v4u pw0, pw1, pw2, pw3;
            pw0 = (v4u){pk2(p0[0], p0[1]), pk2(p0[2], p0[3]), pk2(p0[4], p0[5]), pk2(p0[6], p0[7])}; pw1 = (v4u){pk2(p0[8], p0[9]), pk2(p0[10], p0[11]), pk2(p0[12], p0[13]), pk2(p0[14], p0[15])};
            pw2 = (v4u){pk2(p1[0], p1[1]), pk2(p1[2], p1[3]), pk2(p1[4], p1[5]), pk2(p1[6], p1[7])}; pw3 = (v4u){pk2(p1[8], p1[9]), pk2(p1[10], p1[11]), pk2(p1[12], p1[13]), pk2(p1[14], p1[15])};
            ATT_SBAR();
            pv(o, vb0 + s * SLOTV, __builtin_bit_cast(bf16x8, pw0), __builtin_bit_cast(bf16x8, pw1), __builtin_bit_cast(bf16x8, pw2), __builtin_bit_cast(bf16x8, pw3));
        }
    }
    { auto rr = __builtin_amdgcn_permlane32_swap(__float_as_uint(l_reg), __float_as_uint(l_reg), false, false); l_reg = __uint_as_float(rr[0]) + __uint_as_float(rr[1]); }
    if (hi == 0) wsf[32 + r32] = l_reg;
    asm volatile("s_waitcnt lgkmcnt(0)" ::: "memory");
    float rli[16];
#pragma unroll
    for (int r = 0; r < 16; ++r) rli[r] = __builtin_amdgcn_rcpf(wsf[32 + crow(r, hi)]);
    bf16* Ow = MIX + (rowbase + q0 + wid * 32) * 1024 + 512 + h * 64;
    { LAS bf16* stg = (LAS bf16*)(shm + LDS_OST) + wid * 2048;
#pragma unroll
      for (int r = 0; r < 16; ++r) { const int orow = crow(r, hi);
#pragma unroll
          for (int d0 = 0; d0 < 2; ++d0) stg[orow * 64 + d0 * 32 + r32] = f2bf(o[d0][r] * rli[r]); }
      asm volatile("s_waitcnt lgkmcnt(0)" ::: "memory");
#pragma unroll
      for (int i = 0; i < 4; ++i) { const int row = i * 8 + (lane >> 3), ch = lane & 7; const v4u v = *(const LAS v4u*)(stg + row * 64 + ch * 8); *(v4u*)(Ow + (long)row * 1024 + ch * 8) = v;
          float ss = (bflo(v.x) * bflo(v.x) + bfhi(v.x) * bfhi(v.x)) + (bflo(v.y) * bflo(v.y) + bfhi(v.y) * bfhi(v.y)) + (bflo(v.z) * bflo(v.z) + bfhi(v.z) * bfhi(v.z)) + (bflo(v.w) * bflo(v.w) + bfhi(v.w) * bfhi(v.w));
          ss += __shfl_xor(ss, 1); ss += __shfl_xor(ss, 2); ss += __shfl_xor(ss, 4);
          if (ch == 0) ((GAS float*)SS)[(rowbase + q0 + wid * 32 + row) * 16 + 8 + h] = ss; } }
    ATT_WAIT_BAR();
#undef ATT_DMA
}
__device__ __forceinline__ void attn_phase(const bf16* QN, const bf16* KN, const bf16* KVR, bf16* MIX, float* SS, const float* qg, LAS unsigned char* lds, int vcu, int G) {
#pragma unroll 1
    for (int v = vcu; v < 256; v += G) {
        const int bh = v >> 2, s = v & 3;
#pragma unroll 1
        for (int i = 0; i < 4; ++i) { const int qb = (i == 0) ? s : (i == 1) ? 7 - s : (i == 2) ? 8 + s : 15 - s; attn_unit(bh >> 3, bh & 7, qb, QN, KN, KVR, MIX, SS, qg, lds); } }
}
}
#define XB_TMO      128
#define XB_XCNT(j)  (256  + 64 * (j))
#define XB_XSUB(j)  (1280 + 64 * (j))
#define XB_XGEN(j)  (2304 + 64 * (j))
#define XB_TOP      3328
#define XB_TOPGEN   3392
#define XCD_BAR_WORDS 3456
#define XB_SPIN_CAP (1u << 18)
__device__ __forceinline__ unsigned xb_ld(unsigned* p)              { return __hip_atomic_load(p, __ATOMIC_RELAXED, __HIP_MEMORY_SCOPE_AGENT); }
__device__ __forceinline__ unsigned xb_add(unsigned* p, unsigned v) { return __hip_atomic_fetch_add(p, v, __ATOMIC_RELAXED, __HIP_MEMORY_SCOPE_AGENT); }
__device__ __forceinline__ unsigned xb_xcc_id() { return (unsigned)__builtin_amdgcn_s_getreg((3 << 11) | 20) & 0xFu; }
#define XB_SPIN(cond, bar) do { unsigned _sp = 0; while (cond) { __builtin_amdgcn_s_sleep(1); \
    if ((++_sp & 255u) == 0u) { if (xb_ld(&(bar)[XB_TMO])) break; if (_sp > XB_SPIN_CAP) { atomicAdd(&(bar)[XB_TMO], 1u); break; } } } } while (0)
struct XcdBarrier { unsigned* bar; unsigned x; volatile LAS unsigned* st; };
__device__ __forceinline__ XcdBarrier xcd_barrier_post(unsigned* bar, volatile LAS unsigned* st) {
    XcdBarrier b; b.bar = bar; b.x = xb_xcc_id(); b.st = st;
    if (threadIdx.x == 0) (void)xb_add(&bar[XB_XCNT(b.x)], 1u);
    return b;
}
__device__ __forceinline__ void xcd_barrier_complete(unsigned* bar, unsigned x, unsigned& nloc, unsigned& nx) {
    const unsigned G = gridDim.x * gridDim.y * gridDim.z;
    unsigned sum, cnt, mine, sp = 0u;
    for (;;) {
        sum = 0u; cnt = 0u; mine = 0u;
#pragma unroll
        for (unsigned j = 0; j < 16; ++j) { const unsigned c = xb_ld(&bar[XB_XCNT(j)]); sum += c; cnt += (c > 0u) ? 1u : 0u; mine = (j == x) ? c : mine; }
        if (sum == G) break;
        __builtin_amdgcn_s_sleep(1);
        if ((++sp & 255u) == 0u) { if (xb_ld(&bar[XB_TMO])) break; if (sp > XB_SPIN_CAP) { atomicAdd(&bar[XB_TMO], 1u); break; } }
    }
    nloc = mine > 0u ? mine : 1u; nx = cnt > 0u ? cnt : 1u;
}
__device__ __forceinline__ void xcd_barrier(const XcdBarrier& b) {
    asm volatile("s_waitcnt vmcnt(0)" ::: "memory");
    __syncthreads();
    if (threadIdx.x == 0) {
        unsigned* bar = b.bar; asm volatile("" : "+s"(bar));
        __builtin_amdgcn_s_waitcnt(0);
        unsigned nloc = b.st[0], nx = b.st[1];
        if (nloc == 0u) { xcd_barrier_complete(bar, b.x, nloc, nx); b.st[0] = nloc; b.st[1] = nx; }
        const unsigned old = xb_add(&bar[XB_XSUB(b.x)], 1u);
        const unsigned gen = old / nloc;
        if (old + 1u == (gen + 1u) * nloc) {
            __builtin_amdgcn_fence(__ATOMIC_RELEASE, "agent");
            asm volatile("s_waitcnt vmcnt(0)" ::: "memory");
            const unsigned og = xb_add(&bar[XB_TOP], 1u);
            const unsigned tg = og / nx;
            if (og + 1u == (tg + 1u) * nx) xb_add(&bar[XB_TOPGEN], 1u);
            else XB_SPIN(xb_ld(&bar[XB_TOPGEN]) == tg, bar);
            __builtin_amdgcn_fence(__ATOMIC_ACQUIRE, "agent");
            xb_add(&bar[XB_XGEN(b.x)], 1u);
            asm volatile("s_waitcnt vmcnt(0)" ::: "memory");
        } else {
            XB_SPIN(xb_ld(&bar[XB_XGEN(b.x)]) == gen, bar);
            __builtin_amdgcn_fence(__ATOMIC_ACQUIRE, "agent");
            asm volatile("s_waitcnt vmcnt(0)" ::: "memory");
        }
    }
    __syncthreads();
}

constexpr int RING_BYTES = 131072, MISC_OFF = RING_BYTES + 320, LDS_BYTES = 147456;
enum { PH_PREP = 0, PH_NORM1, PH_INPROJ, PH_SSMS, PH_SSMY, PH_GLU, PH_LATNORM, PH_QUP, PH_KVUP, PH_QKPREP, PH_ATTN, PH_OUTNORM, PH_OUTPROJ, PH_NORM2, PH_F0, PH_F1, PH_F2, PH_F3, PH_F4, PH_PER_LAYER = 32 };
struct Args { Params P; int ph_lo, ph_hi; unsigned skip_mask; int pad; };

struct LArgs { unsigned char* ws; float* outp; int G, bx, vcu, pad; };
#ifndef REPMASK0
#define REPMASK0 0x0
#define REPMASK1 0x0
#endif
#define REPS(k) (((((unsigned)(layer == 0 ? REPMASK0 : REPMASK1)) >> (k)) & 1u) ? 2 : 1)
#define RUN(k, ...) do { { const float rep_scale = 1.f; (void)rep_scale; __VA_ARGS__; } if constexpr (REPS(k) > 1) { const float rep_scale = 0.f; (void)rep_scale; __syncthreads(); __VA_ARGS__; } } while (0)
#define BAR() xcd_barrier(bar)
template <int layer> __device__ __forceinline__ void run_layer(const LArgs a, const XcdBarrier bar, LAS unsigned char* lds) {
    unsigned char* const ws = a.ws; float* const outp = a.outp; const int G = a.G, bx = a.bx, vcu = a.vcu;
    const int tid = threadIdx.x, lane = tid & 63, wave = __builtin_amdgcn_readfirstlane(tid >> 6);
    const int gw = vcu * 8 + wave, NGW = G * 8, gtid = bx * 512 + tid, gthreads = G * 512;
    bf16* HB = (bf16*)(ws + WS_HB); bf16* Z = (bf16*)outp; bf16* LAT = (bf16*)outp; bf16* KN = (bf16*)outp; bf16* MIX = (bf16*)(ws + WS_MIX); bf16* PL = (bf16*)(ws + WS_PL);
    bf16* UA = (bf16*)(ws + WS_UAUG); bf16* YG = (bf16*)(ws + WS_YG); bf16* KVR = (bf16*)(ws + WS_KVRAW); bf16* QR = (bf16*)(ws + WS_QRAW);
    bf16* ACTD = (bf16*)(ws + WS_ACTD); bf16* ACTM = (bf16*)(ws + WS_ACTM);
    LAS float* scr = (LAS float*)(lds + wave * 16384);
    unsigned char* wsm = ws + WS_WSMALL + (size_t)layer * WSM_STRIDE;
    RUN(0, { for (int j = bx; j < 256; j += G) ph_ssm_prep(ws, layer, j & 31, j >> 5, lds, tid);
             conv_small(ws, layer, scr, gw, NGW, lane, gtid, gthreads);
             if constexpr (layer == 0) conv_dense(ws, scr, gw, NGW, lane);
             if constexpr (layer == 0) ph_x2hb(kin(I_X), HB, (float*)(ws + WS_SS3), gw, NGW, lane); });
    BAR();
    RUN(1, { DenseSched S{(const char*)HB, (const char*)(wsm + WSM_IN), DM * 2, DM * 2, M / 256, 4, DM / 64, G, bx}; EpiInProjRs E{UA, PL, (const float*)(ws + WS_SS3), lds}; pg8::gemm_phase(lds, S, E); });
    BAR();
    RUN(2, { { SsmSSched S{(const char*)UA, (const char*)(ws + WS_BIGW + BW_WST), UAW * 2, NYC * 2, G, bx}; EpiSsmS E{UA, (const float*)(ws + WS_APOW)}; pg8::gemm_phase<EpiSsmS, SsmSSched, false, true>(lds, S, E); }
             ph_latnorm(PL, kin(I_Q_NORM) + layer * QRANK, kin(I_KV_NORM) + layer * KVRANK, LAT, gw, NGW, lane); });
    BAR();
    RUN(3, { { SsmYSched S{(const char*)UA, (const char*)(ws + WS_BIGW + BW_MAUG), UAW * 2, UAW * 2, G, bx}; EpiSsmY E{YG}; pg8::gemm_phase(lds, S, E); }
             { DenseSched S{(const char*)LAT, (const char*)(wsm + WSM_Q), 512 * 2, QRANK * 2, M / 256, 3, 4, G, bx}; EpiBf16 E{QR, 768}; pg8::gemm_phase(lds, S, E); }
             { DenseSched S{(const char*)(LAT + 256), (const char*)(wsm + WSM_KV), 512 * 2, 256 * 2, M / 256, 4, 4, G, bx}; EpiBf16 E{KVR, 1024}; pg8::gemm_phase(lds, S, E); } });
    BAR();
    RUN(4, { { DenseSched S{(const char*)YG, (const char*)(wsm + WSM_GLU), DSSM * 2, DSSM * 2, M / 256, 2, DSSM / 64, G, bx}; EpiGlu E{YG, kin(I_B_GLU) + layer * DSSM, MIX, (float*)(ws + WS_SS)}; pg8::gemm_phase(lds, S, E); }
             ph_qkprep(KVR, PL, KN, kin(I_K_GAIN) + layer * DQK, gw, NGW, lane); });
    BAR();
    RUN(5, att::attn_phase(QR, KN, KVR, MIX, (float*)(ws + WS_SS), kin(I_Q_GAIN) + layer * DQK, lds, vcu, G));
    BAR();
    RUN(7, { DenseSched S{(const char*)MIX, (const char*)(wsm + WSM_OUT), DM * 2, DM * 2, M / 256, 4, DM / 64, G, bx}; EpiOutProj E{HB, (const float*)(ws + WS_SS), rep_scale, lds, (float*)(ws + WS_SS2)}; pg8::gemm_phase(lds, S, E); });
    BAR();
    if constexpr (layer == 0) {
        RUN(9, { DenseSched S{(const char*)HB, (const char*)(ws + WS_BIGW + BW_DGU), DM * 2, DM * 2, M / 256, 22, DM / 64, G, bx}; EpiSwigluRs E{ACTD, FFD, (const float*)(ws + WS_SS2), lds}; pg8::gemm_phase(lds, S, E); });
        BAR();
        RUN(10, { DenseSched S{(const char*)ACTD, (const char*)(ws + WS_BIGW + BW_DD), FFD * 2, FFD * 2, M / 256, 4, FFD / 64, G, bx}; EpiResid E{HB, rep_scale, (float*)(ws + WS_SS3)}; pg8::gemm_phase(lds, S, E); });
        BAR();
    } else {
        unsigned char* rt = ws + WS_ROUTE;
        RUN(8, { ph_norm_route(HB, kin(I_FFN_NORM) + layer * DM, kin(I_MW_ROUTER), Z, (v4u*)rt, gw, NGW, lane); });
        BAR();
        RUN(9, { if (bx == G - 1) { ph_route_sort((const v4u*)rt, rt, lds, tid); __syncthreads(); } conv_moe(ws, scr, gw, NGW, lane); });
        BAR();
        bf16* PART0 = (bf16*)((unsigned char*)outp + 64 * MiB); bf16* PART1 = (bf16*)(ws + WS_BIGW);
#pragma unroll 1
        for (int k = 0; k < 2; ++k) {
            const int* tile_e = (const int*)(rt + RT_TILE_E) + k * MOE_TILES; const int* slot_tok = (const int*)(rt + RT_SLOT_TOK) + k * MOE_SLOTS; const float* slot_w = (const float*)(rt + RT_SLOT_W) + k * MOE_SLOTS; const int* ntl = (const int*)(rt + RT_NTILES) + k;
            if (k == 1) ph_moe_reduce<false>((const int*)(rt + RT_SLOT_TOK), (const int*)(rt + RT_NTILES), PART0, HB, outp, gw, NGW, lane);
            RUN(10, { MoeSched S{(const char*)Z, (const char*)(ws + WS_BIGW + BW_MGU), DM * 2, DM * 2, (size_t)2 * FFE * DM * 2, 28, DM / 64, G, bx, tile_e, slot_tok, ntl}; EpiSwiglu E{ACTM, FFE}; pg8::gemm_phase(lds, S, E); });
            BAR();
            if (k == 0) RUN(11, { MoeDownSched S{(const char*)ACTM, (const char*)(ws + WS_BIGW + BW_MD), FFE * 2, FFE * 2, (size_t)DM * FFE * 2, G, bx, tile_e, ntl}; EpiMoeDown<false> E{slot_tok, slot_w, HB, outp, rep_scale, ntl, PART0}; pg8::gemm_phase(lds, S, E); });
            else RUN(12, { MoeDownSched S{(const char*)ACTM, (const char*)(ws + WS_BIGW + BW_MD), FFE * 2, FFE * 2, (size_t)DM * FFE * 2, G, bx, tile_e, ntl}; EpiMoeDown<true> E{slot_tok, slot_w, HB, outp, 1.f, ntl, PART1}; pg8::gemm_phase(lds, S, E); });
            BAR();
            if (k == 1) ph_moe_reduce<true>(slot_tok, ntl, PART1, HB, outp, gw, NGW, lane);
        }
    }
}
__global__ void __launch_bounds__(512, 2) fwd(Args args) {
    extern __shared__ __attribute__((aligned(16))) unsigned char lds_raw[];
    LAS unsigned char* lds = (LAS unsigned char*)lds_raw;
    unsigned char* const ws = args.P.ws; float* const outp = args.P.out;
    const int tid = threadIdx.x, lane = tid & 63, wave = __builtin_amdgcn_readfirstlane(tid >> 6);
    const int G = gridDim.x, bx = blockIdx.x; const int vcu = (G % 8 == 0) ? (bx % 8) * (G / 8) + bx / 8 : bx;
    const int gw = vcu * 8 + wave, NGW = G * 8, gtid = bx * 512 + tid, gthreads = G * 512;
    volatile LAS unsigned* MISC = (volatile LAS unsigned*)(lds + MISC_OFF);
    for (int u = tid; u < (LDS_BYTES - RING_BYTES) / 4; u += 512) ((LAS unsigned*)(lds + RING_BYTES))[u] = 0u;
    __syncthreads();
    unsigned* ctl = (unsigned*)(ws + WS_CTL);
    XcdBarrier bar = xcd_barrier_post(ctl + CW_BAR, MISC + 8);

    LArgs la; la.ws = ws; la.outp = outp; la.G = G; la.bx = bx; la.vcu = vcu; la.pad = 0;
    run_layer<0>(la, bar, lds);
    run_layer<1>(la, bar, lds);
}
static void launch_fwd(const Params& P, int lo, int hi, unsigned skip, int grid, hipStream_t st) {
    Args a{}; a.P = P; a.ph_lo = lo; a.ph_hi = hi; a.skip_mask = skip; a.pad = 0;
    hipLaunchKernelGGL(fwd, dim3(grid), dim3(512), LDS_BYTES, st, a);
}
extern "C" void kernel_launch(void* const* d_in, const int* in_sizes, int n_in, void* d_out, int out_size, void* d_ws, size_t ws_size, hipStream_t stream) {
    static int grid = 0;
    if (grid == 0) {
        if (n_in != 30 || out_size != M * DM || ws_size < WS_END) { fprintf(stderr, "kernel_launch: unexpected shapes: n_in %d out %d ws %zu (need %zu)\n", n_in, out_size, ws_size, (size_t)WS_END); grid = -1; return; }
        int dev = 0, cus = 0;
        if (hipGetDevice(&dev) != hipSuccess || hipDeviceGetAttribute(&cus, hipDeviceAttributeMultiprocessorCount, dev) != hipSuccess) { grid = -1; return; }
        if (hipFuncSetAttribute((const void*)fwd, hipFuncAttributeMaxDynamicSharedMemorySize, LDS_BYTES) != hipSuccess) { fprintf(stderr, "kernel_launch: hipFuncSetAttribute failed\n"); grid = -1; return; }
        (void)hipGetLastError();
        grid = cus;
    }
    if (grid < 0) return;
    Params P{};
    for (int i = 0; i < 30; ++i) P.in[i] = (const float*)d_in[i];
    P.out = (float*)d_out; P.ws = (unsigned char*)d_ws;
    unsigned char* ws = P.ws;
    (void)hipMemsetAsync(ws + WS_CTL, 0, CTL_ZERO_BYTES, stream);
    launch_fwd(P, 0, DEPTH * PH_PER_LAYER, 0, grid, stream);
}
```

```cpp
#include <hip/hip_runtime.h>
#include <cstdio>
#include <cstdint>

constexpr int NB = 8, SEQ = 4096, DM = 1024, M = NB * SEQ, DEPTH = 2;
#ifndef SSM_TCH
#define SSM_TCH 32
#endif
constexpr int DSSM = 512, NG = 32, GH = 16, NP = 64, TCH = SSM_TCH, NCH = SEQ / TCH;
constexpr int NROWG = NB * NCH, NYC = TCH * 16, SSM_RT = NROWG / 256, SSM_CT = NYC / 256, TP1 = TCH + 1;
constexpr int NHEAD = 8, DV = 64, DNOPE = 64, DROPE = 32, DQK = 96, QRANK = 256, KVRANK = 128;
constexpr int DIN = 928, FFD = 2816, NE = 8, FFE = 3584;
constexpr float EPS = 1e-6f;
constexpr int UAW = 128 + NYC;
constexpr int MOE_SLOTS = 34816;
constexpr int MOE_TILES = MOE_SLOTS / 256;

constexpr size_t MiB = 1u << 20;
constexpr size_t WS_CTL = 0, CTL_ZERO_BYTES = 64 * 1024;
constexpr size_t WS_WSMALL = 1 * MiB;
constexpr size_t WSM_IN = 0, WSM_GLU = 2 * MiB, WSM_Q = 2 * MiB + 512 * 1024, WSM_KV = 3 * MiB, WSM_OUT = 3 * MiB + 512 * 1024, WSM_STRIDE = 6 * MiB;
constexpr size_t WS_APOW = 13 * MiB;
constexpr size_t WS_ROUTE = 14 * MiB;
constexpr size_t RT_SLOT_TOK = 512 * 1024, RT_SLOT_W = RT_SLOT_TOK + 2 * MOE_SLOTS * 4, RT_TILE_E = RT_SLOT_W + 2 * MOE_SLOTS * 4, RT_NTILES = RT_TILE_E + 2 * MOE_TILES * 4;
constexpr size_t WS_SS = 16 * MiB;
constexpr size_t WS_SS2 = 126 * MiB, WS_SS3 = 124 * MiB;
constexpr size_t WS_BIGW = 19 * MiB;
constexpr size_t BW_MAUG = 0, BW_WST = 72 * MiB, BW_DGU = 88 * MiB, BW_DD = 99 * MiB;
constexpr size_t BW_MGU = 0, BW_MD = 112 * MiB;
constexpr size_t WS_HB = 195 * MiB;
constexpr size_t WS_MIX = 259 * MiB;
constexpr size_t WS_PL = 323 * MiB;
constexpr size_t WS_UAUG = 355 * MiB;
constexpr size_t WS_YG = 395 * MiB;
constexpr size_t WS_KVRAW = 128 * MiB;
constexpr size_t WS_QRAW = 427 * MiB;
constexpr size_t WS_ACTD = 323 * MiB;
constexpr size_t WS_ACTM = 259 * MiB;
constexpr size_t WS_END = 511 * MiB;
static_assert(WS_ACTM + (size_t)MOE_SLOTS * FFE * 2 <= WS_END && WS_ACTD + (size_t)M * FFD * 2 <= WS_END && WS_QRAW + (size_t)M * 768 * 2 <= WS_END, "ws map");
static_assert(WS_BIGW + BW_MD + (size_t)NE * DM * FFE * 2 <= WS_HB && WS_UAUG + (size_t)NG * NROWG * UAW * 2 <= WS_YG, "ws map 2");
static_assert(RT_NTILES + 64 <= 5 * MiB, "route map");

constexpr int CW_BAR = 4096;

#define GAS __attribute__((address_space(1)))
#define LAS __attribute__((address_space(3)))
typedef unsigned short bf16;
typedef unsigned v4u __attribute__((ext_vector_type(4)));
typedef unsigned v2u __attribute__((ext_vector_type(2)));
typedef float f32x4 __attribute__((ext_vector_type(4)));
typedef float f32x2 __attribute__((ext_vector_type(2)));
typedef short bf16x8 __attribute__((ext_vector_type(8)));
typedef __bf16 bf16x2_t __attribute__((ext_vector_type(2)));
#define LDS_WAIT() asm volatile("s_waitcnt lgkmcnt(0)" ::: "memory")
#define VM_WAIT() asm volatile("s_waitcnt vmcnt(0)" ::: "memory")
__device__ __forceinline__ unsigned pk2(float lo, float hi) { f32x2 v = {lo, hi}; bf16x2_t b = __builtin_convertvector(v, bf16x2_t); return __builtin_bit_cast(unsigned, b); }
__device__ __forceinline__ bf16 f2bf(float f) { return (bf16)(pk2(f, 0.f) & 0xffffu); }
__device__ __forceinline__ float bf2f(bf16 b) { return __builtin_bit_cast(float, (unsigned)b << 16); }
__device__ __forceinline__ float bflo(unsigned w) { return __builtin_bit_cast(float, w << 16); }
__device__ __forceinline__ float bfhi(unsigned w) { return __builtin_bit_cast(float, w & 0xffff0000u); }
__device__ __forceinline__ float wave_sum(float v) {
#pragma unroll
    for (int o = 1; o < 64; o <<= 1) v += __shfl_xor(v, o);
    return v;
}
__device__ __forceinline__ float sigmoidf_(float x) { return __builtin_amdgcn_rcpf(1.f + __builtin_amdgcn_exp2f(-1.4426950408889634f * x)); }
__device__ __forceinline__ float gelu_tanh(float x) { const float u = 0.7978845608028654f * (x + 0.044715f * x * x * x); return x * sigmoidf_(2.f * u); }

struct Params { const float* in[30]; float* out; unsigned char* ws; };
__device__ __forceinline__ const float* kin(int i) { const float* const* ka = (const float* const*)__builtin_amdgcn_kernarg_segment_ptr(); asm volatile("" : "+s"(ka)); return ka[i]; }
enum { I_X = 0, I_ATTN_NORM, I_W_IN, I_A_RE, I_A_IM, I_LOG_STEP, I_B_RE, I_B_IM, I_C_RE, I_C_IM, I_D, I_W_GLU, I_B_GLU, I_Q_NORM, I_W_Q_UP, I_KV_NORM, I_W_KV_UP,
       I_Q_GAIN, I_K_GAIN, I_SSM_OUT_NORM, I_MLA_OUT_NORM, I_W_OUT, I_FFN_NORM, I_DW_GATE, I_DW_UP, I_DW_DOWN, I_MW_ROUTER, I_MW_GATE, I_MW_UP, I_MW_DOWN };

#ifndef NAIVE
#define NAIVE 0
#endif
#ifndef FAST_GEMM
#define FAST_GEMM 1
#endif
namespace pg8 {
constexpr int BM = 256, BK = 64, HALF = 128, HTB = HALF * BK * 2, STAGE_BYTES = 8 * HTB, NXCD = 8, WGM = 8;
__host__ __device__ __forceinline__ int lds_byte(int r, int c) { const int st = (r >> 4) * 2 + (c >> 5), rr = r & 15, cc = c & 31, ob = rr * 64 + cc * 2; return st * 1024 + (ob ^ (((ob >> 9) & 1) << 5)); }
__host__ __device__ __forceinline__ void stage_rc(int b, int& R, int& C) { const int st = b / 1024, sb = b % 1024, swz = sb ^ (((sb >> 9) & 1) << 5); R = (st >> 1) * 16 + swz / 64; C = (st & 1) * 32 + (swz % 64) / 2; }
__host__ __device__ __forceinline__ int perm32(int rho) { const int n = rho >> 4, i = rho & 15; return 8 * (i >> 2) + 4 * n + (i & 3); }

struct Unit { int pm, pn, aux, kp, seq; };

__device__ __forceinline__ bool static_unit(int i, int G, int c, int nM, int nN, Unit& u) {
    const int nwg = nM * nN; const long L = (long)i * G + c; if (L >= nwg) return false;
    int wgid = (int)L; { const int q = nwg / NXCD, r = nwg % NXCD, xcd = wgid % NXCD, off = wgid / NXCD; wgid = (xcd < r ? xcd * (q + 1) : r * (q + 1) + (xcd - r) * q) + off; }
    const int nig = WGM * nN, gid = wgid / nig, fm = gid * WGM, gsz = (nM - fm) < WGM ? (nM - fm) : WGM;
    u.pm = fm + ((wgid % nig) % gsz); u.pn = (wgid % nig) / gsz; u.aux = 0; u.kp = -1; return true;
}

template <class T, class = void> struct has_mid { static constexpr bool value = false; };
template <class T> struct has_mid<T, decltype((void)T::MID_T)> { static constexpr bool value = true; };
template <class T, class = void> struct has_begin { static constexpr bool value = false; };
template <class T> struct has_begin<T, decltype((void)T::BEGIN)> { static constexpr bool value = true; };
template <class T, class = void> struct has_pair { static constexpr bool value = false; };
template <class T> struct has_pair<T, decltype((void)T::PAIR)> { static constexpr bool value = true; };
template <class T, class = void> struct has_custom { static constexpr bool value = false; };
template <class T> struct has_custom<T, decltype((void)T::CUSTOM)> { static constexpr bool value = true; };
template <class Epi> __device__ __forceinline__ void epi_apply(const Epi& E, const f32x4 (&acc)[2][2][4][2], const Unit& u, int wr, int wc, int fr, int fq) {
    if constexpr (has_custom<Epi>::value) E.apply(acc, u, wr, wc, fr, fq);
    else {
#pragma unroll
    for (int ai = 0; ai < 2; ++ai)
#pragma unroll
        for (int m = 0; m < 4; ++m) { const int r = ai * HALF + wr * 64 + m * 16 + fr;
            if constexpr (has_pair<Epi>::value) E.putpair(u, r, wc * 32 + 8 * fq, acc[ai][0][m][0], acc[ai][0][m][1], acc[ai][1][m][0], acc[ai][1][m][1]);
            else {
#pragma unroll
            for (int bj = 0; bj < 2; ++bj) {
                if constexpr (Epi::PERM) E.put8(u, r, bj * HALF + wc * 32 + 8 * fq, acc[ai][bj][m][0], acc[ai][bj][m][1]);
                else { E.put4(u, r, bj * HALF + wc * 32 + 4 * fq, acc[ai][bj][m][0]); E.put4(u, r, bj * HALF + wc * 32 + 16 + 4 * fq, acc[ai][bj][m][1]); } } }
            asm volatile("" ::: "memory"); }
    }
}

template <class Epi, class Sched, bool ALIGN_EPI = true, bool SP2 = true>
__device__ __forceinline__ void gemm_phase(LAS unsigned char* lds, const Sched& S, const Epi& E) {
    int tid = threadIdx.x; asm volatile("" : "+v"(tid));
    const int wid = __builtin_amdgcn_readfirstlane(tid >> 6), lane = tid & 63, wr = wid >> 2, wc = wid & 3, fr = lane & 15, fq = lane >> 4;
    int RA[2], CA2[2]; unsigned voffB[2], voA0[2], voA1[2], nvA0[2], nvA1[2];
    const unsigned lda = S.lda, ldb = S.ldb;
#pragma unroll
    for (int i = 0; i < 2; ++i) { int R, C; stage_rc(tid * 16 + i * 8192, R, C); const int Rb = Epi::PERM ? ((R & ~31) + perm32(R & 31)) : R;
        RA[i] = R; CA2[i] = C * 2; voffB[i] = (unsigned)Rb * ldb + (unsigned)C * 2u; voA0[i] = (unsigned)R * lda + (unsigned)C * 2u; voA1[i] = (unsigned)(R + HALF) * lda + (unsigned)C * 2u; nvA0[i] = voA0[i]; nvA1[i] = voA1[i]; }
    const size_t kstep = (size_t)(BK * 2);
    const size_t hstepB = (size_t)HALF * ldb;
    const unsigned ldsw = (unsigned)wid * 1024u;
    const int aoff = lds_byte(wr * 64 + fr, fq * 8), boff = lds_byte(wc * 32 + fr, fq * 8);
#define PG8_SA(b, h) (((b) * 2 + (h)) * HTB)
#define PG8_SB(b, h) ((4 + (b) * 2 + (h)) * HTB)
#define PG8_STAGE(bufoff, gbase, voff) do { _Pragma("unroll") for (int _i = 0; _i < 2; ++_i) \
        __builtin_amdgcn_global_load_lds((const unsigned*)((const char*)(gbase) + (voff)[_i]), (LAS unsigned*)(lds + (bufoff) + ldsw + _i * 8192), 16, 0, 0); } while (0)
#define PG8_LDA(dst, b, h) do { _Pragma("unroll") for (int m = 0; m < 4; ++m) _Pragma("unroll") for (int k = 0; k < 2; ++k) dst[m][k] = *(const LAS bf16x8*)(lds + PG8_SA(b, h) + aoff + m * 2048 + k * 1024); } while (0)
#define PG8_LDB(dst, b, h) do { _Pragma("unroll") for (int n = 0; n < 2; ++n) _Pragma("unroll") for (int k = 0; k < 2; ++k) dst[n][k] = *(const LAS bf16x8*)(lds + PG8_SB(b, h) + boff + n * 2048 + k * 1024); } while (0)
#define PG8_MMA(ai, bj, At, Bt) do { __builtin_amdgcn_s_setprio(1); _Pragma("unroll") for (int m = 0; m < 4; ++m) _Pragma("unroll") for (int n = 0; n < 2; ++n) _Pragma("unroll") for (int k = 0; k < 2; ++k) \
        acc[ai][bj][m][n] = __builtin_amdgcn_mfma_f32_16x16x32_bf16(Bt[n][k], At[m][k], acc[ai][bj][m][n], 0, 0, 0); __builtin_amdgcn_s_setprio(0); } while (0)
#define PG8_WAIT_V(n) asm volatile("s_waitcnt vmcnt(" #n ")" ::: "memory")
#define PG8_WAIT_L(n) asm volatile("s_waitcnt lgkmcnt(" #n ")" ::: "memory")
#define PG8_BAR __builtin_amdgcn_s_barrier()
#define PG8_SCHED __builtin_amdgcn_sched_barrier(0)
    Unit cur, nxt; int ui = 0;
    if (!S.next(0, cur)) return;
    cur.seq = 0;
    if constexpr (Sched::GATHER) {
#pragma unroll
        for (int i = 0; i < 2; ++i) { voA0[i] = S.a_rowoff(cur, RA[i]) + (unsigned)CA2[i]; voA1[i] = S.a_rowoff(cur, RA[i] + HALF) + (unsigned)CA2[i]; }
    }
    f32x4 acc[2][2][4][2];
#pragma unroll
    for (int a = 0; a < 2; ++a)
#pragma unroll
        for (int b = 0; b < 2; ++b)
#pragma unroll
            for (int m = 0; m < 4; ++m)
#pragma unroll
                for (int n = 0; n < 2; ++n) acc[a][b][m][n] = (f32x4){0.f, 0.f, 0.f, 0.f};
    bf16x8 At[4][2], B0[2][2], B1[2][2];
    const char* cA = S.a_base(cur); const char* cB = S.b_base(cur);
    if constexpr (SP2) {
        PG8_STAGE(PG8_SB(0, 0), cB, voffB); PG8_STAGE(PG8_SB(0, 1), cB + hstepB, voffB); PG8_STAGE(PG8_SA(0, 0), cA, voA0); PG8_STAGE(PG8_SA(0, 1), cA, voA1);
        if (wr == 1) PG8_BAR;
        PG8_WAIT_V(2); PG8_BAR;
        PG8_STAGE(PG8_SB(1, 0), cB + kstep, voffB); PG8_STAGE(PG8_SA(1, 0), cA + kstep, voA0); PG8_STAGE(PG8_SB(1, 1), cB + hstepB + kstep, voffB);
        PG8_WAIT_V(6); PG8_BAR;
    } else {
        PG8_STAGE(PG8_SB(0, 0), cB, voffB); PG8_STAGE(PG8_SA(0, 0), cA, voA0); PG8_STAGE(PG8_SB(0, 1), cB + hstepB, voffB); PG8_STAGE(PG8_SA(0, 1), cA, voA1);
        if (wr == 1) PG8_BAR;
        PG8_WAIT_V(4); PG8_BAR;
        PG8_STAGE(PG8_SB(1, 0), cB + kstep, voffB); PG8_STAGE(PG8_SA(1, 0), cA + kstep, voA0); PG8_STAGE(PG8_SB(1, 1), cB + hstepB + kstep, voffB);
        PG8_WAIT_V(6); PG8_BAR;
    }
    for (;;) {
        const bool has_next = S.next(ui + 1, nxt);
        const char* nA = has_next ? S.a_base(nxt) : cA; const char* nB = has_next ? S.b_base(nxt) : cB;
        if constexpr (Sched::GATHER) {
            if (has_next) {
#pragma unroll
                for (int i = 0; i < 2; ++i) { nvA0[i] = S.a_rowoff(nxt, RA[i]) + (unsigned)CA2[i]; nvA1[i] = S.a_rowoff(nxt, RA[i] + HALF) + (unsigned)CA2[i]; }
            } else {
#pragma unroll
                for (int i = 0; i < 2; ++i) { nvA0[i] = voA0[i]; nvA1[i] = voA1[i]; }
            }
        }
        if constexpr (has_begin<Epi>::value) E.unit_begin(cur, lds, tid);
        const int nt = S.nt(cur);
        for (int t = 0; t < nt; t += 2) {
            const bool last = (t == nt - 2);
            if constexpr (has_mid<Epi>::value) { if (t == Epi::MID_T) E.mid(acc, cur, wr, fr, lds); }
            const char* a1 = cA + (size_t)(t + 1) * kstep;
            const char* a2 = last ? nA : cA + (size_t)(t + 2) * kstep; const char* b2 = last ? nB : cB + (size_t)(t + 2) * kstep;
            const char* a3 = a2 + kstep; const char* b3 = b2 + kstep;
            unsigned w0[2], w1[2];
            if constexpr (Sched::GATHER) {
#pragma unroll
                for (int i = 0; i < 2; ++i) { w0[i] = last ? nvA0[i] : voA0[i]; w1[i] = last ? nvA1[i] : voA1[i]; }
            } else {
#pragma unroll
                for (int i = 0; i < 2; ++i) { w0[i] = voA0[i]; w1[i] = voA1[i]; }
            }
            if constexpr (SP2) {
            PG8_LDB(B0, 0, 0); PG8_LDB(B1, 0, 1); PG8_SCHED; PG8_LDA(At, 0, 0); PG8_STAGE(PG8_SA(1, 1), a1, voA1);
            PG8_WAIT_V(8); PG8_WAIT_L(0); PG8_BAR; PG8_MMA(0, 0, At, B0); PG8_MMA(0, 1, At, B1); PG8_BAR; PG8_SCHED;
            PG8_LDA(At, 0, 1); PG8_STAGE(PG8_SB(0, 0), b2, voffB); PG8_STAGE(PG8_SB(0, 1), b2 + hstepB, voffB); PG8_STAGE(PG8_SA(0, 0), a2, w0);
            PG8_WAIT_V(8); PG8_WAIT_L(0); PG8_BAR; PG8_MMA(1, 0, At, B0); PG8_MMA(1, 1, At, B1); PG8_BAR; PG8_SCHED;
            PG8_LDB(B0, 1, 0); PG8_LDB(B1, 1, 1); PG8_SCHED; PG8_LDA(At, 1, 0); PG8_STAGE(PG8_SA(0, 1), a2, w1);
            PG8_WAIT_V(8); PG8_WAIT_L(0); PG8_BAR; PG8_MMA(0, 0, At, B0); PG8_MMA(0, 1, At, B1); PG8_BAR; PG8_SCHED;
            PG8_LDA(At, 1, 1); PG8_STAGE(PG8_SB(1, 0), b3, voffB); PG8_STAGE(PG8_SB(1, 1), b3 + hstepB, voffB); PG8_STAGE(PG8_SA(1, 0), a3, w0);
            PG8_WAIT_V(8); PG8_WAIT_L(0); PG8_BAR; PG8_MMA(1, 0, At, B0); PG8_MMA(1, 1, At, B1); PG8_BAR; PG8_SCHED;
            } else {
            PG8_LDB(B0, 0, 0); PG8_SCHED; PG8_LDA(At, 0, 0); PG8_STAGE(PG8_SA(1, 1), a1, voA1);
            PG8_WAIT_L(8); PG8_BAR; PG8_WAIT_L(0); PG8_MMA(0, 0, At, B0); PG8_BAR; PG8_SCHED;
            PG8_LDB(B1, 0, 1); PG8_STAGE(PG8_SB(0, 0), b2, voffB);
            PG8_BAR; PG8_WAIT_L(0); PG8_MMA(0, 1, At, B1); PG8_BAR;
            PG8_LDA(At, 0, 1); PG8_STAGE(PG8_SA(0, 0), a2, w0);
            PG8_BAR; PG8_WAIT_L(0); PG8_MMA(1, 0, At, B0); PG8_BAR; PG8_SCHED;
            PG8_STAGE(PG8_SB(0, 1), b2 + hstepB, voffB);
            PG8_WAIT_V(6); PG8_BAR; PG8_MMA(1, 1, At, B1); PG8_BAR;
            PG8_LDB(B0, 1, 0); PG8_SCHED; PG8_LDA(At, 1, 0); PG8_STAGE(PG8_SA(0, 1), a2, w1);
            PG8_WAIT_L(8); PG8_BAR; PG8_WAIT_L(0); PG8_MMA(0, 0, At, B0); PG8_BAR; PG8_SCHED;
            PG8_LDB(B1, 1, 1); PG8_STAGE(PG8_SB(1, 0), b3, voffB);
            PG8_BAR; PG8_WAIT_L(0); PG8_MMA(0, 1, At, B1); PG8_BAR;
            PG8_LDA(At, 1, 1); PG8_STAGE(PG8_SA(1, 0), a3, w0);
            PG8_BAR; PG8_WAIT_L(0); PG8_MMA(1, 0, At, B0); PG8_BAR; PG8_SCHED;
            PG8_STAGE(PG8_SB(1, 1), b3 + hstepB, voffB);
            PG8_WAIT_V(6); PG8_BAR; PG8_MMA(1, 1, At, B1); PG8_BAR;
            }
        }
        if constexpr (ALIGN_EPI) { if (wr == 0) PG8_BAR; }
        if constexpr (!Epi::AFTER_DRAIN) { int fr_ = fr, fq_ = fq; asm volatile("" : "+v"(fr_), "+v"(fq_));
            epi_apply(E, acc, cur, wr, wc, fr_, fq_); }
        if (!has_next) break;
#pragma unroll
        for (int a = 0; a < 2; ++a)
#pragma unroll
            for (int b = 0; b < 2; ++b)
#pragma unroll
                for (int m = 0; m < 4; ++m)
#pragma unroll
                    for (int n = 0; n < 2; ++n) acc[a][b][m][n] = (f32x4){0.f, 0.f, 0.f, 0.f};
        cur = nxt; cA = nA; cB = nB; ++ui; cur.seq = ui;
        if constexpr (Sched::GATHER) {
#pragma unroll
            for (int i = 0; i < 2; ++i) { voA0[i] = nvA0[i]; voA1[i] = nvA1[i]; }
        }
        if constexpr (ALIGN_EPI) { if (wr == 1) PG8_BAR; }
    }
    PG8_WAIT_V(0);
    if constexpr (!ALIGN_EPI) { if (wr == 0) PG8_BAR; }
    PG8_BAR;
    if constexpr (Epi::AFTER_DRAIN) { int fr_ = fr, fq_ = fq, lane_ = lane; asm volatile("" : "+v"(fr_), "+v"(fq_), "+v"(lane_)); E.fused(acc, cur, wr, wc, fr_, fq_, lds, wid, lane_); }
#undef PG8_SA
#undef PG8_SB
#undef PG8_STAGE
#undef PG8_LDA
#undef PG8_LDB
#undef PG8_MMA
#undef PG8_WAIT_V
#undef PG8_WAIT_L
#undef PG8_BAR
#undef PG8_SCHED
}
}
using pg8::Unit;

struct DenseSched {
    static constexpr bool GATHER = false;
    const char* A; const char* Bt; unsigned lda, ldb; int nM, nN, ntk, G, c;
    __device__ __forceinline__ bool next(int i, Unit& u) const { return pg8::static_unit(i, G, c, nM, nN, u); }
    __device__ __forceinline__ int nt(const Unit&) const { return ntk; }
    __device__ __forceinline__ const char* a_base(const Unit& u) const { return A + (size_t)u.pm * 256 * lda; }
    __device__ __forceinline__ const char* b_base(const Unit& u) const { return Bt + (size_t)u.pn * 256 * ldb; }
    __device__ __forceinline__ unsigned a_rowoff(const Unit&, int) const { return 0; }
};
struct SsmSSched {
    static constexpr bool GATHER = false;
    const char* U; const char* W; unsigned lda, ldb; int G, c;
    __device__ __forceinline__ bool next(int i, Unit& u) const { const int L = i * G + c; if (L >= NG * SSM_RT) return false; u.aux = L / SSM_RT; u.pm = L % SSM_RT; u.pn = 0; u.kp = -1; return true; }
    __device__ __forceinline__ int nt(const Unit&) const { return NYC / 64; }
    __device__ __forceinline__ const char* a_base(const Unit& u) const { return U + ((size_t)(u.aux * NROWG + u.pm * 256) * UAW + 128) * 2; }
    __device__ __forceinline__ const char* b_base(const Unit& u) const { return W + (size_t)u.aux * 256 * NYC * 2; }
    __device__ __forceinline__ unsigned a_rowoff(const Unit&, int) const { return 0; }
};
struct SsmYSched {
    static constexpr bool GATHER = false;
    const char* U; const char* W; unsigned lda, ldb; int G, c;
    __device__ __forceinline__ bool next(int i, Unit& u) const { const int L = i * G + c; if (L >= NG * SSM_RT * SSM_CT) return false; const int rem = L % (NG * SSM_RT);
        u.pn = SSM_CT - 1 - L / (NG * SSM_RT); u.aux = rem / SSM_RT; u.pm = rem % SSM_RT; u.kp = -1; return true; }
    __device__ __forceinline__ int nt(const Unit& u) const { return 2 + 4 * (u.pn + 1); }
    __device__ __forceinline__ const char* a_base(const Unit& u) const { return U + (size_t)(u.aux * NROWG + u.pm * 256) * UAW * 2; }
    __device__ __forceinline__ const char* b_base(const Unit& u) const { return W + (size_t)(u.aux * NYC + u.pn * 256) * UAW * 2; }
    __device__ __forceinline__ unsigned a_rowoff(const Unit&, int) const { return 0; }
};
struct MoeSched {
    static constexpr bool GATHER = true;
    const char* A; const char* Bt; unsigned lda, ldb; size_t bstride; int nN, ntk, G, c;
    const int* tile_e; const int* slot_tok; const int* ntp;
    __device__ __forceinline__ bool next(int i, Unit& u) const { const int ntiles = *ntp; if (!pg8::static_unit(i, G, c, ntiles, nN, u)) return false; u.aux = tile_e[u.pm]; return true; }
    __device__ __forceinline__ int nt(const Unit&) const { return ntk; }
    __device__ __forceinline__ const char* a_base(const Unit&) const { return A; }
    __device__ __forceinline__ const char* b_base(const Unit& u) const { return Bt + (size_t)u.aux * bstride + (size_t)u.pn * 256 * ldb; }
    __device__ __forceinline__ unsigned a_rowoff(const Unit& u, int r) const { const int s = u.pm * 256 + r; if (slot_tok) { int t = slot_tok[s]; t = t < 0 ? 0 : t; return (unsigned)t * lda; } return (unsigned)s * lda; }
};

constexpr int KSPLIT = 7, MOE_LEFT_ROWS = 2048;
struct MoeDownSched {
    static constexpr bool GATHER = false;
    const char* A; const char* Bt; unsigned lda, ldb; size_t bstride; int G, c; const int* tile_e; const int* ntp;
    __device__ __forceinline__ bool next(int i, Unit& u) const { const int T = *ntp, Tm = T & ~63, nmain = Tm * 4, nmini = (T - Tm) * 4 * KSPLIT;
        const int nr = nmain > c ? (nmain - c + G - 1) / G : 0;
        if (i < nr) { pg8::static_unit(i, G, c, Tm, 4, u); u.aux = tile_e[u.pm]; return true; }
        const int j = (i - nr) * G + c; if (j >= nmini) return false;
        u.pm = Tm + j / (4 * KSPLIT); u.pn = (j / KSPLIT) & 3; u.kp = j % KSPLIT; u.aux = tile_e[u.pm]; return true; }
    __device__ __forceinline__ int nt(const Unit& u) const { return u.kp < 0 ? FFE / 64 : FFE / 64 / KSPLIT; }
    __device__ __forceinline__ const char* a_base(const Unit& u) const { return A + (size_t)u.pm * 256 * lda + (u.kp < 0 ? (size_t)0 : (size_t)u.kp * (FFE / KSPLIT) * 2); }
    __device__ __forceinline__ const char* b_base(const Unit& u) const { return Bt + (size_t)u.aux * bstride + (size_t)u.pn * 256 * ldb + (u.kp < 0 ? (size_t)0 : (size_t)u.kp * (FFE / KSPLIT) * 2); }
    __device__ __forceinline__ unsigned a_rowoff(const Unit&, int) const { return 0; }
};
static_assert((FFE / 64) % (2 * KSPLIT) == 0 && FFE / 64 / KSPLIT >= 4, "K-split parts: an even number of K-tiles, >= 4");

__device__ __forceinline__ v4u pack8(const f32x4& a, const f32x4& b) { v4u w; w.x = pk2(a[0], a[1]); w.y = pk2(a[2], a[3]); w.z = pk2(b[0], b[1]); w.w = pk2(b[2], b[3]); return w; }
struct EpiInProj {
    static constexpr bool PERM = true, AFTER_DRAIN = false; bf16* UA; bf16* PL;
    __device__ __forceinline__ void put8(const Unit& u, int r, int c, const f32x4& v0, const f32x4& v1) const {
        const int m = u.pm * 256 + r, col = u.pn * 256 + c; bf16* dst;
        if (col < 512) { const int g = col >> 4, hc = col & 15, b = m >> 12, l = m & 4095; dst = UA + ((size_t)(g * NROWG + b * NCH + l / TCH) * UAW + 128 + (l % TCH) * 16 + hc); }
        else dst = PL + (size_t)m * 512 + (col - 512);
        *(GAS v4u*)dst = pack8(v0, v1); }
};
struct EpiBf16 {
    static constexpr bool PERM = true, AFTER_DRAIN = false; bf16* O; int ldc;
    __device__ __forceinline__ void put8(const Unit& u, int r, int c, const f32x4& v0, const f32x4& v1) const { *(GAS v4u*)(O + (size_t)(u.pm * 256 + r) * ldc + u.pn * 256 + c) = pack8(v0, v1); }
};
constexpr int RS_OFF = pg8::STAGE_BYTES + 1024;
__device__ __forceinline__ void rs_begin(const float* SSp, const Unit& u, LAS unsigned char* lds, int tid) {
    if (tid < 256) { const GAS f32x4* p = (const GAS f32x4*)(SSp + (size_t)(u.pm * 256 + tid) * 16); const f32x4 a = p[0], b = p[1], c = p[2], d = p[3];
        const float ss = ((a[0] + a[1]) + (a[2] + a[3])) + ((b[0] + b[1]) + (b[2] + b[3])) + ((c[0] + c[1]) + (c[2] + c[3])) + ((d[0] + d[1]) + (d[2] + d[3]));
        ((LAS float*)(lds + RS_OFF + (u.seq & 1) * 2048))[tid] = 1.f / sqrtf(ss * (1.f / DM) + EPS); }
}
struct EpiInProjRs {
    static constexpr bool PERM = true, AFTER_DRAIN = false, BEGIN = true; bf16* UA; bf16* PL; const float* SSp; LAS unsigned char* L;
    __device__ __forceinline__ void unit_begin(const Unit& u, LAS unsigned char* lds, int tid) const { rs_begin(SSp, u, lds, tid); }
    __device__ __forceinline__ void put8(const Unit& u, int r, int c, const f32x4& v0, const f32x4& v1) const {
        const float q = ((const LAS float*)(L + RS_OFF + (u.seq & 1) * 2048))[r];
        const int m = u.pm * 256 + r, col = u.pn * 256 + c; bf16* dst;
        if (col < 512) { const int g = col >> 4, hc = col & 15, b = m >> 12, l = m & 4095; dst = UA + ((size_t)(g * NROWG + b * NCH + l / TCH) * UAW + 128 + (l % TCH) * 16 + hc); }
        else dst = PL + (size_t)m * 512 + (col - 512);
        *(GAS v4u*)dst = pack8(v0 * q, v1 * q); }
};
struct EpiSwigluRs {
    static constexpr bool PERM = true, AFTER_DRAIN = false, PAIR = true, BEGIN = true; bf16* ACT; int ldact; const float* SSp; LAS unsigned char* L;
    __device__ __forceinline__ void unit_begin(const Unit& u, LAS unsigned char* lds, int tid) const { rs_begin(SSp, u, lds, tid); }
    __device__ __forceinline__ void putpair(const Unit& u, int r, int c, const f32x4& g0_, const f32x4& g1_, const f32x4& u0_, const f32x4& u1_) const {
        const float q = ((const LAS float*)(L + RS_OFF + (u.seq & 1) * 2048))[r];
        const f32x4 g0 = g0_ * q, g1 = g1_ * q, u0 = u0_ * q, u1 = u1_ * q; f32x4 a, b;
#pragma unroll
        for (int j = 0; j < 4; ++j) { a[j] = g0[j] * sigmoidf_(g0[j]) * u0[j]; b[j] = g1[j] * sigmoidf_(g1[j]) * u1[j]; }
        *(GAS v4u*)(ACT + (size_t)(u.pm * 256 + r) * ldact + u.pn * 128 + c) = pack8(a, b); }
};
struct EpiGlu {
    static constexpr bool PERM = true, AFTER_DRAIN = false, CUSTOM = true; const bf16* YG; const float* bias; bf16* MIX; float* SS;
    __device__ __forceinline__ void apply(const f32x4 (&acc)[2][2][4][2], const Unit& u, int wr, int wc, int fr, int fq) const {
#pragma unroll
        for (int ai = 0; ai < 2; ++ai)
#pragma unroll
            for (int mi = 0; mi < 4; ++mi) { const int m = u.pm * 256 + ai * 128 + wr * 64 + mi * 16 + fr; float ssq = 0.f;
#pragma unroll
                for (int bj = 0; bj < 2; ++bj) { const int col = u.pn * 256 + bj * 128 + wc * 32 + 8 * fq; const f32x4& v0 = acc[ai][bj][mi][0]; const f32x4& v1 = acc[ai][bj][mi][1];
                    const v4u yw = *(const GAS v4u*)(YG + (size_t)m * 512 + col); const f32x4 b0 = *(const GAS f32x4*)(bias + col), b1 = *(const GAS f32x4*)(bias + col + 4);
                    f32x4 o0, o1; o0[0] = bflo(yw.x) * sigmoidf_(v0[0] + b0[0]); o0[1] = bfhi(yw.x) * sigmoidf_(v0[1] + b0[1]); o0[2] = bflo(yw.y) * sigmoidf_(v0[2] + b0[2]); o0[3] = bfhi(yw.y) * sigmoidf_(v0[3] + b0[3]);
                    o1[0] = bflo(yw.z) * sigmoidf_(v1[0] + b1[0]); o1[1] = bfhi(yw.z) * sigmoidf_(v1[1] + b1[1]); o1[2] = bflo(yw.w) * sigmoidf_(v1[2] + b1[2]); o1[3] = bfhi(yw.w) * sigmoidf_(v1[3] + b1[3]);
                    ssq += (o0[0] * o0[0] + o0[1] * o0[1]) + (o0[2] * o0[2] + o0[3] * o0[3]) + (o1[0] * o1[0] + o1[1] * o1[1]) + (o1[2] * o1[2] + o1[3] * o1[3]);
                    *(GAS v4u*)(MIX + (size_t)m * 1024 + col) = pack8(o0, o1); }
                ssq += __shfl_xor(ssq, 16); ssq += __shfl_xor(ssq, 32);
                if (fq == 0) ((GAS float*)SS)[(size_t)m * 16 + u.pn * 4 + wc] = ssq;
                asm volatile("" ::: "memory"); }
    }
};
struct EpiSsmY {
    static constexpr bool PERM = true, AFTER_DRAIN = false; bf16* YG;
    __device__ __forceinline__ void put8(const Unit& u, int r, int c, const f32x4& v0, const f32x4& v1) const {
        const int rr = u.pm * 256 + r, n = u.pn * 256 + c, tok = (rr / NCH) * SEQ + (rr % NCH) * TCH + (n >> 4);
        f32x4 a, b;
#pragma unroll
        for (int j = 0; j < 4; ++j) { a[j] = gelu_tanh(v0[j]); b[j] = gelu_tanh(v1[j]); }
        *(GAS v4u*)(YG + (size_t)tok * 512 + u.aux * 16 + (n & 15)) = pack8(a, b); }
};
struct EpiResid {
    static constexpr bool PERM = true, AFTER_DRAIN = false, CUSTOM = true; bf16* HB; float ascale; float* SSo;
    __device__ __forceinline__ void apply(const f32x4 (&acc)[2][2][4][2], const Unit& u, int wr, int wc, int fr, int fq) const {
        bf16* base = HB + (size_t)(u.pm * 256 + wr * 64 + fr) * DM + u.pn * 256 + wc * 32 + 8 * fq;
#pragma unroll
        for (int ai = 0; ai < 2; ++ai) { v4u rv[4][2];
#pragma unroll
            for (int m = 0; m < 4; ++m)
#pragma unroll
                for (int bj = 0; bj < 2; ++bj) rv[m][bj] = *(const GAS v4u*)(base + (size_t)(ai * 128 + m * 16) * DM + bj * 128);
#pragma unroll
            for (int m = 0; m < 4; ++m) { float ssq = 0.f;
#pragma unroll
                for (int bj = 0; bj < 2; ++bj) { const v4u x = rv[m][bj]; const f32x4 a0 = acc[ai][bj][m][0] * ascale, a1 = acc[ai][bj][m][1] * ascale; v4u w;
                    const f32x4 h0 = (f32x4){bflo(x.x), bfhi(x.x), bflo(x.y), bfhi(x.y)} + a0, h1 = (f32x4){bflo(x.z), bfhi(x.z), bflo(x.w), bfhi(x.w)} + a1;
                    ssq += ((h0[0] * h0[0] + h0[1] * h0[1]) + (h0[2] * h0[2] + h0[3] * h0[3])) + ((h1[0] * h1[0] + h1[1] * h1[1]) + (h1[2] * h1[2] + h1[3] * h1[3]));
                    w.x = pk2(h0[0], h0[1]); w.y = pk2(h0[2], h0[3]); w.z = pk2(h1[0], h1[1]); w.w = pk2(h1[2], h1[3]);
                    *(GAS v4u*)(base + (size_t)(ai * 128 + m * 16) * DM + bj * 128) = w; }
                ssq += __shfl_xor(ssq, 16); ssq += __shfl_xor(ssq, 32);
                if (fq == 0) ((GAS float*)SSo)[(size_t)(u.pm * 256 + ai * 128 + wr * 64 + m * 16 + fr) * 16 + u.pn * 4 + wc] = ssq; }
            asm volatile("" ::: "memory"); }
    }
};
struct EpiOutProj {
    static constexpr bool PERM = true, AFTER_DRAIN = false, CUSTOM = true, BEGIN = true; static constexpr int MID_T = 8; bf16* HB; const float* SS; float ascale; LAS unsigned char* L; float* SSo;
    __device__ __forceinline__ void unit_begin(const Unit& u, LAS unsigned char* lds, int tid) const {
        if (tid < 256) { const GAS f32x4* p = (const GAS f32x4*)(SS + (size_t)(u.pm * 256 + tid) * 16); const f32x4 a = p[0], b = p[1], c = p[2], d = p[3];
            const float ss = (a[0] + a[1]) + (a[2] + a[3]) + (b[0] + b[1]) + (b[2] + b[3]), sm = (c[0] + c[1]) + (c[2] + c[3]) + (d[0] + d[1]) + (d[2] + d[3]);
            const float rs = 1.f / sqrtf(ss * (1.f / 512) + EPS), rm = 1.f / sqrtf(sm * (1.f / 512) + EPS);
            ((LAS f32x2*)(lds + RS_OFF + (u.seq & 1) * 2048))[tid] = (f32x2){rs / rm, rm}; }
    }
    __device__ __forceinline__ void mid(f32x4 (&acc)[2][2][4][2], const Unit& u, int wr, int fr, LAS unsigned char* lds) const {
        const LAS f32x2* rsp = (const LAS f32x2*)(lds + RS_OFF + (u.seq & 1) * 2048);
#pragma unroll
        for (int ai = 0; ai < 2; ++ai)
#pragma unroll
            for (int m = 0; m < 4; ++m) { const float q = rsp[ai * 128 + wr * 64 + m * 16 + fr][0];
#pragma unroll
                for (int bj = 0; bj < 2; ++bj)
#pragma unroll
                    for (int n = 0; n < 2; ++n) acc[ai][bj][m][n] *= q; }
    }
    __device__ __forceinline__ void apply(const f32x4 (&acc)[2][2][4][2], const Unit& u, int wr, int wc, int fr, int fq) const {
        const LAS f32x2* rsp = (const LAS f32x2*)(L + RS_OFF + (u.seq & 1) * 2048);
        bf16* base = HB + (size_t)(u.pm * 256 + wr * 64 + fr) * DM + u.pn * 256 + wc * 32 + 8 * fq;
#pragma unroll
        for (int ai = 0; ai < 2; ++ai) { v4u rv[4][2];
#pragma unroll
            for (int m = 0; m < 4; ++m)
#pragma unroll
                for (int bj = 0; bj < 2; ++bj) rv[m][bj] = *(const GAS v4u*)(base + (size_t)(ai * 128 + m * 16) * DM + bj * 128);
#pragma unroll
            for (int m = 0; m < 4; ++m) { const float q = rsp[ai * 128 + wr * 64 + m * 16 + fr][1] * ascale; float ssq = 0.f;
#pragma unroll
                for (int bj = 0; bj < 2; ++bj) { const v4u x = rv[m][bj]; const f32x4 a0 = acc[ai][bj][m][0] * q, a1 = acc[ai][bj][m][1] * q; v4u w;
                    const f32x4 h0 = (f32x4){bflo(x.x), bfhi(x.x), bflo(x.y), bfhi(x.y)} + a0, h1 = (f32x4){bflo(x.z), bfhi(x.z), bflo(x.w), bfhi(x.w)} + a1;
                    ssq += ((h0[0] * h0[0] + h0[1] * h0[1]) + (h0[2] * h0[2] + h0[3] * h0[3])) + ((h1[0] * h1[0] + h1[1] * h1[1]) + (h1[2] * h1[2] + h1[3] * h1[3]));
                    w.x = pk2(h0[0], h0[1]); w.y = pk2(h0[2], h0[3]); w.z = pk2(h1[0], h1[1]); w.w = pk2(h1[2], h1[3]);
                    *(GAS v4u*)(base + (size_t)(ai * 128 + m * 16) * DM + bj * 128) = w; }
                ssq += __shfl_xor(ssq, 16); ssq += __shfl_xor(ssq, 32);
                if (fq == 0) ((GAS float*)SSo)[(size_t)(u.pm * 256 + ai * 128 + wr * 64 + m * 16 + fr) * 16 + u.pn * 4 + wc] = ssq; }
            asm volatile("" ::: "memory"); }
    }
};
struct EpiSwiglu {
    static constexpr bool PERM = true, AFTER_DRAIN = false, PAIR = true; bf16* ACT; int ldact;
    __device__ __forceinline__ void putpair(const Unit& u, int r, int c, const f32x4& g0, const f32x4& g1, const f32x4& u0, const f32x4& u1) const {
        f32x4 a, b;
#pragma unroll
        for (int j = 0; j < 4; ++j) { a[j] = g0[j] * sigmoidf_(g0[j]) * u0[j]; b[j] = g1[j] * sigmoidf_(g1[j]) * u1[j]; }
        *(GAS v4u*)(ACT + (size_t)(u.pm * 256 + r) * ldact + u.pn * 128 + c) = pack8(a, b); }
};
template <bool FINAL> struct EpiMoeDown {
    static constexpr bool PERM = true, AFTER_DRAIN = false, CUSTOM = true; const int* slot_tok; const float* slot_w; bf16* HB; float* out; float ascale; const int* ntp; bf16* PART;
    __device__ __forceinline__ void apply(const f32x4 (&acc)[2][2][4][2], const Unit& u, int wr, int wc, int fr, int fq) const {
        int tok[2][4]; float w[2][4]; const int s0 = u.pm * 256 + wr * 64 + fr;
        const int Tm = (*ntp) & ~63;
#pragma unroll
        for (int ai = 0; ai < 2; ++ai)
#pragma unroll
            for (int m = 0; m < 4; ++m) { tok[ai][m] = ((const GAS int*)slot_tok)[s0 + ai * 128 + m * 16]; w[ai][m] = ((const GAS float*)slot_w)[s0 + ai * 128 + m * 16] * ascale; }
        const int cb = u.pn * 256 + wc * 32 + 8 * fq;
        if (u.kp >= 0) {
            bf16* pb = PART + ((size_t)u.kp * MOE_LEFT_ROWS + (size_t)(u.pm - Tm) * 256 + wr * 64 + fr) * DM + cb;
#pragma unroll
            for (int ai = 0; ai < 2; ++ai)
#pragma unroll
                for (int m = 0; m < 4; ++m)
#pragma unroll
                    for (int bj = 0; bj < 2; ++bj) *(GAS v4u*)(pb + (size_t)(ai * 128 + m * 16) * DM + bj * 128) = pack8(acc[ai][bj][m][0] * w[ai][m], acc[ai][bj][m][1] * w[ai][m]);
            return; }
#pragma unroll
        for (int ai = 0; ai < 2; ++ai) { v4u rv[4][2];
#pragma unroll
            for (int m = 0; m < 4; ++m) { const int t = tok[ai][m] < 0 ? 0 : tok[ai][m];
#pragma unroll
                for (int bj = 0; bj < 2; ++bj) rv[m][bj] = *(const GAS v4u*)(HB + (size_t)t * DM + cb + bj * 128); }
#pragma unroll
            for (int m = 0; m < 4; ++m) { if (tok[ai][m] < 0) continue;
#pragma unroll
                for (int bj = 0; bj < 2; ++bj) { const v4u x = rv[m][bj]; const f32x4 a0 = acc[ai][bj][m][0] * w[ai][m], a1 = acc[ai][bj][m][1] * w[ai][m];
                    const f32x4 r0 = {bflo(x.x) + a0[0], bfhi(x.x) + a0[1], bflo(x.y) + a0[2], bfhi(x.y) + a0[3]}, r1 = {bflo(x.z) + a1[0], bfhi(x.z) + a1[1], bflo(x.w) + a1[2], bfhi(x.w) + a1[3]};
                    if constexpr (FINAL) { GAS f32x4* o = (GAS f32x4*)(out + (size_t)tok[ai][m] * DM + cb + bj * 128); o[0] = r0; o[1] = r1; }
                    else *(GAS v4u*)(HB + (size_t)tok[ai][m] * DM + cb + bj * 128) = pack8(r0, r1); } }
            asm volatile("" ::: "memory"); }
    }
};
struct EpiSsmS {
    static constexpr bool PERM = false, AFTER_DRAIN = true; bf16* UA; const float* aT;
    __device__ __forceinline__ void fused(const f32x4 (&acc)[2][2][4][2], const Unit& u, int wr, int wc, int fr, int fq, LAS unsigned char* lds, int wid, int lane) const {
        LAS float* T = (LAS float*)lds;
#pragma unroll
        for (int ai = 0; ai < 2; ++ai)
#pragma unroll
            for (int m = 0; m < 4; ++m) { const int r = ai * 128 + wr * 64 + m * 16 + fr;
#pragma unroll
                for (int n = 0; n < 2; ++n) *(LAS f32x4*)(T + r * 128 + wc * 32 + 16 * n + 4 * fq) = acc[ai][0][m][n]; }
        LDS_WAIT(); __builtin_amdgcn_s_barrier(); asm volatile("" ::: "memory");
        const int tid = wid * 64 + lane;
        if (tid < 64 * (256 / NCH)) { const int bl = tid >> 6, p = tid & 63, g = u.aux; const float ar = aT[(g * 64 + p) * 2], ai_ = aT[(g * 64 + p) * 2 + 1]; float sr = 0.f, si = 0.f;
            bf16* dst = UA + (size_t)(g * NROWG + u.pm * 256 + bl * NCH) * UAW;
            for (int c = 0; c < NCH; ++c) { dst[(size_t)c * UAW + p] = f2bf(sr); dst[(size_t)c * UAW + 64 + p] = f2bf(si);
                const float lr = T[(bl * NCH + c) * 128 + p], li = T[(bl * NCH + c) * 128 + 64 + p]; const float nr = ar * sr - ai_ * si + lr, ni = ar * si + ai_ * sr + li; sr = nr; si = ni; } }
        LDS_WAIT(); __builtin_amdgcn_s_barrier(); asm volatile("" ::: "memory");
    }
};

struct RmId { int off; __device__ __forceinline__ int operator()(int n) const { return off + n; } };
struct RmGU { int up; __device__ __forceinline__ int operator()(int n) const { return 256 * (n >> 7) + 128 * up + (n & 127); } };
struct KgNone { __device__ __forceinline__ float operator()(int) const { return 1.f; } };
struct KgVec { const float* g; __device__ __forceinline__ float operator()(int k) const { return ((const GAS float*)g)[k]; } };
struct KgOut { const float* gs; const float* gm; __device__ __forceinline__ float operator()(int k) const { return k < 512 ? ((const GAS float*)gs)[k] : ((const GAS float*)gm)[k - 512]; } };
template <class RowMap, class KG = KgNone> __device__ __forceinline__ void tr_matrix(const float* W, int K, int N, bf16* WT, int ldt, RowMap rm, LAS float* scr, int gw, int NGW, int lane, KG kg = KG()) { asm volatile("" : "+v"(lane));
    const int nnb = N / 32, items = (K / 64) * nnb; const int rr = lane >> 3, c4 = (lane & 7) * 4, c = lane & 7;
    int it = gw; if (it >= items) return;
    f32x4 v[8];
#pragma unroll
    for (int i = 0; i < 8; ++i) v[i] = *(const GAS f32x4*)(W + (size_t)(64 * (it / nnb) + 8 * i + rr) * N + 32 * (it % nnb) + c4);
    for (;;) {
        const int k0 = 64 * (it / nnb), n0 = 32 * (it % nnb), nx = it + NGW; const bool more = nx < items;
#pragma unroll
        for (int i = 0; i < 8; ++i) { LAS float* d = scr + (8 * i + rr) * 33 + c4; const float g_ = kg(k0 + 8 * i + rr); d[0] = v[i][0] * g_; d[1] = v[i][1] * g_; d[2] = v[i][2] * g_; d[3] = v[i][3] * g_; }
        if (more) {
#pragma unroll
            for (int i = 0; i < 8; ++i) v[i] = *(const GAS f32x4*)(W + (size_t)(64 * (nx / nnb) + 8 * i + rr) * N + 32 * (nx % nnb) + c4); }
        LDS_WAIT(); asm volatile("" ::: "memory");
#pragma unroll
        for (int j = 0; j < 4; ++j) { const int n = (lane >> 3) + 8 * j; const LAS float* sp = scr + (8 * c) * 33 + n;
            v4u o; o.x = pk2(sp[0 * 33], sp[1 * 33]); o.y = pk2(sp[2 * 33], sp[3 * 33]); o.z = pk2(sp[4 * 33], sp[5 * 33]); o.w = pk2(sp[6 * 33], sp[7 * 33]);
            *(GAS v4u*)(WT + (size_t)rm(n0 + n) * ldt + k0 + 8 * c) = o; }
        LDS_WAIT(); asm volatile("" ::: "memory");
        if (!more) break; it = nx;
    }
}
__device__ __forceinline__ void zero_bf16(bf16* p, size_t n8  , int gtid, int gthreads) { asm volatile("" : "+v"(gtid)); for (size_t i = gtid; i < n8; i += gthreads) ((v4u*)p)[i] = (v4u){0u, 0u, 0u, 0u}; }

__device__ __forceinline__ int rot(int gw, int NGW, int off) { int r = gw - (off % NGW); return r < 0 ? r + NGW : r; }
__device__ __forceinline__ void conv_small(unsigned char* ws_, int layer, LAS float* scr, int gw, int NGW, int lane, int gtid, int gthreads) {
    unsigned char* wb = ws_ + WS_WSMALL + (size_t)layer * WSM_STRIDE;
    bf16* Win_t = (bf16*)(wb + WSM_IN); bf16* Wglu_t = (bf16*)(wb + WSM_GLU); bf16* Wq_t = (bf16*)(wb + WSM_Q); bf16* Wkv_t = (bf16*)(wb + WSM_KV); bf16* Wout_t = (bf16*)(wb + WSM_OUT);
    constexpr int N_IN = (DM / 64) * (DIN / 32), N_GLU = (DSSM / 64) * (DSSM / 32), N_Q = (QRANK / 64) * (768 / 32), N_KV = (KVRANK / 64) * (1024 / 32);
    tr_matrix(kin(I_W_IN) + (size_t)layer * DM * DIN, DM, DIN, Win_t, DM, RmId{0}, scr, gw, NGW, lane, KgVec{kin(I_ATTN_NORM) + layer * DM});
    tr_matrix(kin(I_W_GLU) + (size_t)layer * DSSM * DSSM, DSSM, DSSM, Wglu_t, DSSM, RmId{0}, scr, rot(gw, NGW, N_IN), NGW, lane);
    tr_matrix(kin(I_W_Q_UP) + (size_t)layer * QRANK * 768, QRANK, 768, Wq_t, QRANK, RmId{0}, scr, rot(gw, NGW, N_IN + N_GLU), NGW, lane);
    tr_matrix(kin(I_W_KV_UP) + (size_t)layer * KVRANK * 1024, KVRANK, 1024, Wkv_t, 256, RmId{0}, scr, rot(gw, NGW, N_IN + N_GLU + N_Q), NGW, lane);
    tr_matrix(kin(I_W_OUT) + (size_t)layer * DM * DM, DM, DM, Wout_t, DM, RmId{0}, scr, rot(gw, NGW, N_IN + N_GLU + N_Q + N_KV), NGW, lane, KgOut{kin(I_SSM_OUT_NORM) + layer * DSSM, kin(I_MLA_OUT_NORM) + layer * DSSM});
    zero_bf16(Win_t + (size_t)DIN * DM, (size_t)(1024 - DIN) * DM / 8, gtid, gthreads);
    asm volatile("" : "+v"(gtid));
    for (int i = gtid; i < 1024 * 16; i += gthreads) ((v4u*)(Wkv_t + (size_t)(i >> 4) * 256 + 128))[i & 15] = (v4u){0u, 0u, 0u, 0u};
}
__device__ __forceinline__ void conv_dense(unsigned char* ws_, LAS float* scr, int gw, int NGW, int lane) {
    bf16* Wgu = (bf16*)(ws_ + WS_BIGW + BW_DGU); bf16* Wd = (bf16*)(ws_ + WS_BIGW + BW_DD);
    tr_matrix(kin(I_DW_GATE), DM, FFD, Wgu, DM, RmGU{0}, scr, gw, NGW, lane, KgVec{kin(I_FFN_NORM)});
    tr_matrix(kin(I_DW_UP), DM, FFD, Wgu, DM, RmGU{1}, scr, gw, NGW, lane, KgVec{kin(I_FFN_NORM)});
    tr_matrix(kin(I_DW_DOWN), FFD, DM, Wd, FFD, RmId{0}, scr, gw, NGW, lane);
}
__device__ __forceinline__ void conv_moe(unsigned char* ws_, LAS float* scr, int gw, int NGW, int lane) {
    bf16* Wgu = (bf16*)(ws_ + WS_BIGW + BW_MGU); bf16* Wd = (bf16*)(ws_ + WS_BIGW + BW_MD);
    for (int e = 0; e < NE; ++e) {
        tr_matrix(kin(I_MW_GATE) + (size_t)e * DM * FFE, DM, FFE, Wgu + (size_t)e * 2 * FFE * DM, DM, RmGU{0}, scr, gw, NGW, lane);
        tr_matrix(kin(I_MW_UP) + (size_t)e * DM * FFE, DM, FFE, Wgu + (size_t)e * 2 * FFE * DM, DM, RmGU{1}, scr, gw, NGW, lane);
        tr_matrix(kin(I_MW_DOWN) + (size_t)e * FFE * DM, FFE, DM, Wd + (size_t)e * DM * FFE, FFE, RmId{0}, scr, gw, NGW, lane);
    }
}
__device__ __forceinline__ void rms_row(const float* xrow, const float* g, bf16* orow, int lane) {
    const GAS f32x4* xr = (const GAS f32x4*)xrow + lane; const GAS f32x4* gr = (const GAS f32x4*)g + lane; f32x4 v[4]; float s = 0.f;
#pragma unroll
    for (int j = 0; j < 4; ++j) { v[j] = xr[64 * j]; s += (v[j][0] * v[j][0] + v[j][1] * v[j][1]) + (v[j][2] * v[j][2] + v[j][3] * v[j][3]); }
    const float rstd = 1.f / sqrtf(wave_sum(s) * (1.f / DM) + EPS);
    GAS v2u* o8 = (GAS v2u*)orow + lane;
#pragma unroll
    for (int j = 0; j < 4; ++j) { const f32x4 gg = gr[64 * j]; v2u w; w.x = pk2(v[j][0] * rstd * gg[0], v[j][1] * rstd * gg[1]); w.y = pk2(v[j][2] * rstd * gg[2], v[j][3] * rstd * gg[3]); o8[64 * j] = w; }
}
__device__ __forceinline__ void rms_row_b(const bf16* xrow, const float* g, bf16* orow, int lane) {
    const v4u a = *((const GAS v4u*)xrow + lane), b = *((const GAS v4u*)xrow + 64 + lane);
    float v[16] = {bflo(a.x), bfhi(a.x), bflo(a.y), bfhi(a.y), bflo(a.z), bfhi(a.z), bflo(a.w), bfhi(a.w), bflo(b.x), bfhi(b.x), bflo(b.y), bfhi(b.y), bflo(b.z), bfhi(b.z), bflo(b.w), bfhi(b.w)}; float s = 0.f;
#pragma unroll
    for (int j = 0; j < 16; ++j) s += v[j] * v[j];
    const float rstd = 1.f / sqrtf(wave_sum(s) * (1.f / DM) + EPS);
    const f32x4 g0 = *((const GAS f32x4*)g + 2 * lane), g1 = *((const GAS f32x4*)g + 2 * lane + 1), g2 = *((const GAS f32x4*)g + 128 + 2 * lane), g3 = *((const GAS f32x4*)g + 128 + 2 * lane + 1);
    v4u w; w.x = pk2(v[0] * rstd * g0[0], v[1] * rstd * g0[1]); w.y = pk2(v[2] * rstd * g0[2], v[3] * rstd * g0[3]); w.z = pk2(v[4] * rstd * g1[0], v[5] * rstd * g1[1]); w.w = pk2(v[6] * rstd * g1[2], v[7] * rstd * g1[3]);
    *((GAS v4u*)orow + lane) = w;
    w.x = pk2(v[8] * rstd * g2[0], v[9] * rstd * g2[1]); w.y = pk2(v[10] * rstd * g2[2], v[11] * rstd * g2[3]); w.z = pk2(v[12] * rstd * g3[0], v[13] * rstd * g3[1]); w.w = pk2(v[14] * rstd * g3[2], v[15] * rstd * g3[3]);
    *((GAS v4u*)orow + 64 + lane) = w;
}
__device__ __forceinline__ void ph_rmsnorm_b(const bf16* HB, const float* g, bf16* Z, int gw, int NGW, int lane) { asm volatile("" : "+v"(lane)); for (int m = gw; m < M; m += NGW) rms_row_b(HB + (size_t)m * DM, g, Z + (size_t)m * DM, lane); }
__device__ __forceinline__ void ph_x2hb(const float* x, bf16* HB, float* SSo, int gw, int NGW, int lane) { asm volatile("" : "+v"(lane));
    constexpr int R = 2;
    for (int mb = gw * R; mb < M; mb += NGW * R) { f32x4 v[R][4];
#pragma unroll
        for (int r = 0; r < R; ++r)
#pragma unroll
            for (int j = 0; j < 4; ++j) v[r][j] = *((const GAS f32x4*)(x + (size_t)(mb + r) * DM) + 64 * j + lane);
#pragma unroll
        for (int r = 0; r < R; ++r) { const int m = mb + r; float s = 0.f;
#pragma unroll
            for (int j = 0; j < 4; ++j) s += (v[r][j][0] * v[r][j][0] + v[r][j][1] * v[r][j][1]) + (v[r][j][2] * v[r][j][2] + v[r][j][3] * v[r][j][3]);
            s = wave_sum(s);
            GAS v2u* h8 = (GAS v2u*)(HB + (size_t)m * DM) + lane;
#pragma unroll
            for (int j = 0; j < 4; ++j) { v2u hw; hw.x = pk2(v[r][j][0], v[r][j][1]); hw.y = pk2(v[r][j][2], v[r][j][3]); h8[64 * j] = hw; }
            if (lane < 4) ((GAS f32x4*)(SSo + (size_t)m * 16))[lane] = (f32x4){lane == 0 ? s : 0.f, 0.f, 0.f, 0.f}; } }
}
__device__ __forceinline__ void ph_rmsnorm(const float* h, const float* g, bf16* Z, int gw, int NGW, int lane) { asm volatile("" : "+v"(lane)); for (int m = gw; m < M; m += NGW) rms_row(h + (size_t)m * DM, g, Z + (size_t)m * DM, lane); }
__device__ __forceinline__ void ph_latnorm(const bf16* PL, const float* gq, const float* gkv, bf16* LAT, int gw, int NGW, int lane) { asm volatile("" : "+v"(lane));
    constexpr int R = 8;
    const f32x4 g4 = *((const GAS f32x4*)gq + lane); const f32x2 g2 = *((const GAS f32x2*)gkv + lane);
    for (int mb = gw * R; mb < M; mb += NGW * R) { v2u qa[R]; unsigned ka[R];
#pragma unroll
        for (int r = 0; r < R; ++r) { qa[r] = *((const GAS v2u*)(PL + (size_t)(mb + r) * 512) + lane); ka[r] = *((const GAS unsigned*)(PL + (size_t)(mb + r) * 512 + 256) + lane); }
#pragma unroll
        for (int r = 0; r < R; ++r) { const int m = mb + r;
            const float q0 = bflo(qa[r].x), q1 = bfhi(qa[r].x), q2 = bflo(qa[r].y), q3 = bfhi(qa[r].y), k0 = bflo(ka[r]), k1 = bfhi(ka[r]);
            const float rq = 1.f / sqrtf(wave_sum(q0 * q0 + q1 * q1 + q2 * q2 + q3 * q3) * (1.f / 256) + EPS), rk = 1.f / sqrtf(wave_sum(k0 * k0 + k1 * k1) * (1.f / 128) + EPS);
            v2u w; w.x = pk2(q0 * rq * g4[0], q1 * rq * g4[1]); w.y = pk2(q2 * rq * g4[2], q3 * rq * g4[3]); *((GAS v2u*)(LAT + (size_t)m * 512) + lane) = w;
            *((GAS unsigned*)(LAT + (size_t)m * 512 + 256) + lane) = pk2(k0 * rk * g2[0], k1 * rk * g2[1]); *((GAS unsigned*)(LAT + (size_t)m * 512 + 384) + lane) = 0u; } }
}
constexpr float QSCALE = 0.10206207261596575f * 1.4426950408889634f;
__device__ __forceinline__ void ph_qkprep(const bf16* KVR, const bf16* PL, bf16* KN, const float* kg, int gw, int NGW, int lane) { asm volatile("" : "+v"(lane));
    const int hd = lane >> 3, sub = lane & 7;
    float gk[12];
#pragma unroll
    for (int j = 0; j < 8; ++j) gk[j] = ((const GAS float*)kg)[sub * 8 + j];
#pragma unroll
    for (int j = 0; j < 2; ++j) { gk[8 + j] = ((const GAS float*)kg)[64 + sub * 2 + j]; gk[10 + j] = ((const GAS float*)kg)[80 + sub * 2 + j]; }
    const float ir0 = exp2f(-(float)(sub * 2) * (13.287712379549449f / 16.f)) * 0.15915494309189535f, ir1 = exp2f(-(float)(sub * 2 + 1) * (13.287712379549449f / 16.f)) * 0.15915494309189535f;
    constexpr int R = 8;
    for (int mb = gw * R; mb < M; mb += NGW * R) { v4u kn[R]; unsigned kx1[R], kx2[R];
#pragma unroll
        for (int r = 0; r < R; ++r) { const int m = mb + r; const bf16* kp = KVR + (size_t)m * 1024 + hd * 128; const bf16* rp = PL + (size_t)m * 512 + 384;
            kn[r] = *(const GAS v4u*)(kp + sub * 8); kx1[r] = *(const GAS unsigned*)(rp + sub * 2); kx2[r] = *(const GAS unsigned*)(rp + 16 + sub * 2); }
#pragma unroll
        for (int r = 0; r < R; ++r) { const int m = mb + r; const int pos = m & (SEQ - 1);
            const float a0 = __builtin_amdgcn_fractf((float)pos * ir0), a1 = __builtin_amdgcn_fractf((float)pos * ir1);
            const float s0 = __builtin_amdgcn_sinf(a0), c0 = __builtin_amdgcn_cosf(a0), s1 = __builtin_amdgcn_sinf(a1), c1 = __builtin_amdgcn_cosf(a1);
            float k[12] = {bflo(kn[r].x), bfhi(kn[r].x), bflo(kn[r].y), bfhi(kn[r].y), bflo(kn[r].z), bfhi(kn[r].z), bflo(kn[r].w), bfhi(kn[r].w), bflo(kx1[r]), bfhi(kx1[r]), bflo(kx2[r]), bfhi(kx2[r])};
            float sk = 0.f;
#pragma unroll
            for (int j = 0; j < 12; ++j) sk += k[j] * k[j];
            sk += __shfl_xor(sk, 1); sk += __shfl_xor(sk, 2); sk += __shfl_xor(sk, 4);
            const float rk = 1.f / sqrtf(sk * (1.f / 96) + EPS);
#pragma unroll
            for (int j = 0; j < 12; ++j) k[j] *= rk * gk[j];
            const float ka0 = k[8] * c0 - k[10] * s0, kb0 = k[8] * s0 + k[10] * c0, ka1 = k[9] * c1 - k[11] * s1, kb1 = k[9] * s1 + k[11] * c1;
            bf16* ko = KN + (size_t)m * 768 + hd * 96; v4u w;
            w.x = pk2(k[0], k[1]); w.y = pk2(k[2], k[3]); w.z = pk2(k[4], k[5]); w.w = pk2(k[6], k[7]);
            *(GAS v4u*)(ko + sub * 8) = w; *(GAS unsigned*)(ko + 64 + sub * 2) = pk2(ka0, ka1); *(GAS unsigned*)(ko + 80 + sub * 2) = pk2(kb0, kb1); } }
}
__device__ __forceinline__ void ph_outnorm(bf16* MIX, const float* gs, const float* gm, int gw, int NGW, int lane) { asm volatile("" : "+v"(lane));
    for (int m = gw; m < M; m += NGW) { v4u* rp = (v4u*)(MIX + (size_t)m * 1024) + 2 * lane;
        const v4u a = rp[0], b = rp[1]; float v[16] = {bflo(a.x), bfhi(a.x), bflo(a.y), bfhi(a.y), bflo(a.z), bfhi(a.z), bflo(a.w), bfhi(a.w), bflo(b.x), bfhi(b.x), bflo(b.y), bfhi(b.y), bflo(b.z), bfhi(b.z), bflo(b.w), bfhi(b.w)}; float s = 0.f;
#pragma unroll
        for (int j = 0; j < 16; ++j) s += v[j] * v[j];
#pragma unroll
        for (int o = 1; o < 32; o <<= 1) s += __shfl_xor(s, o);
        const float rstd = 1.f / sqrtf(s * (1.f / 512) + EPS); const float* g = (lane < 32 ? gs : gm) + (lane & 31) * 16;
#pragma unroll
        for (int j = 0; j < 16; ++j) v[j] *= rstd * g[j];
        v4u w; w.x = pk2(v[0], v[1]); w.y = pk2(v[2], v[3]); w.z = pk2(v[4], v[5]); w.w = pk2(v[6], v[7]); rp[0] = w;
        w.x = pk2(v[8], v[9]); w.y = pk2(v[10], v[11]); w.z = pk2(v[12], v[13]); w.w = pk2(v[14], v[15]); rp[1] = w; }
}
__device__ __forceinline__ void ph_norm_route(const bf16* HB, const float* g, const float* Wr, bf16* Z, v4u* route, int gw, int NGW, int lane) { asm volatile("" : "+v"(lane));
    float gg[16], wg[16][8];
#pragma unroll
    for (int j = 0; j < 4; ++j) { const f32x4 g4 = *((const GAS f32x4*)g + 64 * j + lane);
#pragma unroll
        for (int q = 0; q < 4; ++q) { gg[4 * j + q] = g4[q]; const GAS f32x4* wr = (const GAS f32x4*)(Wr + (size_t)(256 * j + 4 * lane + q) * 8); const f32x4 wa = wr[0], wb = wr[1];
#pragma unroll
            for (int e = 0; e < 4; ++e) { wg[4 * j + q][e] = wa[e] * g4[q]; wg[4 * j + q][4 + e] = wb[e] * g4[q]; } } }
    constexpr int R = 4;
    for (int mb = gw * R; mb < M; mb += NGW * R) { v2u x[R][4];
#pragma unroll
        for (int r = 0; r < R; ++r)
#pragma unroll
            for (int j = 0; j < 4; ++j) x[r][j] = *((const GAS v2u*)(HB + (size_t)(mb + r) * DM) + 64 * j + lane);
#pragma unroll
        for (int r = 0; r < R; ++r) { const int m = mb + r; float v[16]; float s = 0.f;
#pragma unroll
            for (int j = 0; j < 4; ++j) { v[4 * j] = bflo(x[r][j].x); v[4 * j + 1] = bfhi(x[r][j].x); v[4 * j + 2] = bflo(x[r][j].y); v[4 * j + 3] = bfhi(x[r][j].y); }
#pragma unroll
            for (int i = 0; i < 16; ++i) s += v[i] * v[i];
            const float rstd = 1.f / sqrtf(wave_sum(s) * (1.f / DM) + EPS);
            float lg[8] = {0.f, 0.f, 0.f, 0.f, 0.f, 0.f, 0.f, 0.f};
#pragma unroll
            for (int i = 0; i < 16; ++i)
#pragma unroll
                for (int e = 0; e < 8; ++e) lg[e] += v[i] * wg[i][e];
#pragma unroll
            for (int j = 0; j < 4; ++j) { v2u w; w.x = pk2(v[4 * j] * rstd * gg[4 * j], v[4 * j + 1] * rstd * gg[4 * j + 1]); w.y = pk2(v[4 * j + 2] * rstd * gg[4 * j + 2], v[4 * j + 3] * rstd * gg[4 * j + 3]); *((GAS v2u*)(Z + (size_t)m * DM) + 64 * j + lane) = w; }
            {
              const bool b5 = (lane & 32) != 0, b4 = (lane & 16) != 0, b3 = (lane & 8) != 0; float a4[4], a2[2];
#pragma unroll
              for (int e = 0; e < 4; ++e) a4[e] = (b5 ? lg[e + 4] : lg[e]) + __shfl_xor(b5 ? lg[e] : lg[e + 4], 32);
#pragma unroll
              for (int e = 0; e < 2; ++e) a2[e] = (b4 ? a4[e + 2] : a4[e]) + __shfl_xor(b4 ? a4[e] : a4[e + 2], 16);
              float c1 = (b3 ? a2[1] : a2[0]) + __shfl_xor(b3 ? a2[0] : a2[1], 8);
              c1 += __shfl_xor(c1, 4); c1 += __shfl_xor(c1, 2); c1 += __shfl_xor(c1, 1);
#pragma unroll
              for (int e = 0; e < 8; ++e) lg[e] = __builtin_bit_cast(float, __builtin_amdgcn_readlane(__builtin_bit_cast(int, c1), 8 * e)) * rstd; }
            int e0 = 0; float v0 = lg[0];
#pragma unroll
            for (int e = 1; e < 8; ++e) if (lg[e] > v0) { v0 = lg[e]; e0 = e; }
            int e1 = -1; float v1 = -3.0e38f;
#pragma unroll
            for (int e = 0; e < 8; ++e) if (e != e0 && lg[e] > v1) { v1 = lg[e]; e1 = e; }
            const float w1 = 1.f / (1.f + expf(v0 - v1)), w0 = 1.f - w1;
            if (lane == 0) { ((GAS v2u*)route)[m] = (v2u){(unsigned)e0, (unsigned)e1}; ((GAS f32x2*)((unsigned char*)route + 256 * 1024))[m] = (f32x2){w0, w1}; } } }
}
__device__ __forceinline__ void ph_route_sort(const v4u* route, unsigned char* rt, LAS unsigned char* lds, int tid) { asm volatile("" : "+v"(tid));
    int* slot_tok = (int*)(rt + RT_SLOT_TOK); float* slot_w = (float*)(rt + RT_SLOT_W); int* tile_e = (int*)(rt + RT_TILE_E); int* ntl = (int*)(rt + RT_NTILES);
    const v2u* re = (const v2u*)route; const f32x2* rw = (const f32x2*)((const unsigned char*)route + 256 * 1024);
    LAS int* wtot = (LAS int*)lds;
    LAS int* wbase = wtot + 128;
    LAS int* etot = wbase + 128;
    const int lane = tid & 63, w = tid >> 6;
    int c[16];
#pragma unroll
    for (int j = 0; j < 16; ++j) c[j] = 0;
    for (int i = 0; i < 64; ++i) { const v2u r = re[w * 4096 + i * 64 + lane];
#pragma unroll
        for (int j = 0; j < 8; ++j) { c[j] += __popcll(__ballot(r.x == (unsigned)j)); c[8 + j] += __popcll(__ballot(r.y == (unsigned)j)); } }
    if (lane == 0) {
#pragma unroll
        for (int j = 0; j < 16; ++j) wtot[w * 16 + j] = c[j]; }
    __syncthreads();
    if (tid < 16) { int s = 0; for (int ww = 0; ww < 8; ++ww) { wbase[ww * 16 + tid] = s; s += wtot[ww * 16 + tid]; } etot[tid] = s; }
    __syncthreads();
    if (tid < 2) { int off = 0; for (int e = 0; e < 8; ++e) { const int n = etot[tid * 8 + e]; const int pad = (n + 255) & ~255; etot[16 + tid * 8 + e] = off;
            for (int t = off / 256; t < (off + pad) / 256; ++t) tile_e[tid * MOE_TILES + t] = e; off += pad; } ntl[tid] = off / 256; }
    __syncthreads();
    for (int j = 0; j < 16; ++j) { const int n = etot[j], off = etot[16 + j], pad = (n + 255) & ~255, k = j >> 3; for (int s = off + n + tid; s < off + pad; s += 512) { slot_tok[k * MOE_SLOTS + s] = -1; slot_w[k * MOE_SLOTS + s] = 0.f; } }
#pragma unroll
    for (int j = 0; j < 16; ++j) c[j] = wbase[w * 16 + j] + etot[16 + j];
    const unsigned long long ltmask = (1ull << lane) - 1ull;
    for (int i = 0; i < 64; ++i) { const int m = w * 4096 + i * 64 + lane; const v2u r = re[m]; const f32x2 wv = rw[m]; int s0 = 0, s1 = 0;
#pragma unroll
        for (int j = 0; j < 8; ++j) { const unsigned long long b0 = __ballot(r.x == (unsigned)j), b1 = __ballot(r.y == (unsigned)j);
            if (r.x == (unsigned)j) s0 = c[j] + __popcll(b0 & ltmask); if (r.y == (unsigned)j) s1 = c[8 + j] + __popcll(b1 & ltmask);
            c[j] += __popcll(b0); c[8 + j] += __popcll(b1); }
        slot_tok[s0] = m; slot_w[s0] = wv[0]; slot_tok[MOE_SLOTS + s1] = m; slot_w[MOE_SLOTS + s1] = wv[1]; }
}
__device__ __forceinline__ void ph_ssm_prep(unsigned char* ws_, int layer, int g, int part, LAS unsigned char* lds, int tid) { asm volatile("" : "+v"(tid));
    LAS float* apr = (LAS float*)lds;
    LAS float* api = apr + 64 * TP1;
    LAS float* bbr = api + 64 * TP1;
    LAS float* bbi = bbr + 1024;
    LAS float* ccr = bbi + 1024;
    LAS float* cci = ccr + 1024;
    LAS float* kt = cci + 1024;
    constexpr int BAND = TCH / 8;
    const float* A_re = kin(I_A_RE) + (size_t)(layer * NG + g) * NP; const float* A_im = kin(I_A_IM) + (size_t)(layer * NG + g) * NP;
    const float step = expf(kin(I_LOG_STEP)[layer * NG + g]);
    const float* B_re = kin(I_B_RE) + (size_t)(layer * NG + g) * NP * GH; const float* B_im = kin(I_B_IM) + (size_t)(layer * NG + g) * NP * GH;
    const float* C_re = kin(I_C_RE) + (size_t)(layer * NG + g) * GH * NP; const float* C_im = kin(I_C_IM) + (size_t)(layer * NG + g) * GH * NP;
    const float* Dv = kin(I_D) + (size_t)(layer * NG + g) * GH;
    for (int i = tid; i < 64 * TP1; i += 512) { const int p = i / TP1, tau = i % TP1; const float e = expf(A_re[p] * step * (float)tau); float sn, cs; sincosf(A_im[p] * step * (float)tau, &sn, &cs); apr[i] = e * cs; api[i] = e * sn; }
    for (int i = tid; i < 1024; i += 512) { const int p = i >> 4; const float lr = A_re[p], li = A_im[p]; const float e = expf(lr * step); float sn, cs; sincosf(li * step, &sn, &cs);
        const float nr = e * cs - 1.f, ni = e * sn, den = lr * lr + li * li, sr = (nr * lr + ni * li) / den, si = (ni * lr - nr * li) / den;
        const float br = B_re[i], bi = B_im[i]; bbr[i] = br * sr - bi * si; bbi[i] = br * si + bi * sr; ccr[i] = C_re[i]; cci[i] = C_im[i]; }
    __syncthreads();
    for (int i = tid; i < BAND * 256; i += 512) { const int tau = BAND * part + (i >> 8), h = (i >> 4) & 15, h2 = i & 15; float s = 0.f;
        for (int p = 0; p < 64; ++p) { const float cr = ccr[h * 64 + p], ci = cci[h * 64 + p], ar = apr[p * TP1 + tau], ai = api[p * TP1 + tau], br = bbr[p * 16 + h2], bi = bbi[p * 16 + h2];
            const float xr = cr * ar - ci * ai, xi = cr * ai + ci * ar; s += xr * br - xi * bi; }
        if (tau == 0 && h == h2) s += Dv[h];
        kt[i] = s; }
    if (part == 0 && tid < 64) { float* aT = (float*)(ws_ + WS_APOW) + (size_t)(g * 64 + tid) * 2; aT[0] = apr[tid * TP1 + TCH]; aT[1] = api[tid * TP1 + TCH]; }
    __syncthreads();
    bf16* Mg = (bf16*)(ws_ + WS_BIGW + BW_MAUG) + (size_t)g * NYC * UAW;
    { const int t0 = BAND * part;
      for (int i = tid; i < BAND * TCH * 32; i += 512) { const int tl = i / (TCH * 32), t = (i >> 5) % TCH, h = (i >> 1) & 15, hf = i & 1, tau = t0 + tl, sft = t - tau; if (sft < 0) continue;
          const LAS f32x4* src = (const LAS f32x4*)(kt + (tl << 8) + h * 16 + hf * 8); const f32x4 x = src[0], y = src[1];
          v4u w; w.x = pk2(x[0], x[1]); w.y = pk2(x[2], x[3]); w.z = pk2(y[0], y[1]); w.w = pk2(y[2], y[3]);
          *(GAS v4u*)(Mg + (size_t)(t * 16 + h) * UAW + 128 + sft * 16 + hf * 8) = w; } }
    for (int i = tid; i < (NYC / 8) * (UAW / 8); i += 512) { const int n = part * (NYC / 8) + i / (UAW / 8), k0 = (i % (UAW / 8)) * 8, t = n >> 4, h = n & 15; float v[8];
        if (k0 >= 128) { if (((k0 - 128) >> 4) <= t) continue;
#pragma unroll
            for (int j = 0; j < 8; ++j) v[j] = 0.f; }
        else {
#pragma unroll
            for (int j = 0; j < 8; ++j) { const int k = k0 + j, p = k & 63; const float cr = ccr[h * 64 + p], ci = cci[h * 64 + p], ar = apr[p * TP1 + t + 1], ai = api[p * TP1 + t + 1];
                v[j] = (k < 64) ? (cr * ar - ci * ai) : -(cr * ai + ci * ar); } }
        v4u w; w.x = pk2(v[0], v[1]); w.y = pk2(v[2], v[3]); w.z = pk2(v[4], v[5]); w.w = pk2(v[6], v[7]); *(GAS v4u*)(Mg + (size_t)n * UAW + k0) = w; }
    bf16* Wg = (bf16*)(ws_ + WS_BIGW + BW_WST) + (size_t)g * 256 * NYC;
    for (int i = tid; i < 32 * (NYC / 8); i += 512) { const int n = part * 32 + i / (NYC / 8), k0 = (i % (NYC / 8)) * 8, s = k0 >> 4, h2 = k0 & 15; float v[8];
        if (n < 128) { const int p = n & 63; const float ar = apr[p * TP1 + TCH - 1 - s], ai = api[p * TP1 + TCH - 1 - s];
#pragma unroll
            for (int j = 0; j < 8; ++j) { const float br = bbr[p * 16 + h2 + j], bi = bbi[p * 16 + h2 + j]; v[j] = (n < 64) ? (ar * br - ai * bi) : (ar * bi + ai * br); } }
        else {
#pragma unroll
            for (int j = 0; j < 8; ++j) v[j] = 0.f; }
        v4u w; w.x = pk2(v[0], v[1]); w.y = pk2(v[2], v[3]); w.z = pk2(v[4], v[5]); w.w = pk2(v[6], v[7]); *(GAS v4u*)(Wg + (size_t)n * NYC + k0) = w; }
    __syncthreads();
}
template <bool FINAL> __device__ __forceinline__ void ph_moe_reduce(const int* slot_tok, const int* ntp, const bf16* PART, bf16* HB, float* out, int gw, int NGW, int lane) { asm volatile("" : "+v"(lane));
    const int T = *ntp, Tm = T & ~63, nrow = (T - Tm) * 256;
    for (int r = gw; r < nrow; r += NGW) { const int tok = ((const GAS int*)slot_tok)[Tm * 256 + r]; if (tok < 0) continue;
#pragma unroll
        for (int hf = 0; hf < 2; ++hf) { const v4u h = *((const GAS v4u*)(HB + (size_t)tok * DM) + hf * 64 + lane);
            float v[8] = {bflo(h.x), bfhi(h.x), bflo(h.y), bfhi(h.y), bflo(h.z), bfhi(h.z), bflo(h.w), bfhi(h.w)};
#pragma unroll
            for (int kp = 0; kp < KSPLIT; ++kp) { const v4u p = *((const GAS v4u*)(PART + ((size_t)kp * MOE_LEFT_ROWS + r) * DM) + hf * 64 + lane);
                v[0] += bflo(p.x); v[1] += bfhi(p.x); v[2] += bflo(p.y); v[3] += bfhi(p.y); v[4] += bflo(p.z); v[5] += bfhi(p.z); v[6] += bflo(p.w); v[7] += bfhi(p.w); }
            if constexpr (FINAL) { GAS f32x4* o = (GAS f32x4*)(out + (size_t)tok * DM) + hf * 128 + 2 * lane; o[0] = (f32x4){v[0], v[1], v[2], v[3]}; o[1] = (f32x4){v[4], v[5], v[6], v[7]}; }
            else { v4u w; w.x = pk2(v[0], v[1]); w.y = pk2(v[2], v[3]); w.z = pk2(v[4], v[5]); w.w = pk2(v[6], v[7]); *((GAS v4u*)(HB + (size_t)tok * DM) + hf * 64 + lane) = w; } } }
}

namespace att {
typedef float f32x16 __attribute__((ext_vector_type(16)));
typedef short s16x4 __attribute__((ext_vector_type(4)));
constexpr int SLOTK = 12288, SLOTV = 8192, LDS_K = 0, LDS_V = 2 * SLOTK, LDS_WS = LDS_V + 2 * SLOTV, LDS_OST = LDS_WS + 8 * 256, LDS_BYTES = LDS_OST + 8 * 4096;
__device__ __forceinline__ int crow(int r, int hi) { return (r & 3) + 8 * (r >> 2) + 4 * hi; }
__device__ __forceinline__ void glds16(const void* gsrc, unsigned lds_dst) { unsigned keep;
    asm volatile("s_mov_b32 %0, m0\n\ts_mov_b32 m0, %2\n\ts_nop 0\n\tglobal_load_lds_dwordx4 %1, off\n\ts_mov_b32 m0, %0" : "=&s"(keep) : "v"(gsrc), "s"(lds_dst) : "memory"); }
#define ATT_WAIT_BAR() asm volatile("s_waitcnt vmcnt(0) lgkmcnt(0)\n\ts_barrier" ::: "memory")
#define ATT_SBAR() __builtin_amdgcn_sched_barrier(0)
__device__ __forceinline__ float max3f(float a, float b, float c) { return __builtin_fmaxf(__builtin_fmaxf(a, b), c); }
__device__ __forceinline__ float rowmax32(const f32x16& p0, const f32x16& p1) {
    float a = max3f(p0[0], p0[1], p1[0]), b = max3f(p0[2], p0[3], p1[1]); a = max3f(a, p1[2], p1[3]);
#pragma unroll
    for (int r = 4; r < 16; r += 4) { a = max3f(a, p0[r], p0[r + 1]); b = max3f(b, p0[r + 2], p0[r + 3]); a = max3f(a, p1[r], p1[r + 1]); b = max3f(b, p1[r + 2], p1[r + 3]); }
    const float m = fmaxf(a, b);
    auto rr = __builtin_amdgcn_permlane32_swap(__float_as_uint(m), __float_as_uint(m), false, false);
    return fmaxf(__uint_as_float(rr[0]), __uint_as_float(rr[1]));
}
__device__ __forceinline__ void pv(f32x16* o, int vb, bf16x8 pa0, bf16x8 pa1, bf16x8 pa2, bf16x8 pa3) {
#pragma unroll
    for (int d0 = 0; d0 < 2; ++d0) { s16x4 lo[4], hi[4];
#pragma unroll
        for (int ks = 0; ks < 4; ++ks) {
            asm volatile("ds_read_b64_tr_b16 %0,%1 offset:%c2" : "=&v"(lo[ks]) : "v"(vb), "i"(d0 * 4096 + ks * 1024) : "memory");
            asm volatile("ds_read_b64_tr_b16 %0,%1 offset:%c2" : "=&v"(hi[ks]) : "v"(vb), "i"(d0 * 4096 + ks * 1024 + 512) : "memory"); }
        asm volatile("s_waitcnt lgkmcnt(0)" ::: "memory"); ATT_SBAR();
#define ATT_PK(k) (bf16x8){lo[k][0], lo[k][1], lo[k][2], lo[k][3], hi[k][0], hi[k][1], hi[k][2], hi[k][3]}
        o[d0] = __builtin_amdgcn_mfma_f32_32x32x16_bf16(pa0, ATT_PK(0), o[d0], 0, 0, 0);
        o[d0] = __builtin_amdgcn_mfma_f32_32x32x16_bf16(pa1, ATT_PK(1), o[d0], 0, 0, 0);
        o[d0] = __builtin_amdgcn_mfma_f32_32x32x16_bf16(pa2, ATT_PK(2), o[d0], 0, 0, 0);
        o[d0] = __builtin_amdgcn_mfma_f32_32x32x16_bf16(pa3, ATT_PK(3), o[d0], 0, 0, 0);
#undef ATT_PK
    }
}
__device__ __forceinline__ void attn_unit(int b, int h, int qb, const bf16* QN, const bf16* KN, const bf16* KVR, bf16* MIX, float* SS, const float* qg, LAS unsigned char* shm) {
    int tid = threadIdx.x; asm volatile("" : "+v"(tid));
    const int lane = tid & 63, r32 = lane & 31, hi = lane >> 5, wid = __builtin_amdgcn_readfirstlane(tid >> 6);
    const long rowbase = (long)b * SEQ; const int q0 = qb * 256;
    const unsigned lds0 = (unsigned)(uintptr_t)shm;
    LAS float* wsf = (LAS float*)(shm + LDS_WS) + wid * 64;
    const bf16* ksrc0 = KN + (rowbase + lane) * 768 + h * 96 + wid * 8;
    const bf16* ksrc1 = ksrc0 + 64;
    const bf16* vsrc = KVR + (rowbase + 16 * (wid & 3) + (lane >> 2)) * 1024 + h * 128 + 64 + (wid >> 2) * 32 + (lane & 3) * 8;
    const unsigned kdst0 = lds0 + LDS_K + wid * 1024, kdst1 = lds0 + LDS_K + (8 + wid) * 1024, vdst = lds0 + LDS_V + wid * 1024;
#define ATT_DMA(t, s) do { glds16(ksrc0 + (long)(t) * 64 * 768, (unsigned)__builtin_amdgcn_readfirstlane(kdst0 + (s) * SLOTK)); \
        if (wid < 4) glds16(ksrc1 + (long)(t) * 64 * 768, (unsigned)__builtin_amdgcn_readfirstlane(kdst1 + (s) * SLOTK)); \
        glds16(vsrc + (long)(t) * 64 * 1024, (unsigned)__builtin_amdgcn_readfirstlane(vdst + (s) * SLOTV)); } while (0)
    const int vb0 = (int)(lds0 + LDS_V) + ((lane >> 4) & 1) * 32 + (lane & 3) * 8 + (4 * hi + ((lane & 15) >> 2)) * 64;
    const int NT = 4 * qb + 4, jmax = 4 * qb + (wid >> 1);
    ATT_DMA(0, 0);
    bf16x8 qr[6];
    {
      const bf16* Qw = QN + (rowbase + q0 + wid * 32 + r32) * 768 + h * 96 + hi * 8; v4u qw[6];
#pragma unroll
      for (int d0 = 0; d0 < 6; ++d0) qw[d0] = *(const GAS v4u*)(Qw + d0 * 16);
      f32x4 gA[6], gB[6];
#pragma unroll
      for (int d0 = 0; d0 < 6; ++d0) { gA[d0] = *(const GAS f32x4*)(qg + d0 * 16 + hi * 8); gB[d0] = *(const GAS f32x4*)(qg + d0 * 16 + hi * 8 + 4); }
      float qf[6][8]; float ss = 0.f;
#pragma unroll
      for (int d0 = 0; d0 < 6; ++d0) { qf[d0][0] = bflo(qw[d0].x); qf[d0][1] = bfhi(qw[d0].x); qf[d0][2] = bflo(qw[d0].y); qf[d0][3] = bfhi(qw[d0].y); qf[d0][4] = bflo(qw[d0].z); qf[d0][5] = bfhi(qw[d0].z); qf[d0][6] = bflo(qw[d0].w); qf[d0][7] = bfhi(qw[d0].w);
#pragma unroll
          for (int j = 0; j < 8; ++j) ss += qf[d0][j] * qf[d0][j]; }
      { auto rr = __builtin_amdgcn_permlane32_swap(__float_as_uint(ss), __float_as_uint(ss), false, false); ss = __uint_as_float(rr[0]) + __uint_as_float(rr[1]); }
      const float rq = QSCALE / sqrtf(ss * (1.f / 96) + EPS);
#pragma unroll
      for (int d0 = 0; d0 < 6; ++d0)
#pragma unroll
          for (int j = 0; j < 8; ++j) qf[d0][j] *= rq * (j < 4 ? gA[d0][j] : gB[d0][j - 4]);
      const float posf = (float)(q0 + wid * 32 + r32);
#pragma unroll
      for (int j = 0; j < 8; ++j) { const float ir = exp2f(-(float)(hi * 8 + j) * (13.287712379549449f / 16.f)) * 0.15915494309189535f;
          const float a = __builtin_amdgcn_fractf(posf * ir), sn = __builtin_amdgcn_sinf(a), cs = __builtin_amdgcn_cosf(a);
          const float x1 = qf[4][j], x2 = qf[5][j]; qf[4][j] = x1 * cs - x2 * sn; qf[5][j] = x1 * sn + x2 * cs; }
#pragma unroll
      for (int d0 = 0; d0 < 6; ++d0) { v4u w; w.x = pk2(qf[d0][0], qf[d0][1]); w.y = pk2(qf[d0][2], qf[d0][3]); w.z = pk2(qf[d0][4], qf[d0][5]); w.w = pk2(qf[d0][6], qf[d0][7]); qr[d0] = __builtin_bit_cast(bf16x8, w); } }
    float mhat = 0.f, l_reg = 0.f; f32x16 o[2]; f32x16 negm;
#pragma unroll
    for (int r = 0; r < 16; ++r) { o[0][r] = 0.f; o[1][r] = 0.f; negm[r] = 0.f; }
    constexpr float THRL = 8.f;
    for (int j = 0; j < NT; ++j) {
        ATT_WAIT_BAR();
        const int s = j & 1;
        if (j + 1 < NT) ATT_DMA(j + 1, s ^ 1);
        if (j <= jmax) {
            const LAS unsigned char* kb = shm + LDS_K + s * SLOTK + hi * 1024 + r32 * 16;
            f32x16 p0 = negm, p1 = negm;
#pragma unroll
            for (int d0 = 0; d0 < 6; ++d0) { const bf16x8 k0 = *(const LAS bf16x8*)(kb + d0 * 2048), k1 = *(const LAS bf16x8*)(kb + d0 * 2048 + 512);
                p0 = __builtin_amdgcn_mfma_f32_32x32x16_bf16(k0, qr[d0], p0, 0, 0, 0); p1 = __builtin_amdgcn_mfma_f32_32x32x16_bf16(k1, qr[d0], p1, 0, 0, 0); }
            const float rm = rowmax32(p0, p1);
            if (__any(rm > THRL) || j == 0) {
                const float dl = (j == 0) ? rm : fmaxf(rm, 0.f); mhat += dl;
#pragma unroll
                for (int r = 0; r < 16; ++r) { p0[r] -= dl; p1[r] -= dl; negm[r] = -mhat; }
                const float f = __builtin_amdgcn_exp2f(-dl); l_reg *= f;
                if (hi == 0) wsf[r32] = f;
                asm volatile("s_waitcnt lgkmcnt(0)" ::: "memory");
#pragma unroll
                for (int r = 0; r < 16; ++r) { const float g = wsf[crow(r, hi)]; o[0][r] *= g; o[1][r] *= g; }
            }
            float sacc = 0.f;
#pragma unroll
            for (int r = 0; r < 16; ++r) { p0[r] = __builtin_amdgcn_exp2f(p0[r]); p1[r] = __builtin_amdgcn_exp2f(p1[r]); sacc += p0[r] + p1[r]; }
            l_reg += sacc;
            v4u pw0, pw1, pw2, pw3;
            pw0 = (v4u){pk2(p0[0], p0[1]), pk2(p0[2], p0[3]), pk2(p0[4], p0[5]), pk2(p0[6], p0[7])}; pw1 = (v4u){pk2(p0[8], p0[9]), pk2(p0[10], p0[11]), pk2(p0[12], p0[13]), pk2(p0[14], p0[15])};
            pw2 = (v4u){pk2(p1[0], p1[1]), pk2(p1[2], p1[3]), pk2(p1[4], p1[5]), pk2(p1[6], p1[7])}; pw3 = (v4u){pk2(p1[8], p1[9]), pk2(p1[10], p1[11]), pk2(p1[12], p1[13]), pk2(p1[14], p1[15])};
            ATT_SBAR();
            pv(o, vb0 + s * SLOTV, __builtin_bit_cast(bf16x8, pw0), __builtin_bit_cast(bf16x8, pw1), __builtin_bit_cast(bf16x8, pw2), __builtin_bit_cast(bf16x8, pw3));
        }
    }
    { auto rr = __builtin_amdgcn_permlane32_swap(__float_as_uint(l_reg), __float_as_uint(l_reg), false, false); l_reg = __uint_as_float(rr[0]) + __uint_as_float(rr[1]); }
    if (hi == 0) wsf[32 + r32] = l_reg;
    asm volatile("s_waitcnt lgkmcnt(0)" ::: "memory");
    float rli[16];
#pragma unroll
    for (int r = 0; r < 16; ++r) rli[r] = __builtin_amdgcn_rcpf(wsf[32 + crow(r, hi)]);
    bf16* Ow = MIX + (rowbase + q0 + wid * 32) * 1024 + 512 + h * 64;
    { LAS bf16* stg = (LAS bf16*)(shm + LDS_OST) + wid * 2048;
#pragma unroll
      for (int r = 0; r < 16; ++r) { const int orow = crow(r, hi);
#pragma unroll
          for (int d0 = 0; d0 < 2; ++d0) stg[orow * 64 + d0 * 32 + r32] = f2bf(o[d0][r] * rli[r]); }
      asm volatile("s_waitcnt lgkmcnt(0)" ::: "memory");
#pragma unroll
      for (int i = 0; i < 4; ++i) { const int row = i * 8 + (lane >> 3), ch = lane & 7; const v4u v = *(const LAS v4u*)(stg + row * 64 + ch * 8); *(v4u*)(Ow + (long)row * 1024 + ch * 8) = v;
          float ss = (bflo(v.x) * bflo(v.x) + bfhi(v.x) * bfhi(v.x)) + (bflo(v.y) * bflo(v.y) + bfhi(v.y) * bfhi(v.y)) + (bflo(v.z) * bflo(v.z) + bfhi(v.z) * bfhi(v.z)) + (bflo(v.w) * bflo(v.w) + bfhi(v.w) * bfhi(v.w));
          ss += __shfl_xor(ss, 1); ss += __shfl_xor(ss, 2); ss += __shfl_xor(ss, 4);
          if (ch == 0) ((GAS float*)SS)[(rowbase + q0 + wid * 32 + row) * 16 + 8 + h] = ss; } }
    ATT_WAIT_BAR();
#undef ATT_DMA
}
__device__ __forceinline__ void attn_phase(const bf16* QN, const bf16* KN, const bf16* KVR, bf16* MIX, float* SS, const float* qg, LAS unsigned char* lds, int vcu, int G) {
#pragma unroll 1
    for (int v = vcu; v < 256; v += G) {
        const int bh = v >> 2, s = v & 3;
#pragma unroll 1
        for (int i = 0; i < 4; ++i) { const int qb = (i == 0) ? s : (i == 1) ? 7 - s : (i == 2) ? 8 + s : 15 - s; attn_unit(bh >> 3, bh & 7, qb, QN, KN, KVR, MIX, SS, qg, lds); } }
}
}
#define XB_TMO      128
#define XB_XCNT(j)  (256  + 64 * (j))
#define XB_XSUB(j)  (1280 + 64 * (j))
#define XB_XGEN(j)  (2304 + 64 * (j))
#define XB_TOP      3328
#define XB_TOPGEN   3392
#define XCD_BAR_WORDS 3456
#define XB_SPIN_CAP (1u << 18)
__device__ __forceinline__ unsigned xb_ld(unsigned* p)              { return __hip_atomic_load(p, __ATOMIC_RELAXED, __HIP_MEMORY_SCOPE_AGENT); }
__device__ __forceinline__ unsigned xb_add(unsigned* p, unsigned v) { return __hip_atomic_fetch_add(p, v, __ATOMIC_RELAXED, __HIP_MEMORY_SCOPE_AGENT); }
__device__ __forceinline__ unsigned xb_xcc_id() { return (unsigned)__builtin_amdgcn_s_getreg((3 << 11) | 20) & 0xFu; }
#define XB_SPIN(cond, bar) do { unsigned _sp = 0; while (cond) { __builtin_amdgcn_s_sleep(1); \
    if ((++_sp & 255u) == 0u) { if (xb_ld(&(bar)[XB_TMO])) break; if (_sp > XB_SPIN_CAP) { atomicAdd(&(bar)[XB_TMO], 1u); break; } } } } while (0)
struct XcdBarrier { unsigned* bar; unsigned x; volatile LAS unsigned* st; };
__device__ __forceinline__ XcdBarrier xcd_barrier_post(unsigned* bar, volatile LAS unsigned* st) {
    XcdBarrier b; b.bar = bar; b.x = xb_xcc_id(); b.st = st;
    if (threadIdx.x == 0) (void)xb_add(&bar[XB_XCNT(b.x)], 1u);
    return b;
}
__device__ __forceinline__ void xcd_barrier_complete(unsigned* bar, unsigned x, unsigned& nloc, unsigned& nx) {
    const unsigned G = gridDim.x * gridDim.y * gridDim.z;
    unsigned sum, cnt, mine, sp = 0u;
    for (;;) {
        sum = 0u; cnt = 0u; mine = 0u;
#pragma unroll
        for (unsigned j = 0; j < 16; ++j) { const unsigned c = xb_ld(&bar[XB_XCNT(j)]); sum += c; cnt += (c > 0u) ? 1u : 0u; mine = (j == x) ? c : mine; }
        if (sum == G) break;
        __builtin_amdgcn_s_sleep(1);
        if ((++sp & 255u) == 0u) { if (xb_ld(&bar[XB_TMO])) break; if (sp > XB_SPIN_CAP) { atomicAdd(&bar[XB_TMO], 1u); break; } }
    }
    nloc = mine > 0u ? mine : 1u; nx = cnt > 0u ? cnt : 1u;
}
__device__ __forceinline__ void xcd_barrier(const XcdBarrier& b) {
    asm volatile("s_waitcnt vmcnt(0)" ::: "memory");
    __syncthreads();
    if (threadIdx.x == 0) {
        unsigned* bar = b.bar; asm volatile("" : "+s"(bar));
        __builtin_amdgcn_s_waitcnt(0);
        unsigned nloc = b.st[0], nx = b.st[1];
        if (nloc == 0u) { xcd_barrier_complete(bar, b.x, nloc, nx); b.st[0] = nloc; b.st[1] = nx; }
        const unsigned old = xb_add(&bar[XB_XSUB(b.x)], 1u);
        const unsigned gen = old / nloc;
        if (old + 1u == (gen + 1u) * nloc) {
            __builtin_amdgcn_fence(__ATOMIC_RELEASE, "agent");
            asm volatile("s_waitcnt vmcnt(0)" ::: "memory");
            const unsigned og = xb_add(&bar[XB_TOP], 1u);
            const unsigned tg = og / nx;
            if (og + 1u == (tg + 1u) * nx) xb_add(&bar[XB_TOPGEN], 1u);
            else XB_SPIN(xb_ld(&bar[XB_TOPGEN]) == tg, bar);
            __builtin_amdgcn_fence(__ATOMIC_ACQUIRE, "agent");
            xb_add(&bar[XB_XGEN(b.x)], 1u);
            asm volatile("s_waitcnt vmcnt(0)" ::: "memory");
        } else {
            XB_SPIN(xb_ld(&bar[XB_XGEN(b.x)]) == gen, bar);
            __builtin_amdgcn_fence(__ATOMIC_ACQUIRE, "agent");
            asm volatile("s_waitcnt vmcnt(0)" ::: "memory");
        }
    }
    __syncthreads();
}

constexpr int RING_BYTES = 131072, MISC_OFF = RING_BYTES + 320, LDS_BYTES = 147456;
enum { PH_PREP = 0, PH_NORM1, PH_INPROJ, PH_SSMS, PH_SSMY, PH_GLU, PH_LATNORM, PH_QUP, PH_KVUP, PH_QKPREP, PH_ATTN, PH_OUTNORM, PH_OUTPROJ, PH_NORM2, PH_F0, PH_F1, PH_F2, PH_F3, PH_F4, PH_PER_LAYER = 32 };
struct Args { Params P; int ph_lo, ph_hi; unsigned skip_mask; int pad; };

struct LArgs { unsigned char* ws; float* outp; int G, bx, vcu, pad; };
#ifndef REPMASK0
#define REPMASK0 0x0
#define REPMASK1 0x0
#endif
#define REPS(k) (((((unsigned)(layer == 0 ? REPMASK0 : REPMASK1)) >> (k)) & 1u) ? 2 : 1)
#define RUN(k, ...) do { { const float rep_scale = 1.f; (void)rep_scale; __VA_ARGS__; } if constexpr (REPS(k) > 1) { const float rep_scale = 0.f; (void)rep_scale; __syncthreads(); __VA_ARGS__; } } while (0)
#define BAR() xcd_barrier(bar)
template <int layer> __device__ __forceinline__ void run_layer(const LArgs a, const XcdBarrier bar, LAS unsigned char* lds) {
    unsigned char* const ws = a.ws; float* const outp = a.outp; const int G = a.G, bx = a.bx, vcu = a.vcu;
    const int tid = threadIdx.x, lane = tid & 63, wave = __builtin_amdgcn_readfirstlane(tid >> 6);
    const int gw = vcu * 8 + wave, NGW = G * 8, gtid = bx * 512 + tid, gthreads = G * 512;
    bf16* HB = (bf16*)(ws + WS_HB); bf16* Z = (bf16*)outp; bf16* LAT = (bf16*)outp; bf16* KN = (bf16*)outp; bf16* MIX = (bf16*)(ws + WS_MIX); bf16* PL = (bf16*)(ws + WS_PL);
    bf16* UA = (bf16*)(ws + WS_UAUG); bf16* YG = (bf16*)(ws + WS_YG); bf16* KVR = (bf16*)(ws + WS_KVRAW); bf16* QR = (bf16*)(ws + WS_QRAW);
    bf16* ACTD = (bf16*)(ws + WS_ACTD); bf16* ACTM = (bf16*)(ws + WS_ACTM);
    LAS float* scr = (LAS float*)(lds + wave * 16384);
    unsigned char* wsm = ws + WS_WSMALL + (size_t)layer * WSM_STRIDE;
    RUN(0, { for (int j = bx; j < 256; j += G) ph_ssm_prep(ws, layer, j & 31, j >> 5, lds, tid);
             conv_small(ws, layer, scr, gw, NGW, lane, gtid, gthreads);
             if constexpr (layer == 0) conv_dense(ws, scr, gw, NGW, lane);
             if constexpr (layer == 0) ph_x2hb(kin(I_X), HB, (float*)(ws + WS_SS3), gw, NGW, lane); });
    BAR();
    RUN(1, { DenseSched S{(const char*)HB, (const char*)(wsm + WSM_IN), DM * 2, DM * 2, M / 256, 4, DM / 64, G, bx}; EpiInProjRs E{UA, PL, (const float*)(ws + WS_SS3), lds}; pg8::gemm_phase(lds, S, E); });
    BAR();
    RUN(2, { { SsmSSched S{(const char*)UA, (const char*)(ws + WS_BIGW + BW_WST), UAW * 2, NYC * 2, G, bx}; EpiSsmS E{UA, (const float*)(ws + WS_APOW)}; pg8::gemm_phase<EpiSsmS, SsmSSched, false, true>(lds, S, E); }
             ph_latnorm(PL, kin(I_Q_NORM) + layer * QRANK, kin(I_KV_NORM) + layer * KVRANK, LAT, gw, NGW, lane); });
    BAR();
    RUN(3, { { SsmYSched S{(const char*)UA, (const char*)(ws + WS_BIGW + BW_MAUG), UAW * 2, UAW * 2, G, bx}; EpiSsmY E{YG}; pg8::gemm_phase(lds, S, E); }
             { DenseSched S{(const char*)LAT, (const char*)(wsm + WSM_Q), 512 * 2, QRANK * 2, M / 256, 3, 4, G, bx}; EpiBf16 E{QR, 768}; pg8::gemm_phase(lds, S, E); }
             { DenseSched S{(const char*)(LAT + 256), (const char*)(wsm + WSM_KV), 512 * 2, 256 * 2, M / 256, 4, 4, G, bx}; EpiBf16 E{KVR, 1024}; pg8::gemm_phase(lds, S, E); } });
    BAR();
    RUN(4, { { DenseSched S{(const char*)YG, (const char*)(wsm + WSM_GLU), DSSM * 2, DSSM * 2, M / 256, 2, DSSM / 64, G, bx}; EpiGlu E{YG, kin(I_B_GLU) + layer * DSSM, MIX, (float*)(ws + WS_SS)}; pg8::gemm_phase(lds, S, E); }
             ph_qkprep(KVR, PL, KN, kin(I_K_GAIN) + layer * DQK, gw, NGW, lane); });
    BAR();
    RUN(5, att::attn_phase(QR, KN, KVR, MIX, (float*)(ws + WS_SS), kin(I_Q_GAIN) + layer * DQK, lds, vcu, G));
    BAR();
    RUN(7, { DenseSched S{(const char*)MIX, (const char*)(wsm + WSM_OUT), DM * 2, DM * 2, M / 256, 4, DM / 64, G, bx}; EpiOutProj E{HB, (const float*)(ws + WS_SS), rep_scale, lds, (float*)(ws + WS_SS2)}; pg8::gemm_phase(lds, S, E); });
    BAR();
    if constexpr (layer == 0) {
        RUN(9, { DenseSched S{(const char*)HB, (const char*)(ws + WS_BIGW + BW_DGU), DM * 2, DM * 2, M / 256, 22, DM / 64, G, bx}; EpiSwigluRs E{ACTD, FFD, (const float*)(ws + WS_SS2), lds}; pg8::gemm_phase(lds, S, E); });
        BAR();
        RUN(10, { DenseSched S{(const char*)ACTD, (const char*)(ws + WS_BIGW + BW_DD), FFD * 2, FFD * 2, M / 256, 4, FFD / 64, G, bx}; EpiResid E{HB, rep_scale, (float*)(ws + WS_SS3)}; pg8::gemm_phase(lds, S, E); });
        BAR();
    } else {
        unsigned char* rt = ws + WS_ROUTE;
        RUN(8, { ph_norm_route(HB, kin(I_FFN_NORM) + layer * DM, kin(I_MW_ROUTER), Z, (v4u*)rt, gw, NGW, lane); });
        BAR();
        RUN(9, { if (bx == G - 1) { ph_route_sort((const v4u*)rt, rt, lds, tid); __syncthreads(); } conv_moe(ws, scr, gw, NGW, lane); });
        BAR();
        bf16* PART0 = (bf16*)((unsigned char*)outp + 64 * MiB); bf16* PART1 = (bf16*)(ws + WS_BIGW);
#pragma unroll 1
        for (int k = 0; k < 2; ++k) {
            const int* tile_e = (const int*)(rt + RT_TILE_E) + k * MOE_TILES; const int* slot_tok = (const int*)(rt + RT_SLOT_TOK) + k * MOE_SLOTS; const float* slot_w = (const float*)(rt + RT_SLOT_W) + k * MOE_SLOTS; const int* ntl = (const int*)(rt + RT_NTILES) + k;
            if (k == 1) ph_moe_reduce<false>((const int*)(rt + RT_SLOT_TOK), (const int*)(rt + RT_NTILES), PART0, HB, outp, gw, NGW, lane);
            RUN(10, { MoeSched S{(const char*)Z, (const char*)(ws + WS_BIGW + BW_MGU), DM * 2, DM * 2, (size_t)2 * FFE * DM * 2, 28, DM / 64, G, bx, tile_e, slot_tok, ntl}; EpiSwiglu E{ACTM, FFE}; pg8::gemm_phase(lds, S, E); });
            BAR();
            if (k == 0) RUN(11, { MoeDownSched S{(const char*)ACTM, (const char*)(ws + WS_BIGW + BW_MD), FFE * 2, FFE * 2, (size_t)DM * FFE * 2, G, bx, tile_e, ntl}; EpiMoeDown<false> E{slot_tok, slot_w, HB, outp, rep_scale, ntl, PART0}; pg8::gemm_phase(lds, S, E); });
            else RUN(12, { MoeDownSched S{(const char*)ACTM, (const char*)(ws + WS_BIGW + BW_MD), FFE * 2, FFE * 2, (size_t)DM * FFE * 2, G, bx, tile_e, ntl}; EpiMoeDown<true> E{slot_tok, slot_w, HB, outp, 1.f, ntl, PART1}; pg8::gemm_phase(lds, S, E); });
            BAR();
            if (k == 1) ph_moe_reduce<true>(slot_tok, ntl, PART1, HB, outp, gw, NGW, lane);
        }
    }
}
__global__ void __launch_bounds__(512, 2) fwd(Args args) {
    extern __shared__ __attribute__((aligned(16))) unsigned char lds_raw[];
    LAS unsigned char* lds = (LAS unsigned char*)lds_raw;
    unsigned char* const ws = args.P.ws; float* const outp = args.P.out;
    const int tid = threadIdx.x, lane = tid & 63, wave = __builtin_amdgcn_readfirstlane(tid >> 6);
    const int G = gridDim.x, bx = blockIdx.x; const int vcu = (G % 8 == 0) ? (bx % 8) * (G / 8) + bx / 8 : bx;
    const int gw = vcu * 8 + wave, NGW = G * 8, gtid = bx * 512 + tid, gthreads = G * 512;
    volatile LAS unsigned* MISC = (volatile LAS unsigned*)(lds + MISC_OFF);
    for (int u = tid; u < (LDS_BYTES - RING_BYTES) / 4; u += 512) ((LAS unsigned*)(lds + RING_BYTES))[u] = 0u;
    __syncthreads();
    unsigned* ctl = (unsigned*)(ws + WS_CTL);
    XcdBarrier bar = xcd_barrier_post(ctl + CW_BAR, MISC + 8);

    LArgs la; la.ws = ws; la.outp = outp; la.G = G; la.bx = bx; la.vcu = vcu; la.pad = 0;
    run_layer<0>(la, bar, lds);
    run_layer<1>(la, bar, lds);
}
static void launch_fwd(const Params& P, int lo, int hi, unsigned skip, int grid, hipStream_t st) {
    Args a{}; a.P = P; a.ph_lo = lo; a.ph_hi = hi; a.skip_mask = skip; a.pad = 0;
    hipLaunchKernelGGL(fwd, dim3(grid), dim3(512), LDS_BYTES, st, a);
}
extern "C" void kernel_launch(void* const* d_in, const int* in_sizes, int n_in, void* d_out, int out_size, void* d_ws, size_t ws_size, hipStream_t stream) {
    static int grid = 0;
    if (grid == 0) {
        if (n_in != 30 || out_size != M * DM || ws_size < WS_END) { fprintf(stderr, "kernel_launch: unexpected shapes: n_in %d out %d ws %zu (need %zu)\n", n_in, out_size, ws_size, (size_t)WS_END); grid = -1; return; }
        int dev = 0, cus = 0;
        if (hipGetDevice(&dev) != hipSuccess || hipDeviceGetAttribute(&cus, hipDeviceAttributeMultiprocessorCount, dev) != hipSuccess) { grid = -1; return; }
        if (hipFuncSetAttribute((const void*)fwd, hipFuncAttributeMaxDynamicSharedMemorySize, LDS_BYTES) != hipSuccess) { fprintf(stderr, "kernel_launch: hipFuncSetAttribute failed\n"); grid = -1; return; }
        (void)hipGetLastError();
        grid = cus;
    }
    if (grid < 0) return;
    Params P{};
    for (int i = 0; i < 30; ++i) P.in[i] = (const float*)d_in[i];
    P.out = (float*)d_out; P.ws = (unsigned char*)d_ws;
    unsigned char* ws = P.ws;
    (void)hipMemsetAsync(ws + WS_CTL, 0, CTL_ZERO_BYTES, stream);
    launch_fwd(P, 0, DEPTH * PH_PER_LAYER, 0, grid, stream);
}
```

```cpp
#include <hip/hip_runtime.h>
#include <cstdio>
#include <cstdint>

constexpr int NB = 8, SEQ = 4096, DM = 1024, M = NB * SEQ, DEPTH = 2;
#ifndef SSM_TCH
#define SSM_TCH 16
#endif
constexpr int DSSM = 512, NG = 32, GH = 16, NP = 64, TCH = SSM_TCH, NCH = SEQ / TCH;
constexpr int NROWG = NB * NCH, NYC = TCH * 16, SSM_RT = NROWG / 256, SSM_CT = NYC / 256, TP1 = TCH + 1;
constexpr int NHEAD = 8, DV = 64, DNOPE = 64, DROPE = 32, DQK = 96, QRANK = 256, KVRANK = 128;
constexpr int DIN = 928, FFD = 2816, NE = 8, FFE = 3584;
constexpr float EPS = 1e-6f;
constexpr int UAW = 128 + NYC;
constexpr int MOE_SLOTS = 34816;
constexpr int MOE_TILES = MOE_SLOTS / 256;

constexpr size_t MiB = 1u << 20;
constexpr size_t WS_CTL = 0, CTL_ZERO_BYTES = 64 * 1024;
constexpr size_t WS_WSMALL = 1 * MiB;
constexpr size_t WSM_IN = 0, WSM_GLU = 2 * MiB, WSM_Q = 2 * MiB + 512 * 1024, WSM_KV = 3 * MiB, WSM_OUT = 3 * MiB + 512 * 1024, WSM_STRIDE = 6 * MiB;
constexpr size_t WS_APOW = 13 * MiB;
constexpr size_t WS_ROUTE = 14 * MiB;
constexpr size_t RT_SLOT_TOK = 512 * 1024, RT_SLOT_W = RT_SLOT_TOK + 2 * MOE_SLOTS * 4, RT_TILE_E = RT_SLOT_W + 2 * MOE_SLOTS * 4, RT_NTILES = RT_TILE_E + 2 * MOE_TILES * 4;
constexpr size_t WS_SS = 16 * MiB;
constexpr size_t WS_SS2 = 126 * MiB, WS_SS3 = 124 * MiB;
constexpr size_t WS_BIGW = 19 * MiB;
constexpr size_t BW_MAUG = 0, BW_WST = 72 * MiB, BW_DGU = 88 * MiB, BW_DD = 99 * MiB;
constexpr size_t BW_MGU = 0, BW_MD = 112 * MiB;
constexpr size_t WS_HB = 195 * MiB;
constexpr size_t WS_MIX = 259 * MiB;
constexpr size_t WS_PL = 323 * MiB;
constexpr size_t WS_UAUG = 355 * MiB;
constexpr size_t WS_YG = WS_UAUG + (((size_t)32 * (8 * (4096 / SSM_TCH)) * (128 + SSM_TCH * 16) * 2 + MiB - 1) / MiB) * MiB;
constexpr size_t WS_KVRAW = 128 * MiB;
constexpr size_t WS_QRAW = WS_YG + 32 * MiB;
constexpr size_t WS_ACTD = 323 * MiB;
constexpr size_t WS_ACTM = 259 * MiB;
constexpr size_t WS_END = 511 * MiB;
static_assert(WS_ACTM + (size_t)MOE_SLOTS * FFE * 2 <= WS_END && WS_ACTD + (size_t)M * FFD * 2 <= WS_END && WS_QRAW + (size_t)M * 768 * 2 <= WS_END, "ws map");
static_assert(WS_BIGW + BW_MD + (size_t)NE * DM * FFE * 2 <= WS_HB && WS_UAUG + (size_t)NG * NROWG * UAW * 2 <= WS_YG, "ws map 2");
static_assert(RT_NTILES + 64 <= 5 * MiB, "route map");

constexpr int CW_BAR = 4096;

#define GAS __attribute__((address_space(1)))
#define LAS __attribute__((address_space(3)))
typedef unsigned short bf16;
typedef unsigned v4u __attribute__((ext_vector_type(4)));
typedef unsigned v2u __attribute__((ext_vector_type(2)));
typedef float f32x4 __attribute__((ext_vector_type(4)));
typedef float f32x2 __attribute__((ext_vector_type(2)));
typedef short bf16x8 __attribute__((ext_vector_type(8)));
typedef __bf16 bf16x2_t __attribute__((ext_vector_type(2)));
#define LDS_WAIT() asm volatile("s_waitcnt lgkmcnt(0)" ::: "memory")
#define VM_WAIT() asm volatile("s_waitcnt vmcnt(0)" ::: "memory")
__device__ __forceinline__ unsigned pk2(float lo, float hi) { f32x2 v = {lo, hi}; bf16x2_t b = __builtin_convertvector(v, bf16x2_t); return __builtin_bit_cast(unsigned, b); }
__device__ __forceinline__ bf16 f2bf(float f) { return (bf16)(pk2(f, 0.f) & 0xffffu); }
__device__ __forceinline__ float bf2f(bf16 b) { return __builtin_bit_cast(float, (unsigned)b << 16); }
__device__ __forceinline__ float bflo(unsigned w) { return __builtin_bit_cast(float, w << 16); }
__device__ __forceinline__ float bfhi(unsigned w) { return __builtin_bit_cast(float, w & 0xffff0000u); }
__device__ __forceinline__ float wave_sum(float v) {
#pragma unroll
    for (int o = 1; o < 64; o <<= 1) v += __shfl_xor(v, o);
    return v;
}
__device__ __forceinline__ float sigmoidf_(float x) { return __builtin_amdgcn_rcpf(1.f + __builtin_amdgcn_exp2f(-1.4426950408889634f * x)); }
__device__ __forceinline__ float gelu_tanh(float x) { const float u = 0.7978845608028654f * (x + 0.044715f * x * x * x); return x * sigmoidf_(2.f * u); }

struct Params { const float* in[30]; float* out; unsigned char* ws; };
__device__ __forceinline__ const float* kin(int i) { const float* const* ka = (const float* const*)__builtin_amdgcn_kernarg_segment_ptr(); asm volatile("" : "+s"(ka)); return ka[i]; }
enum { I_X = 0, I_ATTN_NORM, I_W_IN, I_A_RE, I_A_IM, I_LOG_STEP, I_B_RE, I_B_IM, I_C_RE, I_C_IM, I_D, I_W_GLU, I_B_GLU, I_Q_NORM, I_W_Q_UP, I_KV_NORM, I_W_KV_UP,
       I_Q_GAIN, I_K_GAIN, I_SSM_OUT_NORM, I_MLA_OUT_NORM, I_W_OUT, I_FFN_NORM, I_DW_GATE, I_DW_UP, I_DW_DOWN, I_MW_ROUTER, I_MW_GATE, I_MW_UP, I_MW_DOWN };

#ifndef NAIVE
#define NAIVE 0
#endif
#ifndef FAST_GEMM
#define FAST_GEMM 1
#endif
namespace pg8 {
constexpr int BM = 256, BK = 64, HALF = 128, HTB = HALF * BK * 2, STAGE_BYTES = 8 * HTB, NXCD = 8, WGM = 8;
constexpr int IDX_OFF = STAGE_BYTES + 1024;
__host__ __device__ __forceinline__ int lds_byte(int r, int c) { const int st = (r >> 4) * 2 + (c >> 5), rr = r & 15, cc = c & 31, ob = rr * 64 + cc * 2; return st * 1024 + (ob ^ (((ob >> 9) & 1) << 5)); }
__host__ __device__ __forceinline__ void stage_rc(int b, int& R, int& C) { const int st = b / 1024, sb = b % 1024, swz = sb ^ (((sb >> 9) & 1) << 5); R = (st >> 1) * 16 + swz / 64; C = (st & 1) * 32 + (swz % 64) / 2; }
__host__ __device__ __forceinline__ int perm32(int rho) { const int n = rho >> 4, i = rho & 15; return 8 * (i >> 2) + 4 * n + (i & 3); }

struct Unit { int pm, pn, aux, kp, seq; };
__device__ __forceinline__ void glds16_(const void* gsrc, unsigned lds_dst) { unsigned keep;
    asm volatile("s_mov_b32 %0, m0\n\ts_mov_b32 m0, %2\n\ts_nop 0\n\tglobal_load_lds_dwordx4 %1, off\n\ts_mov_b32 m0, %0" : "=&s"(keep) : "v"(gsrc), "s"(lds_dst) : "memory"); }

__device__ __forceinline__ bool static_unit(int i, int G, int c, int nM, int nN, Unit& u) {
    const int nwg = nM * nN; const long L = (long)i * G + c; if (L >= nwg) return false;
    int wgid = (int)L; { const int q = nwg / NXCD, r = nwg % NXCD, xcd = wgid % NXCD, off = wgid / NXCD; wgid = (xcd < r ? xcd * (q + 1) : r * (q + 1) + (xcd - r) * q) + off; }
    const int nig = WGM * nN, gid = wgid / nig, fm = gid * WGM, gsz = (nM - fm) < WGM ? (nM - fm) : WGM;
    u.pm = fm + ((wgid % nig) % gsz); u.pn = (wgid % nig) / gsz; u.aux = 0; u.kp = -1; return true;
}

template <class T, class = void> struct has_mid { static constexpr bool value = false; };
template <class T> struct has_mid<T, decltype((void)T::MID_T)> { static constexpr bool value = true; };
template <class T, class = void> struct has_begin { static constexpr bool value = false; };
template <class T> struct has_begin<T, decltype((void)T::BEGIN)> { static constexpr bool value = true; };
template <class T, class = void> struct has_pair { static constexpr bool value = false; };
template <class T> struct has_pair<T, decltype((void)T::PAIR)> { static constexpr bool value = true; };
template <class T, class = void> struct has_custom { static constexpr bool value = false; };
template <class T> struct has_custom<T, decltype((void)T::CUSTOM)> { static constexpr bool value = true; };
template <class Epi> __device__ __forceinline__ void epi_apply(const Epi& E, const f32x4 (&acc)[2][2][4][2], const Unit& u, int wr, int wc, int fr, int fq) {
    if constexpr (has_custom<Epi>::value) E.apply(acc, u, wr, wc, fr, fq);
    else {
#pragma unroll
    for (int ai = 0; ai < 2; ++ai)
#pragma unroll
        for (int m = 0; m < 4; ++m) { const int r = ai * HALF + wr * 64 + m * 16 + fr;
            if constexpr (has_pair<Epi>::value) E.putpair(u, r, wc * 32 + 8 * fq, acc[ai][0][m][0], acc[ai][0][m][1], acc[ai][1][m][0], acc[ai][1][m][1]);
            else {
#pragma unroll
            for (int bj = 0; bj < 2; ++bj) {
                if constexpr (Epi::PERM) E.put8(u, r, bj * HALF + wc * 32 + 8 * fq, acc[ai][bj][m][0], acc[ai][bj][m][1]);
                else { E.put4(u, r, bj * HALF + wc * 32 + 4 * fq, acc[ai][bj][m][0]); E.put4(u, r, bj * HALF + wc * 32 + 16 + 4 * fq, acc[ai][bj][m][1]); } } }
            asm volatile("" ::: "memory"); }
    }
}

template <class Epi, class Sched, bool ALIGN_EPI = true, bool SP2 = true>
__device__ __forceinline__ void gemm_phase(LAS unsigned char* lds, const Sched& S, const Epi& E) {
    int tid = threadIdx.x; asm volatile("" : "+v"(tid));
    const int wid = __builtin_amdgcn_readfirstlane(tid >> 6), lane = tid & 63, wr = wid >> 2, wc = wid & 3, fr = lane & 15, fq = lane >> 4;
    int RA[2], CA2[2]; unsigned voffB[2], voA0[2], voA1[2], nvA0[2], nvA1[2];
    const unsigned lda = S.lda, ldb = S.ldb;
#pragma unroll
    for (int i = 0; i < 2; ++i) { int R, C; stage_rc(tid * 16 + i * 8192, R, C); const int Rb = Epi::PERM ? ((R & ~31) + perm32(R & 31)) : R;
        RA[i] = R; CA2[i] = C * 2; voffB[i] = (unsigned)Rb * ldb + (unsigned)C * 2u; voA0[i] = (unsigned)R * lda + (unsigned)C * 2u; voA1[i] = (unsigned)(R + HALF) * lda + (unsigned)C * 2u; nvA0[i] = voA0[i]; nvA1[i] = voA1[i]; }
    const size_t kstep = (size_t)(BK * 2);
    const size_t hstepB = (size_t)HALF * ldb;
    const unsigned ldsw = (unsigned)wid * 1024u;
    const int aoff = lds_byte(wr * 64 + fr, fq * 8), boff = lds_byte(wc * 32 + fr, fq * 8);
#define PG8_SA(b, h) (((b) * 2 + (h)) * HTB)
#define PG8_SB(b, h) ((4 + (b) * 2 + (h)) * HTB)
#define PG8_STAGE(bufoff, gbase, voff) do { _Pragma("unroll") for (int _i = 0; _i < 2; ++_i) \
        __builtin_amdgcn_global_load_lds((const unsigned*)((const char*)(gbase) + (voff)[_i]), (LAS unsigned*)(lds + (bufoff) + ldsw + _i * 8192), 16, 0, 0); } while (0)
#define PG8_LDA(dst, b, h) do { _Pragma("unroll") for (int m = 0; m < 4; ++m) _Pragma("unroll") for (int k = 0; k < 2; ++k) dst[m][k] = *(const LAS bf16x8*)(lds + PG8_SA(b, h) + aoff + m * 2048 + k * 1024); } while (0)
#define PG8_LDB(dst, b, h) do { _Pragma("unroll") for (int n = 0; n < 2; ++n) _Pragma("unroll") for (int k = 0; k < 2; ++k) dst[n][k] = *(const LAS bf16x8*)(lds + PG8_SB(b, h) + boff + n * 2048 + k * 1024); } while (0)
#define PG8_MMA(ai, bj, At, Bt) do { __builtin_amdgcn_s_setprio(1); _Pragma("unroll") for (int m = 0; m < 4; ++m) _Pragma("unroll") for (int n = 0; n < 2; ++n) _Pragma("unroll") for (int k = 0; k < 2; ++k) \
        acc[ai][bj][m][n] = __builtin_amdgcn_mfma_f32_16x16x32_bf16(Bt[n][k], At[m][k], acc[ai][bj][m][n], 0, 0, 0); __builtin_amdgcn_s_setprio(0); } while (0)
#define PG8_WAIT_V(n) asm volatile("s_waitcnt vmcnt(" #n ")" ::: "memory")
#define PG8_WAIT_L(n) asm volatile("s_waitcnt lgkmcnt(" #n ")" ::: "memory")
#define PG8_BAR __builtin_amdgcn_s_barrier()
#define PG8_SCHED __builtin_amdgcn_sched_barrier(0)
    Unit cur, nxt; int ui = 0;
    if (!S.next(0, cur)) return;
    cur.seq = 0;
    if constexpr (Sched::GATHER) {
#pragma unroll
        for (int i = 0; i < 2; ++i) { voA0[i] = S.a_rowoff(cur, RA[i]) + (unsigned)CA2[i]; voA1[i] = S.a_rowoff(cur, RA[i] + HALF) + (unsigned)CA2[i]; }
    }
    f32x4 acc[2][2][4][2];
#pragma unroll
    for (int a = 0; a < 2; ++a)
#pragma unroll
        for (int b = 0; b < 2; ++b)
#pragma unroll
            for (int m = 0; m < 4; ++m)
#pragma unroll
                for (int n = 0; n < 2; ++n) acc[a][b][m][n] = (f32x4){0.f, 0.f, 0.f, 0.f};
    bf16x8 At[4][2], B0[2][2], B1[2][2];
    const char* cA = S.a_base(cur); const char* cB = S.b_base(cur);
    if constexpr (SP2) {
        PG8_STAGE(PG8_SB(0, 0), cB, voffB); PG8_STAGE(PG8_SB(0, 1), cB + hstepB, voffB); PG8_STAGE(PG8_SA(0, 0), cA, voA0); PG8_STAGE(PG8_SA(0, 1), cA, voA1);
        if (wr == 1) PG8_BAR;
        PG8_WAIT_V(2); PG8_BAR;
        PG8_STAGE(PG8_SB(1, 0), cB + kstep, voffB); PG8_STAGE(PG8_SA(1, 0), cA + kstep, voA0); PG8_STAGE(PG8_SB(1, 1), cB + hstepB + kstep, voffB);
        PG8_WAIT_V(6); PG8_BAR;
    } else {
        PG8_STAGE(PG8_SB(0, 0), cB, voffB); PG8_STAGE(PG8_SA(0, 0), cA, voA0); PG8_STAGE(PG8_SB(0, 1), cB + hstepB, voffB); PG8_STAGE(PG8_SA(0, 1), cA, voA1);
        if (wr == 1) PG8_BAR;
        PG8_WAIT_V(4); PG8_BAR;
        PG8_STAGE(PG8_SB(1, 0), cB + kstep, voffB); PG8_STAGE(PG8_SA(1, 0), cA + kstep, voA0); PG8_STAGE(PG8_SB(1, 1), cB + hstepB + kstep, voffB);
        PG8_WAIT_V(6); PG8_BAR;
    }
    for (;;) {
        const bool has_next = S.next(ui + 1, nxt);
        const char* nA = has_next ? S.a_base(nxt) : cA; const char* nB = has_next ? S.b_base(nxt) : cB;
        if constexpr (Sched::GATHER) { if (has_next) S.idx_dma(nxt, (unsigned)__builtin_amdgcn_readfirstlane((int)((unsigned)(uintptr_t)(lds + IDX_OFF) + (unsigned)wid * 1024u)), lane); }
        if constexpr (has_begin<Epi>::value) E.unit_begin(cur, lds, tid);
        const int nt = S.nt(cur);
        for (int t = 0; t < nt; t += 2) {
            const bool last = (t == nt - 2);
            if constexpr (has_mid<Epi>::value) { if (t == Epi::MID_T) E.mid(acc, cur, wr, fr, lds); }
            const char* a1 = cA + (size_t)(t + 1) * kstep;
            const char* a2 = last ? nA : cA + (size_t)(t + 2) * kstep; const char* b2 = last ? nB : cB + (size_t)(t + 2) * kstep;
            const char* a3 = a2 + kstep; const char* b3 = b2 + kstep;
            unsigned w0[2], w1[2];
            if constexpr (Sched::GATHER) {
                if (last) { const LAS int* ip = (const LAS int*)(lds + IDX_OFF + wid * 1024);
#pragma unroll
                    for (int i = 0; i < 2; ++i) { nvA0[i] = has_next ? S.rowoff_idx(ip[RA[i]]) + (unsigned)CA2[i] : voA0[i]; nvA1[i] = has_next ? S.rowoff_idx(ip[RA[i] + HALF]) + (unsigned)CA2[i] : voA1[i]; } }
#pragma unroll
                for (int i = 0; i < 2; ++i) { w0[i] = last ? nvA0[i] : voA0[i]; w1[i] = last ? nvA1[i] : voA1[i]; }
            } else {
#pragma unroll
                for (int i = 0; i < 2; ++i) { w0[i] = voA0[i]; w1[i] = voA1[i]; }
            }
            if constexpr (SP2) {
            PG8_LDB(B0, 0, 0); PG8_LDB(B1, 0, 1); PG8_SCHED; PG8_LDA(At, 0, 0); PG8_STAGE(PG8_SA(1, 1), a1, voA1);
            PG8_WAIT_V(8); PG8_WAIT_L(0); PG8_BAR; PG8_MMA(0, 0, At, B0); PG8_MMA(0, 1, At, B1); PG8_BAR; PG8_SCHED;
            PG8_LDA(At, 0, 1); PG8_STAGE(PG8_SB(0, 0), b2, voffB); PG8_STAGE(PG8_SB(0, 1), b2 + hstepB, voffB); PG8_STAGE(PG8_SA(0, 0), a2, w0);
            PG8_WAIT_V(8); PG8_WAIT_L(0); PG8_BAR; PG8_MMA(1, 0, At, B0); PG8_MMA(1, 1, At, B1); PG8_BAR; PG8_SCHED;
            PG8_LDB(B0, 1, 0); PG8_LDB(B1, 1, 1); PG8_SCHED; PG8_LDA(At, 1, 0); PG8_STAGE(PG8_SA(0, 1), a2, w1);
            PG8_WAIT_V(8); PG8_WAIT_L(0); PG8_BAR; PG8_MMA(0, 0, At, B0); PG8_MMA(0, 1, At, B1); PG8_BAR; PG8_SCHED;
            PG8_LDA(At, 1, 1); PG8_STAGE(PG8_SB(1, 0), b3, voffB); PG8_STAGE(PG8_SB(1, 1), b3 + hstepB, voffB); PG8_STAGE(PG8_SA(1, 0), a3, w0);
            PG8_WAIT_V(8); PG8_WAIT_L(0); PG8_BAR; PG8_MMA(1, 0, At, B0); PG8_MMA(1, 1, At, B1); PG8_BAR; PG8_SCHED;
            } else {
            PG8_LDB(B0, 0, 0); PG8_SCHED; PG8_LDA(At, 0, 0); PG8_STAGE(PG8_SA(1, 1), a1, voA1);
            PG8_WAIT_L(8); PG8_BAR; PG8_WAIT_L(0); PG8_MMA(0, 0, At, B0); PG8_BAR; PG8_SCHED;
            PG8_LDB(B1, 0, 1); PG8_STAGE(PG8_SB(0, 0), b2, voffB);
            PG8_BAR; PG8_WAIT_L(0); PG8_MMA(0, 1, At, B1); PG8_BAR;
            PG8_LDA(At, 0, 1); PG8_STAGE(PG8_SA(0, 0), a2, w0);
            PG8_BAR; PG8_WAIT_L(0); PG8_MMA(1, 0, At, B0); PG8_BAR; PG8_SCHED;
            PG8_STAGE(PG8_SB(0, 1), b2 + hstepB, voffB);
            PG8_WAIT_V(6); PG8_BAR; PG8_MMA(1, 1, At, B1); PG8_BAR;
            PG8_LDB(B0, 1, 0); PG8_SCHED; PG8_LDA(At, 1, 0); PG8_STAGE(PG8_SA(0, 1), a2, w1);
            PG8_WAIT_L(8); PG8_BAR; PG8_WAIT_L(0); PG8_MMA(0, 0, At, B0); PG8_BAR; PG8_SCHED;
            PG8_LDB(B1, 1, 1); PG8_STAGE(PG8_SB(1, 0), b3, voffB);
            PG8_BAR; PG8_WAIT_L(0); PG8_MMA(0, 1, At, B1); PG8_BAR;
            PG8_LDA(At, 1, 1); PG8_STAGE(PG8_SA(1, 0), a3, w0);
            PG8_BAR; PG8_WAIT_L(0); PG8_MMA(1, 0, At, B0); PG8_BAR; PG8_SCHED;
            PG8_STAGE(PG8_SB(1, 1), b3 + hstepB, voffB);
            PG8_WAIT_V(6); PG8_BAR; PG8_MMA(1, 1, At, B1); PG8_BAR;
            }
        }
        if constexpr (ALIGN_EPI) { if (wr == 0) PG8_BAR; }
        if constexpr (!Epi::AFTER_DRAIN) { int fr_ = fr, fq_ = fq; asm volatile("" : "+v"(fr_), "+v"(fq_));
            epi_apply(E, acc, cur, wr, wc, fr_, fq_); }
        if (!has_next) break;
#pragma unroll
        for (int a = 0; a < 2; ++a)
#pragma unroll
            for (int b = 0; b < 2; ++b)
#pragma unroll
                for (int m = 0; m < 4; ++m)
#pragma unroll
                    for (int n = 0; n < 2; ++n) acc[a][b][m][n] = (f32x4){0.f, 0.f, 0.f, 0.f};
        cur = nxt; cA = nA; cB = nB; ++ui; cur.seq = ui;
        if constexpr (Sched::GATHER) {
#pragma unroll
            for (int i = 0; i < 2; ++i) { voA0[i] = nvA0[i]; voA1[i] = nvA1[i]; }
        }
        if constexpr (ALIGN_EPI) { if (wr == 1) PG8_BAR; }
    }
    PG8_WAIT_V(0);
    if constexpr (!ALIGN_EPI) { if (wr == 0) PG8_BAR; }
    PG8_BAR;
    if constexpr (Epi::AFTER_DRAIN) { int fr_ = fr, fq_ = fq, lane_ = lane; asm volatile("" : "+v"(fr_), "+v"(fq_), "+v"(lane_)); E.fused(acc, cur, wr, wc, fr_, fq_, lds, wid, lane_); }
#undef PG8_SA
#undef PG8_SB
#undef PG8_STAGE
#undef PG8_LDA
#undef PG8_LDB
#undef PG8_MMA
#undef PG8_WAIT_V
#undef PG8_WAIT_L
#undef PG8_BAR
#undef PG8_SCHED
}
}
using pg8::Unit;

struct DenseSched {
    static constexpr bool GATHER = false;
    const char* A; const char* Bt; unsigned lda, ldb; int nM, nN, ntk, G, c;
    __device__ __forceinline__ bool next(int i, Unit& u) const { return pg8::static_unit(i, G, c, nM, nN, u); }
    __device__ __forceinline__ int nt(const Unit&) const { return ntk; }
    __device__ __forceinline__ const char* a_base(const Unit& u) const { return A + (size_t)u.pm * 256 * lda; }
    __device__ __forceinline__ const char* b_base(const Unit& u) const { return Bt + (size_t)u.pn * 256 * ldb; }
    __device__ __forceinline__ unsigned a_rowoff(const Unit&, int) const { return 0; }
};
struct SsmSSched {
    static constexpr bool GATHER = false;
    const char* U; const char* W; unsigned lda, ldb; int G, c;
    __device__ __forceinline__ bool next(int i, Unit& u) const { const int L = c; if (i > 0 || L >= NG * SSM_RT) return false; u.aux = L / SSM_RT; u.pm = L % SSM_RT; u.pn = 0; u.kp = -1; return true; }
    __device__ __forceinline__ int nt(const Unit&) const { return NYC / 64; }
    __device__ __forceinline__ const char* a_base(const Unit& u) const { return U + ((size_t)(u.aux * NROWG + u.pm * 256) * UAW + 128) * 2; }
    __device__ __forceinline__ const char* b_base(const Unit& u) const { return W + (size_t)u.aux * 256 * NYC * 2; }
    __device__ __forceinline__ unsigned a_rowoff(const Unit&, int) const { return 0; }
};
struct SsmYSched {
    static constexpr bool GATHER = false;
    const char* U; const char* W; unsigned lda, ldb; int G, c;
    __device__ __forceinline__ bool next(int i, Unit& u) const { const int L = i * G + c; if (L >= NG * SSM_RT * SSM_CT) return false; const int rem = L % (NG * SSM_RT);
        u.pn = SSM_CT - 1 - L / (NG * SSM_RT); u.aux = rem / SSM_RT; u.pm = rem % SSM_RT; u.kp = -1; return true; }
    __device__ __forceinline__ int nt(const Unit& u) const { return 2 + 4 * (u.pn + 1); }
    __device__ __forceinline__ const char* a_base(const Unit& u) const { return U + (size_t)(u.aux * NROWG + u.pm * 256) * UAW * 2; }
    __device__ __forceinline__ const char* b_base(const Unit& u) const { return W + (size_t)(u.aux * NYC + u.pn * 256) * UAW * 2; }
    __device__ __forceinline__ unsigned a_rowoff(const Unit&, int) const { return 0; }
};
struct MoeSched {
    static constexpr bool GATHER = true;
    const char* A; const char* Bt; unsigned lda, ldb; size_t bstride; int nN, ntk, G, c;
    const LAS int* te; const int* slot_tok; int ntiles;
    __device__ __forceinline__ bool next(int i, Unit& u) const { if (!pg8::static_unit(i, G, c, ntiles, nN, u)) return false; u.aux = te[u.pm]; return true; }
    __device__ __forceinline__ int nt(const Unit&) const { return ntk; }
    __device__ __forceinline__ const char* a_base(const Unit&) const { return A; }
    __device__ __forceinline__ const char* b_base(const Unit& u) const { return Bt + (size_t)u.aux * bstride + (size_t)u.pn * 256 * ldb; }
    __device__ __forceinline__ unsigned rowoff_idx(int t) const { return (unsigned)(t < 0 ? 0 : t) * lda; }
    __device__ __forceinline__ unsigned a_rowoff(const Unit& u, int r) const { return rowoff_idx(((const GAS int*)slot_tok)[u.pm * 256 + r]); }
    __device__ __forceinline__ void idx_dma(const Unit& u, unsigned lds_dst, int lane) const { pg8::glds16_(slot_tok + u.pm * 256 + lane * 4, lds_dst); }
};

constexpr int KSPLIT = 7, MOE_LEFT_ROWS = 2048;
struct MoeDownSched {
    static constexpr bool GATHER = false;
    const char* A; const char* Bt; unsigned lda, ldb; size_t bstride; int G, c; const LAS int* te; int T;
    __device__ __forceinline__ bool next(int i, Unit& u) const { const int Tm = T & ~63, nmain = Tm * 4, nmini = (T - Tm) * 4 * KSPLIT;
        const int nr = nmain > c ? (nmain - c + G - 1) / G : 0;
        if (i < nr) { pg8::static_unit(i, G, c, Tm, 4, u); u.aux = te[u.pm]; return true; }
        const int j = (i - nr) * G + c; if (j >= nmini) return false;
        u.pm = Tm + j / (4 * KSPLIT); u.pn = (j / KSPLIT) & 3; u.kp = j % KSPLIT; u.aux = te[u.pm]; return true; }
    __device__ __forceinline__ int nt(const Unit& u) const { return u.kp < 0 ? FFE / 64 : FFE / 64 / KSPLIT; }
    __device__ __forceinline__ const char* a_base(const Unit& u) const { return A + (size_t)u.pm * 256 * lda + (u.kp < 0 ? (size_t)0 : (size_t)u.kp * (FFE / KSPLIT) * 2); }
    __device__ __forceinline__ const char* b_base(const Unit& u) const { return Bt + (size_t)u.aux * bstride + (size_t)u.pn * 256 * ldb + (u.kp < 0 ? (size_t)0 : (size_t)u.kp * (FFE / KSPLIT) * 2); }
    __device__ __forceinline__ unsigned a_rowoff(const Unit&, int) const { return 0; }
};
static_assert((FFE / 64) % (2 * KSPLIT) == 0 && FFE / 64 / KSPLIT >= 4, "K-split parts: an even number of K-tiles, >= 4");

__device__ __forceinline__ v4u pack8(const f32x4& a, const f32x4& b) { v4u w; w.x = pk2(a[0], a[1]); w.y = pk2(a[2], a[3]); w.z = pk2(b[0], b[1]); w.w = pk2(b[2], b[3]); return w; }
struct EpiInProj {
    static constexpr bool PERM = true, AFTER_DRAIN = false; bf16* UA; bf16* PL;
    __device__ __forceinline__ void put8(const Unit& u, int r, int c, const f32x4& v0, const f32x4& v1) const {
        const int m = u.pm * 256 + r, col = u.pn * 256 + c; bf16* dst;
        if (col < 512) { const int g = col >> 4, hc = col & 15, b = m >> 12, l = m & 4095; dst = UA + ((size_t)(g * NROWG + b * NCH + l / TCH) * UAW + 128 + (l % TCH) * 16 + hc); }
        else dst = PL + (size_t)m * 512 + (col - 512);
        *(GAS v4u*)dst = pack8(v0, v1); }
};
struct EpiBf16 {
    static constexpr bool PERM = true, AFTER_DRAIN = false; bf16* O; int ldc;
    __device__ __forceinline__ void put8(const Unit& u, int r, int c, const f32x4& v0, const f32x4& v1) const { *(GAS v4u*)(O + (size_t)(u.pm * 256 + r) * ldc + u.pn * 256 + c) = pack8(v0, v1); }
};
constexpr int RS_OFF = pg8::STAGE_BYTES + 1024;
__device__ __forceinline__ void rs_begin(const float* SSp, const Unit& u, LAS unsigned char* lds, int tid) {
    if (tid < 256) { const GAS f32x4* p = (const GAS f32x4*)(SSp + (size_t)(u.pm * 256 + tid) * 16); const f32x4 a = p[0], b = p[1], c = p[2], d = p[3];
        const float ss = ((a[0] + a[1]) + (a[2] + a[3])) + ((b[0] + b[1]) + (b[2] + b[3])) + ((c[0] + c[1]) + (c[2] + c[3])) + ((d[0] + d[1]) + (d[2] + d[3]));
        ((LAS float*)(lds + RS_OFF + (u.seq & 1) * 2048))[tid] = 1.f / sqrtf(ss * (1.f / DM) + EPS); }
}
struct EpiInProjRs {
    static constexpr bool PERM = true, AFTER_DRAIN = false, BEGIN = true, CUSTOM = true; bf16* UA; bf16* PL; const float* SSp; LAS unsigned char* L; float* SSL;
    __device__ __forceinline__ void unit_begin(const Unit& u, LAS unsigned char* lds, int tid) const { rs_begin(SSp, u, lds, tid); }
    __device__ __forceinline__ void apply(const f32x4 (&acc)[2][2][4][2], const Unit& u, int wr, int wc, int fr, int fq) const {
        const LAS float* rsp = (const LAS float*)(L + RS_OFF + (u.seq & 1) * 2048);
#pragma unroll
        for (int ai = 0; ai < 2; ++ai)
#pragma unroll
            for (int mi = 0; mi < 4; ++mi) { const int r = ai * 128 + wr * 64 + mi * 16 + fr, m = u.pm * 256 + r; const float q = rsp[r]; float ssq[2];
#pragma unroll
                for (int bj = 0; bj < 2; ++bj) { const int col = u.pn * 256 + bj * 128 + wc * 32 + 8 * fq; const f32x4 v0 = acc[ai][bj][mi][0] * q, v1 = acc[ai][bj][mi][1] * q; bf16* dst;
                    if (col < 512) { const int g = col >> 4, hc = col & 15, b = m >> 12, l = m & 4095; dst = UA + ((size_t)(g * NROWG + b * NCH + l / TCH) * UAW + 128 + (l % TCH) * 16 + hc); }
                    else dst = PL + (size_t)m * 512 + (col - 512);
                    *(GAS v4u*)dst = pack8(v0, v1);
                    ssq[bj] = ((v0[0] * v0[0] + v0[1] * v0[1]) + (v0[2] * v0[2] + v0[3] * v0[3])) + ((v1[0] * v1[0] + v1[1] * v1[1]) + (v1[2] * v1[2] + v1[3] * v1[3])); }
                if (u.pn >= 2) { float sacc = (u.pn == 2) ? ssq[0] + ssq[1] : ssq[0]; sacc += __shfl_xor(sacc, 16); sacc += __shfl_xor(sacc, 32);
                    if (fq == 0) ((GAS float*)SSL)[(size_t)m * 8 + (u.pn == 2 ? 0 : 4) + wc] = sacc; }
                asm volatile("" ::: "memory"); }
    }
};
struct EpiBf16Rs {
    static constexpr bool PERM = true, AFTER_DRAIN = false, BEGIN = true; bf16* O; int ldc; const float* SSL; int off; float inv_dim; LAS unsigned char* L;
    __device__ __forceinline__ void unit_begin(const Unit& u, LAS unsigned char* lds, int tid) const {
        if (tid < 256) { const f32x4 p = *(const GAS f32x4*)(SSL + (size_t)(u.pm * 256 + tid) * 8 + off); ((LAS float*)(lds + RS_OFF + (u.seq & 1) * 2048))[tid] = 1.f / sqrtf(((p[0] + p[1]) + (p[2] + p[3])) * inv_dim + EPS); } }
    __device__ __forceinline__ void put8(const Unit& u, int r, int c, const f32x4& v0, const f32x4& v1) const {
        const float q = ((const LAS float*)(L + RS_OFF + (u.seq & 1) * 2048))[r];
        *(GAS v4u*)(O + (size_t)(u.pm * 256 + r) * ldc + u.pn * 256 + c) = pack8(v0 * q, v1 * q); }
};
struct EpiSwigluRs {
    static constexpr bool PERM = true, AFTER_DRAIN = false, PAIR = true, BEGIN = true; bf16* ACT; int ldact; const float* SSp; LAS unsigned char* L;
    __device__ __forceinline__ void unit_begin(const Unit& u, LAS unsigned char* lds, int tid) const { rs_begin(SSp, u, lds, tid); }
    __device__ __forceinline__ void putpair(const Unit& u, int r, int c, const f32x4& g0_, const f32x4& g1_, const f32x4& u0_, const f32x4& u1_) const {
        const float q = ((const LAS float*)(L + RS_OFF + (u.seq & 1) * 2048))[r];
        const f32x4 g0 = g0_ * q, g1 = g1_ * q, u0 = u0_ * q, u1 = u1_ * q; f32x4 a, b;
#pragma unroll
        for (int j = 0; j < 4; ++j) { a[j] = g0[j] * sigmoidf_(g0[j]) * u0[j]; b[j] = g1[j] * sigmoidf_(g1[j]) * u1[j]; }
        *(GAS v4u*)(ACT + (size_t)(u.pm * 256 + r) * ldact + u.pn * 128 + c) = pack8(a, b); }
};
struct EpiGlu {
    static constexpr bool PERM = true, AFTER_DRAIN = false, CUSTOM = true; const bf16* YG; const float* bias; bf16* MIX; float* SS;
    __device__ __forceinline__ void apply(const f32x4 (&acc)[2][2][4][2], const Unit& u, int wr, int wc, int fr, int fq) const {
        f32x4 bb[2][2];
#pragma unroll
        for (int bj = 0; bj < 2; ++bj) { const int col = u.pn * 256 + bj * 128 + wc * 32 + 8 * fq; bb[bj][0] = *(const GAS f32x4*)(bias + col); bb[bj][1] = *(const GAS f32x4*)(bias + col + 4); }
#pragma unroll
        for (int ai = 0; ai < 2; ++ai) { v4u yv[4][2];
#pragma unroll
            for (int mi = 0; mi < 4; ++mi)
#pragma unroll
                for (int bj = 0; bj < 2; ++bj) yv[mi][bj] = *(const GAS v4u*)(YG + (size_t)(u.pm * 256 + ai * 128 + wr * 64 + mi * 16 + fr) * 512 + u.pn * 256 + bj * 128 + wc * 32 + 8 * fq);
#pragma unroll
            for (int mi = 0; mi < 4; ++mi) { const int m = u.pm * 256 + ai * 128 + wr * 64 + mi * 16 + fr; float ssq = 0.f;
#pragma unroll
                for (int bj = 0; bj < 2; ++bj) { const int col = u.pn * 256 + bj * 128 + wc * 32 + 8 * fq; const f32x4& v0 = acc[ai][bj][mi][0]; const f32x4& v1 = acc[ai][bj][mi][1];
                    const v4u yw = yv[mi][bj]; const f32x4 b0 = bb[bj][0], b1 = bb[bj][1];
                    f32x4 o0, o1; o0[0] = bflo(yw.x) * sigmoidf_(v0[0] + b0[0]); o0[1] = bfhi(yw.x) * sigmoidf_(v0[1] + b0[1]); o0[2] = bflo(yw.y) * sigmoidf_(v0[2] + b0[2]); o0[3] = bfhi(yw.y) * sigmoidf_(v0[3] + b0[3]);
                    o1[0] = bflo(yw.z) * sigmoidf_(v1[0] + b1[0]); o1[1] = bfhi(yw.z) * sigmoidf_(v1[1] + b1[1]); o1[2] = bflo(yw.w) * sigmoidf_(v1[2] + b1[2]); o1[3] = bfhi(yw.w) * sigmoidf_(v1[3] + b1[3]);
                    ssq += (o0[0] * o0[0] + o0[1] * o0[1]) + (o0[2] * o0[2] + o0[3] * o0[3]) + (o1[0] * o1[0] + o1[1] * o1[1]) + (o1[2] * o1[2] + o1[3] * o1[3]);
                    *(GAS v4u*)(MIX + (size_t)m * 1024 + col) = pack8(o0, o1); }
                ssq += __shfl_xor(ssq, 16); ssq += __shfl_xor(ssq, 32);
                if (fq == 0) ((GAS float*)SS)[(size_t)m * 16 + u.pn * 4 + wc] = ssq; }
            asm volatile("" ::: "memory"); }
    }
};
struct EpiSsmY {
    static constexpr bool PERM = true, AFTER_DRAIN = false; bf16* YG;
    __device__ __forceinline__ void put8(const Unit& u, int r, int c, const f32x4& v0, const f32x4& v1) const {
        const int rr = u.pm * 256 + r, n = u.pn * 256 + c, tok = (rr / NCH) * SEQ + (rr % NCH) * TCH + (n >> 4);
        f32x4 a, b;
#pragma unroll
        for (int j = 0; j < 4; ++j) { a[j] = gelu_tanh(v0[j]); b[j] = gelu_tanh(v1[j]); }
        *(GAS v4u*)(YG + (size_t)tok * 512 + u.aux * 16 + (n & 15)) = pack8(a, b); }
};
struct EpiResid {
    static constexpr bool PERM = true, AFTER_DRAIN = false, CUSTOM = true; bf16* HB; float ascale; float* SSo;
    __device__ __forceinline__ void apply(const f32x4 (&acc)[2][2][4][2], const Unit& u, int wr, int wc, int fr, int fq) const {
        bf16* base = HB + (size_t)(u.pm * 256 + wr * 64 + fr) * DM + u.pn * 256 + wc * 32 + 8 * fq;
#pragma unroll
        for (int ai = 0; ai < 2; ++ai) { v4u rv[4][2];
#pragma unroll
            for (int m = 0; m < 4; ++m)
#pragma unroll
                for (int bj = 0; bj < 2; ++bj) rv[m][bj] = *(const GAS v4u*)(base + (size_t)(ai * 128 + m * 16) * DM + bj * 128);
#pragma unroll
            for (int m = 0; m < 4; ++m) { float ssq = 0.f;
#pragma unroll
                for (int bj = 0; bj < 2; ++bj) { const v4u x = rv[m][bj]; const f32x4 a0 = acc[ai][bj][m][0] * ascale, a1 = acc[ai][bj][m][1] * ascale; v4u w;
                    const f32x4 h0 = (f32x4){bflo(x.x), bfhi(x.x), bflo(x.y), bfhi(x.y)} + a0, h1 = (f32x4){bflo(x.z), bfhi(x.z), bflo(x.w), bfhi(x.w)} + a1;
                    ssq += ((h0[0] * h0[0] + h0[1] * h0[1]) + (h0[2] * h0[2] + h0[3] * h0[3])) + ((h1[0] * h1[0] + h1[1] * h1[1]) + (h1[2] * h1[2] + h1[3] * h1[3]));
                    w.x = pk2(h0[0], h0[1]); w.y = pk2(h0[2], h0[3]); w.z = pk2(h1[0], h1[1]); w.w = pk2(h1[2], h1[3]);
                    *(GAS v4u*)(base + (size_t)(ai * 128 + m * 16) * DM + bj * 128) = w; }
                ssq += __shfl_xor(ssq, 16); ssq += __shfl_xor(ssq, 32);
                if (fq == 0) ((GAS float*)SSo)[(size_t)(u.pm * 256 + ai * 128 + wr * 64 + m * 16 + fr) * 16 + u.pn * 4 + wc] = ssq; }
            asm volatile("" ::: "memory"); }
    }
};
struct EpiOutProj {
    static constexpr bool PERM = true, AFTER_DRAIN = false, CUSTOM = true, BEGIN = true; static constexpr int MID_T = 8; bf16* HB; const float* SS; float ascale; LAS unsigned char* L; float* SSo;
    __device__ __forceinline__ void unit_begin(const Unit& u, LAS unsigned char* lds, int tid) const {
        if (tid < 256) { const GAS f32x4* p = (const GAS f32x4*)(SS + (size_t)(u.pm * 256 + tid) * 16); const f32x4 a = p[0], b = p[1], c = p[2], d = p[3];
            const float ss = (a[0] + a[1]) + (a[2] + a[3]) + (b[0] + b[1]) + (b[2] + b[3]), sm = (c[0] + c[1]) + (c[2] + c[3]) + (d[0] + d[1]) + (d[2] + d[3]);
            const float rs = 1.f / sqrtf(ss * (1.f / 512) + EPS), rm = 1.f / sqrtf(sm * (1.f / 512) + EPS);
            ((LAS f32x2*)(lds + RS_OFF + (u.seq & 1) * 2048))[tid] = (f32x2){rs / rm, rm}; }
    }
    __device__ __forceinline__ void mid(f32x4 (&acc)[2][2][4][2], const Unit& u, int wr, int fr, LAS unsigned char* lds) const {
        const LAS f32x2* rsp = (const LAS f32x2*)(lds + RS_OFF + (u.seq & 1) * 2048);
#pragma unroll
        for (int ai = 0; ai < 2; ++ai)
#pragma unroll
            for (int m = 0; m < 4; ++m) { const float q = rsp[ai * 128 + wr * 64 + m * 16 + fr][0];
#pragma unroll
                for (int bj = 0; bj < 2; ++bj)
#pragma unroll
                    for (int n = 0; n < 2; ++n) acc[ai][bj][m][n] *= q; }
    }
    __device__ __forceinline__ void apply(const f32x4 (&acc)[2][2][4][2], const Unit& u, int wr, int wc, int fr, int fq) const {
        const LAS f32x2* rsp = (const LAS f32x2*)(L + RS_OFF + (u.seq & 1) * 2048);
        bf16* base = HB + (size_t)(u.pm * 256 + wr * 64 + fr) * DM + u.pn * 256 + wc * 32 + 8 * fq;
#pragma unroll
        for (int ai = 0; ai < 2; ++ai) { v4u rv[4][2];
#pragma unroll
            for (int m = 0; m < 4; ++m)
#pragma unroll
                for (int bj = 0; bj < 2; ++bj) rv[m][bj] = *(const GAS v4u*)(base + (size_t)(ai * 128 + m * 16) * DM + bj * 128);
#pragma unroll
            for (int m = 0; m < 4; ++m) { const float q = rsp[ai * 128 + wr * 64 + m * 16 + fr][1] * ascale; float ssq = 0.f;
#pragma unroll
                for (int bj = 0; bj < 2; ++bj) { const v4u x = rv[m][bj]; const f32x4 a0 = acc[ai][bj][m][0] * q, a1 = acc[ai][bj][m][1] * q; v4u w;
                    const f32x4 h0 = (f32x4){bflo(x.x), bfhi(x.x), bflo(x.y), bfhi(x.y)} + a0, h1 = (f32x4){bflo(x.z), bfhi(x.z), bflo(x.w), bfhi(x.w)} + a1;
                    ssq += ((h0[0] * h0[0] + h0[1] * h0[1]) + (h0[2] * h0[2] + h0[3] * h0[3])) + ((h1[0] * h1[0] + h1[1] * h1[1]) + (h1[2] * h1[2] + h1[3] * h1[3]));
                    w.x = pk2(h0[0], h0[1]); w.y = pk2(h0[2], h0[3]); w.z = pk2(h1[0], h1[1]); w.w = pk2(h1[2], h1[3]);
                    *(GAS v4u*)(base + (size_t)(ai * 128 + m * 16) * DM + bj * 128) = w; }
                ssq += __shfl_xor(ssq, 16); ssq += __shfl_xor(ssq, 32);
                if (fq == 0) ((GAS float*)SSo)[(size_t)(u.pm * 256 + ai * 128 + wr * 64 + m * 16 + fr) * 16 + u.pn * 4 + wc] = ssq; }
            asm volatile("" ::: "memory"); }
    }
};
struct EpiSwiglu {
    static constexpr bool PERM = true, AFTER_DRAIN = false, PAIR = true; bf16* ACT; int ldact;
    __device__ __forceinline__ void putpair(const Unit& u, int r, int c, const f32x4& g0, const f32x4& g1, const f32x4& u0, const f32x4& u1) const {
        f32x4 a, b;
#pragma unroll
        for (int j = 0; j < 4; ++j) { a[j] = g0[j] * sigmoidf_(g0[j]) * u0[j]; b[j] = g1[j] * sigmoidf_(g1[j]) * u1[j]; }
        *(GAS v4u*)(ACT + (size_t)(u.pm * 256 + r) * ldact + u.pn * 128 + c) = pack8(a, b); }
};
template <bool FINAL> struct EpiMoeDown {
    static constexpr bool PERM = true, AFTER_DRAIN = false, CUSTOM = true; const int* slot_tok; const float* slot_w; bf16* HB; float* out; float ascale; const int* ntp; bf16* PART;
    __device__ __forceinline__ void apply(const f32x4 (&acc)[2][2][4][2], const Unit& u, int wr, int wc, int fr, int fq) const {
        int tok[2][4]; float w[2][4]; const int s0 = u.pm * 256 + wr * 64 + fr;
        const int Tm = (*ntp) & ~63;
#pragma unroll
        for (int ai = 0; ai < 2; ++ai)
#pragma unroll
            for (int m = 0; m < 4; ++m) { tok[ai][m] = ((const GAS int*)slot_tok)[s0 + ai * 128 + m * 16]; w[ai][m] = ((const GAS float*)slot_w)[s0 + ai * 128 + m * 16] * ascale; }
        const int cb = u.pn * 256 + wc * 32 + 8 * fq;
        if (u.kp >= 0) {
            bf16* pb = PART + ((size_t)u.kp * MOE_LEFT_ROWS + (size_t)(u.pm - Tm) * 256 + wr * 64 + fr) * DM + cb;
#pragma unroll
            for (int ai = 0; ai < 2; ++ai)
#pragma unroll
                for (int m = 0; m < 4; ++m)
#pragma unroll
                    for (int bj = 0; bj < 2; ++bj) *(GAS v4u*)(pb + (size_t)(ai * 128 + m * 16) * DM + bj * 128) = pack8(acc[ai][bj][m][0] * w[ai][m], acc[ai][bj][m][1] * w[ai][m]);
            return; }
#pragma unroll
        for (int ai = 0; ai < 2; ++ai) { v4u rv[4][2];
#pragma unroll
            for (int m = 0; m < 4; ++m) { const int t = tok[ai][m] < 0 ? 0 : tok[ai][m];
#pragma unroll
                for (int bj = 0; bj < 2; ++bj) rv[m][bj] = *(const GAS v4u*)(HB + (size_t)t * DM + cb + bj * 128); }
#pragma unroll
            for (int m = 0; m < 4; ++m) { if (tok[ai][m] < 0) continue;
#pragma unroll
                for (int bj = 0; bj < 2; ++bj) { const v4u x = rv[m][bj]; const f32x4 a0 = acc[ai][bj][m][0] * w[ai][m], a1 = acc[ai][bj][m][1] * w[ai][m];
                    const f32x4 r0 = {bflo(x.x) + a0[0], bfhi(x.x) + a0[1], bflo(x.y) + a0[2], bfhi(x.y) + a0[3]}, r1 = {bflo(x.z) + a1[0], bfhi(x.z) + a1[1], bflo(x.w) + a1[2], bfhi(x.w) + a1[3]};
                    if constexpr (FINAL) { GAS f32x4* o = (GAS f32x4*)(out + (size_t)tok[ai][m] * DM + cb + bj * 128); o[0] = r0; o[1] = r1; }
                    else *(GAS v4u*)(HB + (size_t)tok[ai][m] * DM + cb + bj * 128) = pack8(r0, r1); } }
            asm volatile("" ::: "memory"); }
    }
};
struct EpiSsmS {
    static constexpr bool PERM = false, AFTER_DRAIN = true; bf16* UA; const float* aT;
    __device__ __forceinline__ void fused(const f32x4 (&acc)[2][2][4][2], const Unit& u, int wr, int wc, int fr, int fq, LAS unsigned char* lds, int wid, int lane) const {
        LAS float* T = (LAS float*)lds;
#pragma unroll
        for (int ai = 0; ai < 2; ++ai)
#pragma unroll
            for (int m = 0; m < 4; ++m) { const int r = ai * 128 + wr * 64 + m * 16 + fr;
#pragma unroll
                for (int n = 0; n < 2; ++n) *(LAS f32x4*)(T + r * 128 + wc * 32 + 16 * n + 4 * fq) = acc[ai][0][m][n]; }
        LDS_WAIT(); __builtin_amdgcn_s_barrier(); asm volatile("" ::: "memory");
        constexpr int NBU = 256 / NCH, NSEG = 8 / NBU, SEG = NCH / NSEG; static_assert(SEG == 32 && NBU * NSEG == 8, "segmented scan: 8 waves x 32 chunks");
        const int p = lane, sg = wid % NSEG, bl = wid / NSEG, g = u.aux;
        const float ar = ((const GAS float*)aT)[(g * 64 + p) * 2], ai_ = ((const GAS float*)aT)[(g * 64 + p) * 2 + 1];
        LAS float* Tb = T + (size_t)(bl * NCH + sg * SEG) * 128;
        float sr = 0.f, si = 0.f;
#pragma unroll 8
        for (int j = 0; j < SEG; ++j) { const float lr = Tb[j * 128 + p], li = Tb[j * 128 + 64 + p]; Tb[j * 128 + p] = sr; Tb[j * 128 + 64 + p] = si;
            const float nr = ar * sr - ai_ * si + lr, ni = ar * si + ai_ * sr + li; sr = nr; si = ni; }
        LAS float* EA = (LAS float*)(lds + RS_OFF);
        EA[(wid * 64 + p) * 2] = sr; EA[(wid * 64 + p) * 2 + 1] = si;
        float br = ar, bi = ai_;
#pragma unroll
        for (int q = 0; q < 5; ++q) { const float t = br * br - bi * bi; bi = 2.f * br * bi; br = t; }
        LDS_WAIT(); __builtin_amdgcn_s_barrier(); asm volatile("" ::: "memory");
        float cr = 0.f, ci = 0.f;
        for (int s2 = 0; s2 < sg; ++s2) { const float er = EA[((bl * NSEG + s2) * 64 + p) * 2], ei = EA[((bl * NSEG + s2) * 64 + p) * 2 + 1]; const float nr = br * cr - bi * ci + er, ni = br * ci + bi * cr + ei; cr = nr; ci = ni; }
        bf16* dst = UA + (size_t)(g * NROWG + u.pm * 256 + bl * NCH + sg * SEG) * UAW;
#pragma unroll 8
        for (int j = 0; j < SEG; ++j) { const float lr = Tb[j * 128 + p] + cr, li = Tb[j * 128 + 64 + p] + ci; dst[(size_t)j * UAW + p] = f2bf(lr); dst[(size_t)j * UAW + 64 + p] = f2bf(li);
            const float nr = ar * cr - ai_ * ci, ni = ar * ci + ai_ * cr; cr = nr; ci = ni; }
        LDS_WAIT(); __builtin_amdgcn_s_barrier(); asm volatile("" ::: "memory");
    }
};

struct RmId { int off; __device__ __forceinline__ int operator()(int n) const { return off + n; } };
struct RmGU { int up; __device__ __forceinline__ int operator()(int n) const { return 256 * (n >> 7) + 128 * up + (n & 127); } };
struct KgNone { __device__ __forceinline__ float operator()(int) const { return 1.f; } };
struct KgVec { const float* g; __device__ __forceinline__ float operator()(int k) const { return ((const GAS float*)g)[k]; } };
struct KgOut { const float* gs; const float* gm; __device__ __forceinline__ float operator()(int k) const { return k < 512 ? ((const GAS float*)gs)[k] : ((const GAS float*)gm)[k - 512]; } };
template <class RowMap, class KG = KgNone> __device__ __forceinline__ void tr_matrix(const float* W, int K, int N, bf16* WT, int ldt, RowMap rm, LAS float* scr, int gw, int NGW, int lane, KG kg = KG()) { asm volatile("" : "+v"(lane));
    const int nnb = N / 32, items = (K / 64) * nnb; const int rr = lane >> 3, c4 = (lane & 7) * 4, c = lane & 7;
    int it = gw; if (it >= items) return;
    f32x4 v[8];
#pragma unroll
    for (int i = 0; i < 8; ++i) v[i] = *(const GAS f32x4*)(W + (size_t)(64 * (it / nnb) + 8 * i + rr) * N + 32 * (it % nnb) + c4);
    for (;;) {
        const int k0 = 64 * (it / nnb), n0 = 32 * (it % nnb), nx = it + NGW; const bool more = nx < items;
#pragma unroll
        for (int i = 0; i < 8; ++i) { LAS float* d = scr + (8 * i + rr) * 33 + c4; const float g_ = kg(k0 + 8 * i + rr); d[0] = v[i][0] * g_; d[1] = v[i][1] * g_; d[2] = v[i][2] * g_; d[3] = v[i][3] * g_; }
        if (more) {
#pragma unroll
            for (int i = 0; i < 8; ++i) v[i] = *(const GAS f32x4*)(W + (size_t)(64 * (nx / nnb) + 8 * i + rr) * N + 32 * (nx % nnb) + c4); }
        LDS_WAIT(); asm volatile("" ::: "memory");
#pragma unroll
        for (int j = 0; j < 4; ++j) { const int n = (lane >> 3) + 8 * j; const LAS float* sp = scr + (8 * c) * 33 + n;
            v4u o; o.x = pk2(sp[0 * 33], sp[1 * 33]); o.y = pk2(sp[2 * 33], sp[3 * 33]); o.z = pk2(sp[4 * 33], sp[5 * 33]); o.w = pk2(sp[6 * 33], sp[7 * 33]);
            *(GAS v4u*)(WT + (size_t)rm(n0 + n) * ldt + k0 + 8 * c) = o; }
        LDS_WAIT(); asm volatile("" ::: "memory");
        if (!more) break; it = nx;
    }
}
__device__ __forceinline__ void zero_bf16(bf16* p, size_t n8  , int gtid, int gthreads) { asm volatile("" : "+v"(gtid)); for (size_t i = gtid; i < n8; i += gthreads) ((v4u*)p)[i] = (v4u){0u, 0u, 0u, 0u}; }

__device__ __forceinline__ int rot(int gw, int NGW, int off) { int r = gw - (off % NGW); return r < 0 ? r + NGW : r; }
__device__ __forceinline__ void conv_small(unsigned char* ws_, int layer, LAS float* scr, int gw, int NGW, int lane, int gtid, int gthreads) {
    unsigned char* wb = ws_ + WS_WSMALL + (size_t)layer * WSM_STRIDE;
    bf16* Win_t = (bf16*)(wb + WSM_IN); bf16* Wglu_t = (bf16*)(wb + WSM_GLU); bf16* Wq_t = (bf16*)(wb + WSM_Q); bf16* Wkv_t = (bf16*)(wb + WSM_KV); bf16* Wout_t = (bf16*)(wb + WSM_OUT);
    constexpr int N_IN = (DM / 64) * (DIN / 32), N_GLU = (DSSM / 64) * (DSSM / 32), N_Q = (QRANK / 64) * (768 / 32), N_KV = (KVRANK / 64) * (1024 / 32);
    tr_matrix(kin(I_W_IN) + (size_t)layer * DM * DIN, DM, DIN, Win_t, DM, RmId{0}, scr, gw, NGW, lane, KgVec{kin(I_ATTN_NORM) + layer * DM});
    tr_matrix(kin(I_W_GLU) + (size_t)layer * DSSM * DSSM, DSSM, DSSM, Wglu_t, DSSM, RmId{0}, scr, rot(gw, NGW, N_IN), NGW, lane);
    tr_matrix(kin(I_W_Q_UP) + (size_t)layer * QRANK * 768, QRANK, 768, Wq_t, QRANK, RmId{0}, scr, rot(gw, NGW, N_IN + N_GLU), NGW, lane, KgVec{kin(I_Q_NORM) + layer * QRANK});
    tr_matrix(kin(I_W_KV_UP) + (size_t)layer * KVRANK * 1024, KVRANK, 1024, Wkv_t, 256, RmId{0}, scr, rot(gw, NGW, N_IN + N_GLU + N_Q), NGW, lane, KgVec{kin(I_KV_NORM) + layer * KVRANK});
    tr_matrix(kin(I_W_OUT) + (size_t)layer * DM * DM, DM, DM, Wout_t, DM, RmId{0}, scr, rot(gw, NGW, N_IN + N_GLU + N_Q + N_KV), NGW, lane, KgOut{kin(I_SSM_OUT_NORM) + layer * DSSM, kin(I_MLA_OUT_NORM) + layer * DSSM});
    zero_bf16(Win_t + (size_t)DIN * DM, (size_t)(1024 - DIN) * DM / 8, gtid, gthreads);
    asm volatile("" : "+v"(gtid));
    for (int i = gtid; i < 1024 * 16; i += gthreads) ((v4u*)(Wkv_t + (size_t)(i >> 4) * 256 + 128))[i & 15] = (v4u){0u, 0u, 0u, 0u};
}
__device__ __forceinline__ void conv_dense(unsigned char* ws_, LAS float* scr, int gw, int NGW, int lane) {
    bf16* Wgu = (bf16*)(ws_ + WS_BIGW + BW_DGU); bf16* Wd = (bf16*)(ws_ + WS_BIGW + BW_DD);
    tr_matrix(kin(I_DW_GATE), DM, FFD, Wgu, DM, RmGU{0}, scr, gw, NGW, lane, KgVec{kin(I_FFN_NORM)});
    tr_matrix(kin(I_DW_UP), DM, FFD, Wgu, DM, RmGU{1}, scr, gw, NGW, lane, KgVec{kin(I_FFN_NORM)});
    tr_matrix(kin(I_DW_DOWN), FFD, DM, Wd, FFD, RmId{0}, scr, gw, NGW, lane);
}
__device__ __forceinline__ void conv_moe(unsigned char* ws_, LAS float* scr, int gw, int NGW, int lane) {
    bf16* Wgu = (bf16*)(ws_ + WS_BIGW + BW_MGU); bf16* Wd = (bf16*)(ws_ + WS_BIGW + BW_MD);
    for (int e = 0; e < NE; ++e) {
        tr_matrix(kin(I_MW_GATE) + (size_t)e * DM * FFE, DM, FFE, Wgu + (size_t)e * 2 * FFE * DM, DM, RmGU{0}, scr, gw, NGW, lane);
        tr_matrix(kin(I_MW_UP) + (size_t)e * DM * FFE, DM, FFE, Wgu + (size_t)e * 2 * FFE * DM, DM, RmGU{1}, scr, gw, NGW, lane);
        tr_matrix(kin(I_MW_DOWN) + (size_t)e * FFE * DM, FFE, DM, Wd + (size_t)e * DM * FFE, FFE, RmId{0}, scr, gw, NGW, lane);
    }
}
__device__ __forceinline__ void rms_row(const float* xrow, const float* g, bf16* orow, int lane) {
    const GAS f32x4* xr = (const GAS f32x4*)xrow + lane; const GAS f32x4* gr = (const GAS f32x4*)g + lane; f32x4 v[4]; float s = 0.f;
#pragma unroll
    for (int j = 0; j < 4; ++j) { v[j] = xr[64 * j]; s += (v[j][0] * v[j][0] + v[j][1] * v[j][1]) + (v[j][2] * v[j][2] + v[j][3] * v[j][3]); }
    const float rstd = 1.f / sqrtf(wave_sum(s) * (1.f / DM) + EPS);
    GAS v2u* o8 = (GAS v2u*)orow + lane;
#pragma unroll
    for (int j = 0; j < 4; ++j) { const f32x4 gg = gr[64 * j]; v2u w; w.x = pk2(v[j][0] * rstd * gg[0], v[j][1] * rstd * gg[1]); w.y = pk2(v[j][2] * rstd * gg[2], v[j][3] * rstd * gg[3]); o8[64 * j] = w; }
}
__device__ __forceinline__ void rms_row_b(const bf16* xrow, const float* g, bf16* orow, int lane) {
    const v4u a = *((const GAS v4u*)xrow + lane), b = *((const GAS v4u*)xrow + 64 + lane);
    float v[16] = {bflo(a.x), bfhi(a.x), bflo(a.y), bfhi(a.y), bflo(a.z), bfhi(a.z), bflo(a.w), bfhi(a.w), bflo(b.x), bfhi(b.x), bflo(b.y), bfhi(b.y), bflo(b.z), bfhi(b.z), bflo(b.w), bfhi(b.w)}; float s = 0.f;
#pragma unroll
    for (int j = 0; j < 16; ++j) s += v[j] * v[j];
    const float rstd = 1.f / sqrtf(wave_sum(s) * (1.f / DM) + EPS);
    const f32x4 g0 = *((const GAS f32x4*)g + 2 * lane), g1 = *((const GAS f32x4*)g + 2 * lane + 1), g2 = *((const GAS f32x4*)g + 128 + 2 * lane), g3 = *((const GAS f32x4*)g + 128 + 2 * lane + 1);
    v4u w; w.x = pk2(v[0] * rstd * g0[0], v[1] * rstd * g0[1]); w.y = pk2(v[2] * rstd * g0[2], v[3] * rstd * g0[3]); w.z = pk2(v[4] * rstd * g1[0], v[5] * rstd * g1[1]); w.w = pk2(v[6] * rstd * g1[2], v[7] * rstd * g1[3]);
    *((GAS v4u*)orow + lane) = w;
    w.x = pk2(v[8] * rstd * g2[0], v[9] * rstd * g2[1]); w.y = pk2(v[10] * rstd * g2[2], v[11] * rstd * g2[3]); w.z = pk2(v[12] * rstd * g3[0], v[13] * rstd * g3[1]); w.w = pk2(v[14] * rstd * g3[2], v[15] * rstd * g3[3]);
    *((GAS v4u*)orow + 64 + lane) = w;
}
__device__ __forceinline__ void ph_rmsnorm_b(const bf16* HB, const float* g, bf16* Z, int gw, int NGW, int lane) { asm volatile("" : "+v"(lane)); for (int m = gw; m < M; m += NGW) rms_row_b(HB + (size_t)m * DM, g, Z + (size_t)m * DM, lane); }
__device__ __forceinline__ void ph_x2hb(const float* x, bf16* HB, float* SSo, int gw, int NGW, int lane) { asm volatile("" : "+v"(lane));
    constexpr int R = 2;
    for (int mb = gw * R; mb < M; mb += NGW * R) { f32x4 v[R][4];
#pragma unroll
        for (int r = 0; r < R; ++r)
#pragma unroll
            for (int j = 0; j < 4; ++j) v[r][j] = *((const GAS f32x4*)(x + (size_t)(mb + r) * DM) + 64 * j + lane);
#pragma unroll
        for (int r = 0; r < R; ++r) { const int m = mb + r; float s = 0.f;
#pragma unroll
            for (int j = 0; j < 4; ++j) s += (v[r][j][0] * v[r][j][0] + v[r][j][1] * v[r][j][1]) + (v[r][j][2] * v[r][j][2] + v[r][j][3] * v[r][j][3]);
            s = wave_sum(s);
            GAS v2u* h8 = (GAS v2u*)(HB + (size_t)m * DM) + lane;
#pragma unroll
            for (int j = 0; j < 4; ++j) { v2u hw; hw.x = pk2(v[r][j][0], v[r][j][1]); hw.y = pk2(v[r][j][2], v[r][j][3]); h8[64 * j] = hw; }
            if (lane < 4) ((GAS f32x4*)(SSo + (size_t)m * 16))[lane] = (f32x4){lane == 0 ? s : 0.f, 0.f, 0.f, 0.f}; } }
}
__device__ __forceinline__ void ph_rmsnorm(const float* h, const float* g, bf16* Z, int gw, int NGW, int lane) { asm volatile("" : "+v"(lane)); for (int m = gw; m < M; m += NGW) rms_row(h + (size_t)m * DM, g, Z + (size_t)m * DM, lane); }
__device__ __forceinline__ void ph_latnorm(const bf16* PL, const float* gq, const float* gkv, bf16* LAT, int gw, int NGW, int lane) { asm volatile("" : "+v"(lane));
    constexpr int R = 8;
    const f32x4 g4 = *((const GAS f32x4*)gq + lane); const f32x2 g2 = *((const GAS f32x2*)gkv + lane);
    for (int mb = gw * R; mb < M; mb += NGW * R) { v2u qa[R]; unsigned ka[R];
#pragma unroll
        for (int r = 0; r < R; ++r) { qa[r] = *((const GAS v2u*)(PL + (size_t)(mb + r) * 512) + lane); ka[r] = *((const GAS unsigned*)(PL + (size_t)(mb + r) * 512 + 256) + lane); }
#pragma unroll
        for (int r = 0; r < R; ++r) { const int m = mb + r;
            const float q0 = bflo(qa[r].x), q1 = bfhi(qa[r].x), q2 = bflo(qa[r].y), q3 = bfhi(qa[r].y), k0 = bflo(ka[r]), k1 = bfhi(ka[r]);
            const float rq = 1.f / sqrtf(wave_sum(q0 * q0 + q1 * q1 + q2 * q2 + q3 * q3) * (1.f / 256) + EPS), rk = 1.f / sqrtf(wave_sum(k0 * k0 + k1 * k1) * (1.f / 128) + EPS);
            v2u w; w.x = pk2(q0 * rq * g4[0], q1 * rq * g4[1]); w.y = pk2(q2 * rq * g4[2], q3 * rq * g4[3]); *((GAS v2u*)(LAT + (size_t)m * 512) + lane) = w;
            *((GAS unsigned*)(LAT + (size_t)m * 512 + 256) + lane) = pk2(k0 * rk * g2[0], k1 * rk * g2[1]); *((GAS unsigned*)(LAT + (size_t)m * 512 + 384) + lane) = 0u; } }
}
constexpr float QSCALE = 0.10206207261596575f * 1.4426950408889634f;
__device__ __forceinline__ void ph_qkprep(const bf16* KVR, const bf16* PL, bf16* KN, const float* kg, int gw, int NGW, int lane) { asm volatile("" : "+v"(lane));
    const int hd = lane >> 3, sub = lane & 7;
    float gk[12];
#pragma unroll
    for (int j = 0; j < 8; ++j) gk[j] = ((const GAS float*)kg)[sub * 8 + j];
#pragma unroll
    for (int j = 0; j < 2; ++j) { gk[8 + j] = ((const GAS float*)kg)[64 + sub * 2 + j]; gk[10 + j] = ((const GAS float*)kg)[80 + sub * 2 + j]; }
    const float ir0 = exp2f(-(float)(sub * 2) * (13.287712379549449f / 16.f)) * 0.15915494309189535f, ir1 = exp2f(-(float)(sub * 2 + 1) * (13.287712379549449f / 16.f)) * 0.15915494309189535f;
    constexpr int R = 8;
    for (int mb = gw * R; mb < M; mb += NGW * R) { v4u kn[R]; unsigned kx1[R], kx2[R];
#pragma unroll
        for (int r = 0; r < R; ++r) { const int m = mb + r; const bf16* kp = KVR + (size_t)m * 1024 + hd * 128; const bf16* rp = PL + (size_t)m * 512 + 384;
            kn[r] = *(const GAS v4u*)(kp + sub * 8); kx1[r] = *(const GAS unsigned*)(rp + sub * 2); kx2[r] = *(const GAS unsigned*)(rp + 16 + sub * 2); }
#pragma unroll
        for (int r = 0; r < R; ++r) { const int m = mb + r; const int pos = m & (SEQ - 1);
            const float a0 = __builtin_amdgcn_fractf((float)pos * ir0), a1 = __builtin_amdgcn_fractf((float)pos * ir1);
            const float s0 = __builtin_amdgcn_sinf(a0), c0 = __builtin_amdgcn_cosf(a0), s1 = __builtin_amdgcn_sinf(a1), c1 = __builtin_amdgcn_cosf(a1);
            float k[12] = {bflo(kn[r].x), bfhi(kn[r].x), bflo(kn[r].y), bfhi(kn[r].y), bflo(kn[r].z), bfhi(kn[r].z), bflo(kn[r].w), bfhi(kn[r].w), bflo(kx1[r]), bfhi(kx1[r]), bflo(kx2[r]), bfhi(kx2[r])};
            float sk = 0.f;
#pragma unroll
            for (int j = 0; j < 12; ++j) sk += k[j] * k[j];
            sk += __shfl_xor(sk, 1); sk += __shfl_xor(sk, 2); sk += __shfl_xor(sk, 4);
            const float rk = 1.f / sqrtf(sk * (1.f / 96) + EPS);
#pragma unroll
            for (int j = 0; j < 12; ++j) k[j] *= rk * gk[j];
            const float ka0 = k[8] * c0 - k[10] * s0, kb0 = k[8] * s0 + k[10] * c0, ka1 = k[9] * c1 - k[11] * s1, kb1 = k[9] * s1 + k[11] * c1;
            bf16* ko = KN + (size_t)m * 768 + hd * 96; v4u w;
            w.x = pk2(k[0], k[1]); w.y = pk2(k[2], k[3]); w.z = pk2(k[4], k[5]); w.w = pk2(k[6], k[7]);
            *(GAS v4u*)(ko + sub * 8) = w; *(GAS unsigned*)(ko + 64 + sub * 2) = pk2(ka0, ka1); *(GAS unsigned*)(ko + 80 + sub * 2) = pk2(kb0, kb1); } }
}
__device__ __forceinline__ void ph_outnorm(bf16* MIX, const float* gs, const float* gm, int gw, int NGW, int lane) { asm volatile("" : "+v"(lane));
    for (int m = gw; m < M; m += NGW) { v4u* rp = (v4u*)(MIX + (size_t)m * 1024) + 2 * lane;
        const v4u a = rp[0], b = rp[1]; float v[16] = {bflo(a.x), bfhi(a.x), bflo(a.y), bfhi(a.y), bflo(a.z), bfhi(a.z), bflo(a.w), bfhi(a.w), bflo(b.x), bfhi(b.x), bflo(b.y), bfhi(b.y), bflo(b.z), bfhi(b.z), bflo(b.w), bfhi(b.w)}; float s = 0.f;
#pragma unroll
        for (int j = 0; j < 16; ++j) s += v[j] * v[j];
#pragma unroll
        for (int o = 1; o < 32; o <<= 1) s += __shfl_xor(s, o);
        const float rstd = 1.f / sqrtf(s * (1.f / 512) + EPS); const float* g = (lane < 32 ? gs : gm) + (lane & 31) * 16;
#pragma unroll
        for (int j = 0; j < 16; ++j) v[j] *= rstd * g[j];
        v4u w; w.x = pk2(v[0], v[1]); w.y = pk2(v[2], v[3]); w.z = pk2(v[4], v[5]); w.w = pk2(v[6], v[7]); rp[0] = w;
        w.x = pk2(v[8], v[9]); w.y = pk2(v[10], v[11]); w.z = pk2(v[12], v[13]); w.w = pk2(v[14], v[15]); rp[1] = w; }
}
__device__ __forceinline__ void ph_norm_route(const bf16* HB, const float* g, const float* Wr, bf16* Z, v4u* route, int gw, int NGW, int lane) { asm volatile("" : "+v"(lane));
    float gg[16], wg[16][8];
#pragma unroll
    for (int j = 0; j < 4; ++j) { const f32x4 g4 = *((const GAS f32x4*)g + 64 * j + lane);
#pragma unroll
        for (int q = 0; q < 4; ++q) { gg[4 * j + q] = g4[q]; const GAS f32x4* wr = (const GAS f32x4*)(Wr + (size_t)(256 * j + 4 * lane + q) * 8); const f32x4 wa = wr[0], wb = wr[1];
#pragma unroll
            for (int e = 0; e < 4; ++e) { wg[4 * j + q][e] = wa[e] * g4[q]; wg[4 * j + q][4 + e] = wb[e] * g4[q]; } } }
    constexpr int R = 4;
    for (int mb = gw * R; mb < M; mb += NGW * R) { v2u x[R][4];
#pragma unroll
        for (int r = 0; r < R; ++r)
#pragma unroll
            for (int j = 0; j < 4; ++j) x[r][j] = *((const GAS v2u*)(HB + (size_t)(mb + r) * DM) + 64 * j + lane);
#pragma unroll
        for (int r = 0; r < R; ++r) { const int m = mb + r; float v[16]; float s = 0.f;
#pragma unroll
            for (int j = 0; j < 4; ++j) { v[4 * j] = bflo(x[r][j].x); v[4 * j + 1] = bfhi(x[r][j].x); v[4 * j + 2] = bflo(x[r][j].y); v[4 * j + 3] = bfhi(x[r][j].y); }
#pragma unroll
            for (int i = 0; i < 16; ++i) s += v[i] * v[i];
            const float rstd = 1.f / sqrtf(wave_sum(s) * (1.f / DM) + EPS);
            float lg[8] = {0.f, 0.f, 0.f, 0.f, 0.f, 0.f, 0.f, 0.f};
#pragma unroll
            for (int i = 0; i < 16; ++i)
#pragma unroll
                for (int e = 0; e < 8; ++e) lg[e] += v[i] * wg[i][e];
#pragma unroll
            for (int j = 0; j < 4; ++j) { v2u w; w.x = pk2(v[4 * j] * rstd * gg[4 * j], v[4 * j + 1] * rstd * gg[4 * j + 1]); w.y = pk2(v[4 * j + 2] * rstd * gg[4 * j + 2], v[4 * j + 3] * rstd * gg[4 * j + 3]); *((GAS v2u*)(Z + (size_t)m * DM) + 64 * j + lane) = w; }
            {
              const bool b5 = (lane & 32) != 0, b4 = (lane & 16) != 0, b3 = (lane & 8) != 0; float a4[4], a2[2];
#pragma unroll
              for (int e = 0; e < 4; ++e) a4[e] = (b5 ? lg[e + 4] : lg[e]) + __shfl_xor(b5 ? lg[e] : lg[e + 4], 32);
#pragma unroll
              for (int e = 0; e < 2; ++e) a2[e] = (b4 ? a4[e + 2] : a4[e]) + __shfl_xor(b4 ? a4[e] : a4[e + 2], 16);
              float c1 = (b3 ? a2[1] : a2[0]) + __shfl_xor(b3 ? a2[0] : a2[1], 8);
              c1 += __shfl_xor(c1, 4); c1 += __shfl_xor(c1, 2); c1 += __shfl_xor(c1, 1);
#pragma unroll
              for (int e = 0; e < 8; ++e) lg[e] = __builtin_bit_cast(float, __builtin_amdgcn_readlane(__builtin_bit_cast(int, c1), 8 * e)) * rstd; }
            int e0 = 0; float v0 = lg[0];
#pragma unroll
            for (int e = 1; e < 8; ++e) if (lg[e] > v0) { v0 = lg[e]; e0 = e; }
            int e1 = -1; float v1 = -3.0e38f;
#pragma unroll
            for (int e = 0; e < 8; ++e) if (e != e0 && lg[e] > v1) { v1 = lg[e]; e1 = e; }
            const float w1 = 1.f / (1.f + expf(v0 - v1)), w0 = 1.f - w1;
            if (lane == 0) { ((GAS v2u*)route)[m] = (v2u){(unsigned)e0, (unsigned)e1}; ((GAS f32x2*)((unsigned char*)route + 256 * 1024))[m] = (f32x2){w0, w1}; } } }
}
__device__ __forceinline__ void ph_route_sort(const v4u* route, unsigned char* rt, LAS unsigned char* lds, int tid) { asm volatile("" : "+v"(tid));
    int* slot_tok = (int*)(rt + RT_SLOT_TOK); float* slot_w = (float*)(rt + RT_SLOT_W); int* tile_e = (int*)(rt + RT_TILE_E); int* ntl = (int*)(rt + RT_NTILES);
    const v2u* re = (const v2u*)route; const f32x2* rw = (const f32x2*)((const unsigned char*)route + 256 * 1024);
    LAS int* wtot = (LAS int*)lds;
    LAS int* wbase = wtot + 128;
    LAS int* etot = wbase + 128;
    const int lane = tid & 63, w = tid >> 6;
    int c[16];
#pragma unroll
    for (int j = 0; j < 16; ++j) c[j] = 0;
    for (int i = 0; i < 64; ++i) { const v2u r = re[w * 4096 + i * 64 + lane];
#pragma unroll
        for (int j = 0; j < 8; ++j) { c[j] += __popcll(__ballot(r.x == (unsigned)j)); c[8 + j] += __popcll(__ballot(r.y == (unsigned)j)); } }
    if (lane == 0) {
#pragma unroll
        for (int j = 0; j < 16; ++j) wtot[w * 16 + j] = c[j]; }
    __syncthreads();
    if (tid < 16) { int s = 0; for (int ww = 0; ww < 8; ++ww) { wbase[ww * 16 + tid] = s; s += wtot[ww * 16 + tid]; } etot[tid] = s; }
    __syncthreads();
    if (tid < 2) { int off = 0; for (int e = 0; e < 8; ++e) { const int n = etot[tid * 8 + e]; const int pad = (n + 255) & ~255; etot[16 + tid * 8 + e] = off;
            for (int t = off / 256; t < (off + pad) / 256; ++t) tile_e[tid * MOE_TILES + t] = e; off += pad; } ntl[tid] = off / 256; }
    __syncthreads();
    for (int j = 0; j < 16; ++j) { const int n = etot[j], off = etot[16 + j], pad = (n + 255) & ~255, k = j >> 3; for (int s = off + n + tid; s < off + pad; s += 512) { slot_tok[k * MOE_SLOTS + s] = -1; slot_w[k * MOE_SLOTS + s] = 0.f; } }
#pragma unroll
    for (int j = 0; j < 16; ++j) c[j] = wbase[w * 16 + j] + etot[16 + j];
    const unsigned long long ltmask = (1ull << lane) - 1ull;
    for (int i = 0; i < 64; ++i) { const int m = w * 4096 + i * 64 + lane; const v2u r = re[m]; const f32x2 wv = rw[m]; int s0 = 0, s1 = 0;
#pragma unroll
        for (int j = 0; j < 8; ++j) { const unsigned long long b0 = __ballot(r.x == (unsigned)j), b1 = __ballot(r.y == (unsigned)j);
            if (r.x == (unsigned)j) s0 = c[j] + __popcll(b0 & ltmask); if (r.y == (unsigned)j) s1 = c[8 + j] + __popcll(b1 & ltmask);
            c[j] += __popcll(b0); c[8 + j] += __popcll(b1); }
        slot_tok[s0] = m; slot_w[s0] = wv[0]; slot_tok[MOE_SLOTS + s1] = m; slot_w[MOE_SLOTS + s1] = wv[1]; }
}
__device__ __forceinline__ void ph_ssm_prep(unsigned char* ws_, int layer, int g, int part, LAS unsigned char* lds, int tid) { asm volatile("" : "+v"(tid));
    LAS float* apr = (LAS float*)lds;
    LAS float* api = apr + 64 * TP1;
    LAS float* bbr = api + 64 * TP1;
    LAS float* bbi = bbr + 1024;
    LAS float* ccr = bbi + 1024;
    LAS float* cci = ccr + 1024;
    LAS float* kt = cci + 1024;
    constexpr int BAND = TCH / 8;
    const float* A_re = kin(I_A_RE) + (size_t)(layer * NG + g) * NP; const float* A_im = kin(I_A_IM) + (size_t)(layer * NG + g) * NP;
    const float step = expf(kin(I_LOG_STEP)[layer * NG + g]);
    const float* B_re = kin(I_B_RE) + (size_t)(layer * NG + g) * NP * GH; const float* B_im = kin(I_B_IM) + (size_t)(layer * NG + g) * NP * GH;
    const float* C_re = kin(I_C_RE) + (size_t)(layer * NG + g) * GH * NP; const float* C_im = kin(I_C_IM) + (size_t)(layer * NG + g) * GH * NP;
    const float* Dv = kin(I_D) + (size_t)(layer * NG + g) * GH;
    for (int i = tid; i < 64 * TP1; i += 512) { const int p = i / TP1, tau = i % TP1; const float e = expf(A_re[p] * step * (float)tau); float sn, cs; sincosf(A_im[p] * step * (float)tau, &sn, &cs); apr[i] = e * cs; api[i] = e * sn; }
    for (int i = tid; i < 1024; i += 512) { const int p = i >> 4; const float lr = A_re[p], li = A_im[p]; const float e = expf(lr * step); float sn, cs; sincosf(li * step, &sn, &cs);
        const float nr = e * cs - 1.f, ni = e * sn, den = lr * lr + li * li, sr = (nr * lr + ni * li) / den, si = (ni * lr - nr * li) / den;
        const float br = B_re[i], bi = B_im[i]; bbr[i] = br * sr - bi * si; bbi[i] = br * si + bi * sr; ccr[i] = C_re[i]; cci[i] = C_im[i]; }
    __syncthreads();
    for (int i = tid; i < BAND * 256; i += 512) { const int tau = BAND * part + (i >> 8), h = (i >> 4) & 15, h2 = i & 15; float s = 0.f;
        for (int p = 0; p < 64; ++p) { const float cr = ccr[h * 64 + p], ci = cci[h * 64 + p], ar = apr[p * TP1 + tau], ai = api[p * TP1 + tau], br = bbr[p * 16 + h2], bi = bbi[p * 16 + h2];
            const float xr = cr * ar - ci * ai, xi = cr * ai + ci * ar; s += xr * br - xi * bi; }
        if (tau == 0 && h == h2) s += Dv[h];
        kt[i] = s; }
    if (part == 0 && tid < 64) { float* aT = (float*)(ws_ + WS_APOW) + (size_t)(g * 64 + tid) * 2; aT[0] = apr[tid * TP1 + TCH]; aT[1] = api[tid * TP1 + TCH]; }
    __syncthreads();
    bf16* Mg = (bf16*)(ws_ + WS_BIGW + BW_MAUG) + (size_t)g * NYC * UAW;
    { const int t0 = BAND * part;
      for (int i = tid; i < BAND * TCH * 32; i += 512) { const int tl = i / (TCH * 32), t = (i >> 5) % TCH, h = (i >> 1) & 15, hf = i & 1, tau = t0 + tl, sft = t - tau; if (sft < 0) continue;
          const LAS f32x4* src = (const LAS f32x4*)(kt + (tl << 8) + h * 16 + hf * 8); const f32x4 x = src[0], y = src[1];
          v4u w; w.x = pk2(x[0], x[1]); w.y = pk2(x[2], x[3]); w.z = pk2(y[0], y[1]); w.w = pk2(y[2], y[3]);
          *(GAS v4u*)(Mg + (size_t)(t * 16 + h) * UAW + 128 + sft * 16 + hf * 8) = w; } }
    for (int i = tid; i < (NYC / 8) * (UAW / 8); i += 512) { const int n = part * (NYC / 8) + i / (UAW / 8), k0 = (i % (UAW / 8)) * 8, t = n >> 4, h = n & 15; float v[8];
        if (k0 >= 128) { if (((k0 - 128) >> 4) <= t) continue;
#pragma unroll
            for (int j = 0; j < 8; ++j) v[j] = 0.f; }
        else {
#pragma unroll
            for (int j = 0; j < 8; ++j) { const int k = k0 + j, p = k & 63; const float cr = ccr[h * 64 + p], ci = cci[h * 64 + p], ar = apr[p * TP1 + t + 1], ai = api[p * TP1 + t + 1];
                v[j] = (k < 64) ? (cr * ar - ci * ai) : -(cr * ai + ci * ar); } }
        v4u w; w.x = pk2(v[0], v[1]); w.y = pk2(v[2], v[3]); w.z = pk2(v[4], v[5]); w.w = pk2(v[6], v[7]); *(GAS v4u*)(Mg + (size_t)n * UAW + k0) = w; }
    bf16* Wg = (bf16*)(ws_ + WS_BIGW + BW_WST) + (size_t)g * 256 * NYC;
    for (int i = tid; i < 32 * (NYC / 8); i += 512) { const int n = part * 32 + i / (NYC / 8), k0 = (i % (NYC / 8)) * 8, s = k0 >> 4, h2 = k0 & 15; float v[8];
        if (n < 128) { const int p = n & 63; const float ar = apr[p * TP1 + TCH - 1 - s], ai = api[p * TP1 + TCH - 1 - s];
#pragma unroll
            for (int j = 0; j < 8; ++j) { const float br = bbr[p * 16 + h2 + j], bi = bbi[p * 16 + h2 + j]; v[j] = (n < 64) ? (ar * br - ai * bi) : (ar * bi + ai * br); } }
        else {
#pragma unroll
            for (int j = 0; j < 8; ++j) v[j] = 0.f; }
        v4u w; w.x = pk2(v[0], v[1]); w.y = pk2(v[2], v[3]); w.z = pk2(v[4], v[5]); w.w = pk2(v[6], v[7]); *(GAS v4u*)(Wg + (size_t)n * NYC + k0) = w; }
    __syncthreads();
}
template <bool FINAL> __device__ __forceinline__ void ph_moe_reduce(const int* slot_tok, const int* ntp, const bf16* PART, bf16* HB, float* out, int gw, int NGW, int lane) { asm volatile("" : "+v"(lane));
    const int T = *ntp, Tm = T & ~63, nrow = (T - Tm) * 256;
    for (int r = gw; r < nrow; r += NGW) { const int tok = ((const GAS int*)slot_tok)[Tm * 256 + r]; if (tok < 0) continue;
#pragma unroll
        for (int hf = 0; hf < 2; ++hf) { const v4u h = *((const GAS v4u*)(HB + (size_t)tok * DM) + hf * 64 + lane);
            float v[8] = {bflo(h.x), bfhi(h.x), bflo(h.y), bfhi(h.y), bflo(h.z), bfhi(h.z), bflo(h.w), bfhi(h.w)};
#pragma unroll
            for (int kp = 0; kp < KSPLIT; ++kp) { const v4u p = *((const GAS v4u*)(PART + ((size_t)kp * MOE_LEFT_ROWS + r) * DM) + hf * 64 + lane);
                v[0] += bflo(p.x); v[1] += bfhi(p.x); v[2] += bflo(p.y); v[3] += bfhi(p.y); v[4] += bflo(p.z); v[5] += bfhi(p.z); v[6] += bflo(p.w); v[7] += bfhi(p.w); }
            if constexpr (FINAL) { GAS f32x4* o = (GAS f32x4*)(out + (size_t)tok * DM) + hf * 128 + 2 * lane; o[0] = (f32x4){v[0], v[1], v[2], v[3]}; o[1] = (f32x4){v[4], v[5], v[6], v[7]}; }
            else { v4u w; w.x = pk2(v[0], v[1]); w.y = pk2(v[2], v[3]); w.z = pk2(v[4], v[5]); w.w = pk2(v[6], v[7]); *((GAS v4u*)(HB + (size_t)tok * DM) + hf * 64 + lane) = w; } } }
}

namespace att {
typedef float f32x16 __attribute__((ext_vector_type(16)));
typedef short s16x4 __attribute__((ext_vector_type(4)));
typedef short v4i16_t __attribute__((ext_vector_type(4)));
constexpr int SLOTK = 12288, SLOTV = 8192, LDS_K = 0, LDS_V = 4 * SLOTK, LDS_WS = LDS_V + 3 * SLOTV, LDS_OST = LDS_WS + 8 * 256, LDS_BYTES = LDS_OST + 8 * 4096;
__device__ __forceinline__ int crow(int r, int hi) { return (r & 3) + 8 * (r >> 2) + 4 * hi; }
__device__ __forceinline__ void glds16(const void* gsrc, unsigned lds_dst) { unsigned keep;
    asm volatile("s_mov_b32 %0, m0\n\ts_mov_b32 m0, %2\n\ts_nop 0\n\tglobal_load_lds_dwordx4 %1, off\n\ts_mov_b32 m0, %0" : "=&s"(keep) : "v"(gsrc), "s"(lds_dst) : "memory"); }
#define ATT_WAIT_BAR(N) asm volatile("s_waitcnt vmcnt(" #N ") lgkmcnt(0)\n\ts_barrier" ::: "memory")
#define ATT_SBAR() __builtin_amdgcn_sched_barrier(0)
#define ATT_PIN(x) asm volatile("" : "+v"(x))
#define ATT_MFMA(a, b, c) __builtin_amdgcn_mfma_f32_32x32x16_bf16(a, b, c, 0, 0, 0)
__device__ __forceinline__ float max3f(float a, float b, float c) { return __builtin_fmaxf(__builtin_fmaxf(a, b), c); }
__device__ __forceinline__ float rowmax32(const f32x16& p0, const f32x16& p1) {
    float a = max3f(p0[0], p0[1], p1[0]), b = max3f(p0[2], p0[3], p1[1]); a = max3f(a, p1[2], p1[3]);
#pragma unroll
    for (int r = 4; r < 16; r += 4) { a = max3f(a, p0[r], p0[r + 1]); b = max3f(b, p0[r + 2], p0[r + 3]); a = max3f(a, p1[r], p1[r + 1]); b = max3f(b, p1[r + 2], p1[r + 3]); }
    const float m = fmaxf(a, b);
    auto rr = __builtin_amdgcn_permlane32_swap(__float_as_uint(m), __float_as_uint(m), false, false);
    return fmaxf(__uint_as_float(rr[0]), __uint_as_float(rr[1]));
}
__device__ __forceinline__ void kld(bf16x8* kf, int idx, const LAS unsigned char* kp, int d0) { kf[idx] = *(const LAS bf16x8*)(kp + d0 * 2048); kf[idx + 1] = *(const LAS bf16x8*)(kp + d0 * 2048 + 512); }
__device__ __forceinline__ s16x4 vtr(const LAS unsigned char* p) { return __builtin_bit_cast(s16x4, __builtin_amdgcn_ds_read_tr16_b64_v4i16((LAS v4i16_t*)p)); }
__device__ __forceinline__ void attn_unit(int b, int h, int qb, const bf16* QN, const bf16* KN, const bf16* KVR, bf16* MIX, float* SS, const float* qg, LAS unsigned char* shm) {
    int tid = threadIdx.x; asm volatile("" : "+v"(tid));
    const int lane = tid & 63, r32 = lane & 31, hi = lane >> 5, wid = __builtin_amdgcn_readfirstlane(tid >> 6);
    const long rowbase = (long)b * SEQ; const int q0 = qb * 256;
    const unsigned lds0 = (unsigned)(uintptr_t)shm;
    LAS float* wsf = (LAS float*)(shm + LDS_WS) + wid * 64;
    const int kc2 = wid < 4 ? 8 + wid : wid;
    const bf16* ksrc0 = KN + (rowbase + lane) * 768 + h * 96 + wid * 8;
    const bf16* ksrc1 = KN + (rowbase + lane) * 768 + h * 96 + kc2 * 8;
    const bf16* vsrc = KVR + (rowbase + 16 * (wid & 3) + (lane >> 2)) * 1024 + h * 128 + 64 + (wid >> 2) * 32 + (lane & 3) * 8;
    const unsigned kdst0 = lds0 + LDS_K + wid * 1024, kdst1 = lds0 + LDS_K + kc2 * 1024, vdst = lds0 + LDS_V + wid * 1024;
#define DMA_K(t, ks) do { glds16(ksrc0 + (long)(t) * 64 * 768, (unsigned)__builtin_amdgcn_readfirstlane(kdst0 + (ks) * SLOTK)); glds16(ksrc1 + (long)(t) * 64 * 768, (unsigned)__builtin_amdgcn_readfirstlane(kdst1 + (ks) * SLOTK)); } while (0)
#define DMA_V(t, vs) glds16(vsrc + (long)(t) * 64 * 1024, (unsigned)__builtin_amdgcn_readfirstlane(vdst + (vs) * SLOTV))
    const LAS unsigned char* vp0 = shm + LDS_V + ((lane >> 4) & 1) * 32 + (lane & 3) * 8 + (4 * hi + ((lane & 15) >> 2)) * 64;
    const LAS unsigned char* kp0 = shm + LDS_K + hi * 1024 + r32 * 16;
    const int NT = 4 * qb + 4, jmax = 4 * qb + (wid >> 1);
    DMA_K(0, 0); DMA_V(0, 0); DMA_K(1, 1);
    bf16x8 qr[6];
    {
      const bf16* Qw = QN + (rowbase + q0 + wid * 32 + r32) * 768 + h * 96 + hi * 8; v4u qw[6];
#pragma unroll
      for (int d0 = 0; d0 < 6; ++d0) qw[d0] = *(const GAS v4u*)(Qw + d0 * 16);
      f32x4 gA[6], gB[6];
#pragma unroll
      for (int d0 = 0; d0 < 6; ++d0) { gA[d0] = *(const GAS f32x4*)(qg + d0 * 16 + hi * 8); gB[d0] = *(const GAS f32x4*)(qg + d0 * 16 + hi * 8 + 4); }
      float qf[6][8]; float ss = 0.f;
#pragma unroll
      for (int d0 = 0; d0 < 6; ++d0) { qf[d0][0] = bflo(qw[d0].x); qf[d0][1] = bfhi(qw[d0].x); qf[d0][2] = bflo(qw[d0].y); qf[d0][3] = bfhi(qw[d0].y); qf[d0][4] = bflo(qw[d0].z); qf[d0][5] = bfhi(qw[d0].z); qf[d0][6] = bflo(qw[d0].w); qf[d0][7] = bfhi(qw[d0].w);
#pragma unroll
          for (int j = 0; j < 8; ++j) ss += qf[d0][j] * qf[d0][j]; }
      { auto rr = __builtin_amdgcn_permlane32_swap(__float_as_uint(ss), __float_as_uint(ss), false, false); ss = __uint_as_float(rr[0]) + __uint_as_float(rr[1]); }
      const float rq = QSCALE / sqrtf(ss * (1.f / 96) + EPS);
#pragma unroll
      for (int d0 = 0; d0 < 6; ++d0)
#pragma unroll
          for (int j = 0; j < 8; ++j) qf[d0][j] *= rq * (j < 4 ? gA[d0][j] : gB[d0][j - 4]);
      const float posf = (float)(q0 + wid * 32 + r32);
#pragma unroll
      for (int j = 0; j < 8; ++j) { const float ir = exp2f(-(float)(hi * 8 + j) * (13.287712379549449f / 16.f)) * 0.15915494309189535f;
          const float a = __builtin_amdgcn_fractf(posf * ir), sn = __builtin_amdgcn_sinf(a), cs = __builtin_amdgcn_cosf(a);
          const float x1 = qf[4][j], x2 = qf[5][j]; qf[4][j] = x1 * cs - x2 * sn; qf[5][j] = x1 * sn + x2 * cs; }
#pragma unroll
      for (int d0 = 0; d0 < 6; ++d0) { v4u w; w.x = pk2(qf[d0][0], qf[d0][1]); w.y = pk2(qf[d0][2], qf[d0][3]); w.z = pk2(qf[d0][4], qf[d0][5]); w.w = pk2(qf[d0][6], qf[d0][7]); qr[d0] = __builtin_bit_cast(bf16x8, w); } }
    DMA_K(2, 2);
    float mhat = 0.f, l_reg = 0.f; f32x16 o[2];
#pragma unroll
    for (int r = 0; r < 16; ++r) { o[0][r] = 0.f; o[1][r] = 0.f; }
#define ZERO16 (f32x16){0.f, 0.f, 0.f, 0.f, 0.f, 0.f, 0.f, 0.f, 0.f, 0.f, 0.f, 0.f, 0.f, 0.f, 0.f, 0.f}
    constexpr float THRL = 8.f;
    bool resc = false;
    const bf16x8 kone = (hi == 0) ? (bf16x8){(short)0x3F80, 0, 0, 0, 0, 0, 0, 0} : (bf16x8){0, 0, 0, 0, 0, 0, 0, 0};
    bf16x8 qx = {0, 0, 0, 0, 0, 0, 0, 0};
    f32x16 pA0, pA1, pB0, pB1; bf16x8 kf[8]; s16x4 vlo[8], vhi[8]; v4u pw0, pw1, pw2, pw3;
    int kcs = 1, vprev = 0, vnext = 2;
#define ROT() do { kcs = (kcs + 1) & 3; vprev = (vprev == 2) ? 0 : vprev + 1; vnext = (vnext == 2) ? 0 : vnext + 1; } while (0)
#define RESC() do { if (resc) { _Pragma("unroll") for (int d_ = 0; d_ < 2; ++d_) _Pragma("unroll") for (int r = 0; r < 16; ++r) o[d_][r] *= wsf[crow(r, hi)]; } } while (0)
    ATT_WAIT_BAR(5);
#pragma unroll
    for (int d0 = 0; d0 < 4; ++d0) kld(kf, 2 * d0, kp0, d0);
    pA0 = ATT_MFMA(kf[0], qr[0], ZERO16); pA1 = ATT_MFMA(kf[1], qr[0], ZERO16); pA0 = ATT_MFMA(kf[2], qr[1], pA0); pA1 = ATT_MFMA(kf[3], qr[1], pA1);
    pA0 = ATT_MFMA(kf[4], qr[2], pA0); pA1 = ATT_MFMA(kf[5], qr[2], pA1); pA0 = ATT_MFMA(kf[6], qr[3], pA0); pA1 = ATT_MFMA(kf[7], qr[3], pA1);
    ATT_SBAR(); kld(kf, 0, kp0, 4); kld(kf, 2, kp0, 5);
    pA0 = ATT_MFMA(kf[0], qr[4], pA0); pA1 = ATT_MFMA(kf[1], qr[4], pA1); pA0 = ATT_MFMA(kf[2], qr[5], pA0); pA1 = ATT_MFMA(kf[3], qr[5], pA1);
    { const float rm0 = rowmax32(pA0, pA1); const unsigned mb = pk2(rm0, 0.f) & 0xffffu; const float rm = __builtin_bit_cast(float, mb << 16); mhat = rm;
      if (hi == 0) qx[0] = (short)(pk2(-rm, 0.f) & 0xffffu);
#pragma unroll
      for (int r = 0; r < 16; ++r) { pA0[r] = __builtin_amdgcn_exp2f(pA0[r] - rm); pA1[r] = __builtin_amdgcn_exp2f(pA1[r] - rm); } }
    ATT_WAIT_BAR(0);
    DMA_K(3, 3); DMA_V(1, 1);
#pragma unroll
    for (int d0 = 0; d0 < 4; ++d0) kld(kf, 2 * d0, kp0 + SLOTK, d0);
    ATT_WAIT_BAR(3);
#define PKW(P, i) pk2(P[i], P[i + 1])
#define PAF(k) __builtin_bit_cast(bf16x8, pw##k)
#define VFR(i) (bf16x8){vlo[i][0], vlo[i][1], vlo[i][2], vlo[i][3], vhi[i][0], vhi[i][1], vhi[i][2], vhi[i][3]}
#define VRD(i) do { vlo[i] = vtr(vp_ + (((i) >> 2) * 4096 + ((i) & 3) * 1024)); vhi[i] = vtr(vp_ + (((i) >> 2) * 4096 + ((i) & 3) * 1024 + 512)); } while (0)
#define KRD(G, d0) do { if (G) { kld(kf, 2 * (d0), kp0 + ((kcs + 1) & 3) * SLOTK, d0); ATT_SBAR(); } } while (0)
#define GAPA(MF, a0, a1, a2, a3, W0, W1, PW) do { MF; sacc += (f32x2){a0, a1}; sacc += (f32x2){a2, a3}; W0; W1; ATT_PIN(PW); ATT_PIN(sacc); ATT_SBAR(); } while (0)
#define EX(v) __builtin_amdgcn_exp2f(v)
#define GAPB(MF, X, i) do { MF; X[i] = EX(X[i]); X[i + 1] = EX(X[i + 1]); X[i + 2] = EX(X[i + 2]); X[i + 3] = EX(X[i + 3]); ATT_PIN(X); ATT_SBAR(); } while (0)
#define STEP(C0, C1, P0, P1, t, MASK, GK, GV, GL) do { ATT_SBAR(); \
    const LAS unsigned char* vp_ = vp0 + vprev * SLOTV; const LAS unsigned char* kp_ = kp0 + kcs * SLOTK; \
    VRD(0); ATT_SBAR(); f32x2 sacc = {P0[0], P0[1]}; \
                        C0 = ATT_MFMA(kone, qx, ZERO16); C1 = ATT_MFMA(kone, qx, ZERO16); \
                        GAPA(C0 = ATT_MFMA(kf[0], qr[0], C0), P0[2], P0[3], P0[4], P0[5],     pw0[0] = PKW(P0, 0),  pw0[1] = PKW(P0, 2),  pw0); \
    VRD(4); ATT_SBAR(); GAPA(C1 = ATT_MFMA(kf[1], qr[0], C1), P0[6], P0[7], P0[8], P0[9],     pw0[2] = PKW(P0, 4),  pw0[3] = PKW(P0, 6),  pw0); \
    kld(kf, 0, kp_, 4); ATT_SBAR();                                                                                     \
    VRD(1); ATT_SBAR(); GAPA(C0 = ATT_MFMA(kf[2], qr[1], C0),   P0[10], P0[11], P0[12], P0[13], pw1[0] = PKW(P0, 8),  pw1[1] = PKW(P0, 10), pw1); \
    VRD(5); ATT_SBAR(); GAPA(C1 = ATT_MFMA(kf[3], qr[1], C1),   P0[14], P0[15], P1[0], P1[1],   pw1[2] = PKW(P0, 12), pw1[3] = PKW(P0, 14), pw1); \
    kld(kf, 2, kp_, 5); ATT_SBAR(); \
    VRD(2); ATT_SBAR(); GAPA(C0 = ATT_MFMA(kf[4], qr[2], C0),   P1[2], P1[3], P1[4], P1[5],     pw2[0] = PKW(P1, 0),  pw2[1] = PKW(P1, 2),  pw2); \
    VRD(6); ATT_SBAR(); GAPA(C1 = ATT_MFMA(kf[5], qr[2], C1),   P1[6], P1[7], P1[8], P1[9],     pw2[2] = PKW(P1, 4),  pw2[3] = PKW(P1, 6),  pw2); \
    VRD(3); ATT_SBAR(); GAPA(C0 = ATT_MFMA(kf[6], qr[3], C0),   P1[10], P1[11], P1[12], P1[13], pw3[0] = PKW(P1, 8),  pw3[1] = PKW(P1, 10), pw3); \
    VRD(7); ATT_SBAR(); GAPA(C1 = ATT_MFMA(kf[7], qr[3], C1),   P1[14], P1[15], 0.f, 0.f,       pw3[2] = PKW(P1, 12), pw3[3] = PKW(P1, 14), pw3); \
    C0 = ATT_MFMA(kf[0], qr[4], C0); C1 = ATT_MFMA(kf[1], qr[4], C1); C0 = ATT_MFMA(kf[2], qr[5], C0); C1 = ATT_MFMA(kf[3], qr[5], C1); ATT_SBAR(); \
    l_reg += sacc[0] + sacc[1]; \
    if (GK) DMA_K((t) + 3, (kcs + 3) & 3); if (GV) DMA_V((t) + 1, vnext); \
    if (MASK) { if ((t) > jmax) { _Pragma("unroll") for (int r = 0; r < 16; ++r) { C0[r] = -INFINITY; C1[r] = -INFINITY; } } } \
    { const float rm = rowmax32(C0, C1); resc = false;                                                                    \
      if (__builtin_expect(__any(rm > THRL), 0)) { const float mn = __builtin_bit_cast(float, (pk2(mhat + __builtin_fmaxf(rm, 0.f), 0.f) & 0xffffu) << 16); const float dl = mn - mhat; mhat = mn;     \
          _Pragma("unroll") for (int r = 0; r < 16; ++r) { C0[r] -= dl; C1[r] -= dl; } \
          if (hi == 0) qx[0] = (short)(pk2(-mn, 0.f) & 0xffffu); \
          const float f = __builtin_amdgcn_exp2f(-dl); l_reg *= f; if (hi == 0) wsf[r32] = f; resc = true; } } \
    ATT_SBAR(); \
    GAPB(o[0] = ATT_MFMA(PAF(0), VFR(0), o[0]), C0, 0);              GAPB(o[1] = ATT_MFMA(PAF(0), VFR(4), o[1]), C0, 4); \
    KRD(GL, 0); GAPB(o[0] = ATT_MFMA(PAF(1), VFR(1), o[0]), C0, 8);  KRD(GL, 1); GAPB(o[1] = ATT_MFMA(PAF(1), VFR(5), o[1]), C0, 12); \
    KRD(GL, 2); GAPB(o[0] = ATT_MFMA(PAF(2), VFR(2), o[0]), C1, 0);  KRD(GL, 3); GAPB(o[1] = ATT_MFMA(PAF(2), VFR(6), o[1]), C1, 4); \
    GAPB(o[0] = ATT_MFMA(PAF(3), VFR(3), o[0]), C1, 8);              GAPB(o[1] = ATT_MFMA(PAF(3), VFR(7), o[1]), C1, 12); \
    } while (0)
    int t = 1;
    for (; t + 5 < NT; t += 2) {
        STEP(pB0, pB1, pA0, pA1, t, false, true, true, true);     ATT_WAIT_BAR(3); RESC(); ROT();
        STEP(pA0, pA1, pB0, pB1, t + 1, false, true, true, true); ATT_WAIT_BAR(3); RESC(); ROT();
    }
#define ENDW(tt) do { if ((tt) + 3 < NT) { ATT_WAIT_BAR(3); } else if ((tt) + 2 < NT) { ATT_WAIT_BAR(1); } else { ATT_WAIT_BAR(0); } } while (0)
    for (; t + 1 < NT; t += 2) {
        STEP(pB0, pB1, pA0, pA1, t, true, (t + 3 < NT), (t + 1 < NT), (t + 1 < NT));         ENDW(t);     RESC(); ROT();
        STEP(pA0, pA1, pB0, pB1, t + 1, true, (t + 4 < NT), (t + 2 < NT), (t + 2 < NT));     ENDW(t + 1); RESC(); ROT();
    }
    STEP(pB0, pB1, pA0, pA1, NT - 1, true, false, false, false); RESC();
    { float sacc = pB0[0] + pB0[1];
#pragma unroll
      for (int r = 2; r < 16; ++r) sacc += pB0[r];
#pragma unroll
      for (int r = 0; r < 16; ++r) sacc += pB1[r];
      l_reg += sacc;
      pw0 = (v4u){PKW(pB0, 0), PKW(pB0, 2), PKW(pB0, 4), PKW(pB0, 6)}; pw1 = (v4u){PKW(pB0, 8), PKW(pB0, 10), PKW(pB0, 12), PKW(pB0, 14)};
      pw2 = (v4u){PKW(pB1, 0), PKW(pB1, 2), PKW(pB1, 4), PKW(pB1, 6)}; pw3 = (v4u){PKW(pB1, 8), PKW(pB1, 10), PKW(pB1, 12), PKW(pB1, 14)};
      ROT(); const LAS unsigned char* vp_ = vp0 + vprev * SLOTV;
#pragma unroll
      for (int i = 0; i < 8; ++i) VRD(i);
      o[0] = ATT_MFMA(PAF(0), VFR(0), o[0]); o[1] = ATT_MFMA(PAF(0), VFR(4), o[1]); o[0] = ATT_MFMA(PAF(1), VFR(1), o[0]); o[1] = ATT_MFMA(PAF(1), VFR(5), o[1]);
      o[0] = ATT_MFMA(PAF(2), VFR(2), o[0]); o[1] = ATT_MFMA(PAF(2), VFR(6), o[1]); o[0] = ATT_MFMA(PAF(3), VFR(3), o[0]); o[1] = ATT_MFMA(PAF(3), VFR(7), o[1]); }
    { auto rr = __builtin_amdgcn_permlane32_swap(__float_as_uint(l_reg), __float_as_uint(l_reg), false, false); l_reg = __uint_as_float(rr[0]) + __uint_as_float(rr[1]); }
    if (hi == 0) wsf[32 + r32] = l_reg;
    asm volatile("s_waitcnt lgkmcnt(0)" ::: "memory");
    float rli[16];
#pragma unroll
    for (int r = 0; r < 16; ++r) rli[r] = __builtin_amdgcn_rcpf(wsf[32 + crow(r, hi)]);
    bf16* Ow = MIX + (rowbase + q0 + wid * 32) * 1024 + 512 + h * 64;
    { LAS bf16* stg = (LAS bf16*)(shm + LDS_OST) + wid * 2048;
#pragma unroll
      for (int r = 0; r < 16; ++r) { const int orow = crow(r, hi);
#pragma unroll
          for (int d0 = 0; d0 < 2; ++d0) stg[orow * 64 + d0 * 32 + r32] = f2bf(o[d0][r] * rli[r]); }
      asm volatile("s_waitcnt lgkmcnt(0)" ::: "memory");
#pragma unroll
      for (int i = 0; i < 4; ++i) { const int row = i * 8 + (lane >> 3), ch = lane & 7; const v4u v = *(const LAS v4u*)(stg + row * 64 + ch * 8); *(v4u*)(Ow + (long)row * 1024 + ch * 8) = v;
          float ss = (bflo(v.x) * bflo(v.x) + bfhi(v.x) * bfhi(v.x)) + (bflo(v.y) * bflo(v.y) + bfhi(v.y) * bfhi(v.y)) + (bflo(v.z) * bflo(v.z) + bfhi(v.z) * bfhi(v.z)) + (bflo(v.w) * bflo(v.w) + bfhi(v.w) * bfhi(v.w));
          ss += __shfl_xor(ss, 1); ss += __shfl_xor(ss, 2); ss += __shfl_xor(ss, 4);
          if (ch == 0) ((GAS float*)SS)[(rowbase + q0 + wid * 32 + row) * 16 + 8 + h] = ss; } }
    asm volatile("s_waitcnt lgkmcnt(0)\n\ts_barrier" ::: "memory");
#undef DMA_K
#undef DMA_V
#undef ROT
#undef RESC
#undef PKW
#undef PAF
#undef VFR
#undef VRD
#undef KRD
#undef GAPA
#undef GAPB
#undef EX
#undef STEP
#undef ENDW
#undef ZERO16
}
__device__ __forceinline__ void attn_phase(const bf16* QN, const bf16* KN, const bf16* KVR, bf16* MIX, float* SS, const float* qg, LAS unsigned char* lds, int vcu, int G) {
#pragma unroll 1
    for (int v = vcu; v < 256; v += G) {
        const int bh = v >> 2, s = v & 3;
#pragma unroll 1
        for (int i = 0; i < 4; ++i) { const int qb = (i == 0) ? s : (i == 1) ? 7 - s : (i == 2) ? 8 + s : 15 - s; attn_unit(bh >> 3, bh & 7, qb, QN, KN, KVR, MIX, SS, qg, lds); } }
}
}
#define XB_TMO      128
#define XB_XCNT(j)  (256  + 64 * (j))
#define XB_XSUB(j)  (1280 + 64 * (j))
#define XB_XGEN(j)  (2304 + 64 * (j))
#define XB_TOP      3328
#define XB_TOPGEN   3392
#define XCD_BAR_WORDS 3456
#define XB_SPIN_CAP (1u << 18)
__device__ __forceinline__ unsigned xb_ld(unsigned* p)              { return __hip_atomic_load(p, __ATOMIC_RELAXED, __HIP_MEMORY_SCOPE_AGENT); }
__device__ __forceinline__ unsigned xb_add(unsigned* p, unsigned v) { return __hip_atomic_fetch_add(p, v, __ATOMIC_RELAXED, __HIP_MEMORY_SCOPE_AGENT); }
__device__ __forceinline__ unsigned xb_xcc_id() { return (unsigned)__builtin_amdgcn_s_getreg((3 << 11) | 20) & 0xFu; }
#define XB_SPIN(cond, bar) do { unsigned _sp = 0; while (cond) { __builtin_amdgcn_s_sleep(1); \
    if ((++_sp & 255u) == 0u) { if (xb_ld(&(bar)[XB_TMO])) break; if (_sp > XB_SPIN_CAP) { atomicAdd(&(bar)[XB_TMO], 1u); break; } } } } while (0)
struct XcdBarrier { unsigned* bar; unsigned x; volatile LAS unsigned* st; };
__device__ __forceinline__ XcdBarrier xcd_barrier_post(unsigned* bar, volatile LAS unsigned* st) {
    XcdBarrier b; b.bar = bar; b.x = xb_xcc_id(); b.st = st;
    if (threadIdx.x == 0) (void)xb_add(&bar[XB_XCNT(b.x)], 1u);
    return b;
}
__device__ __forceinline__ void xcd_barrier_complete(unsigned* bar, unsigned x, unsigned& nloc, unsigned& nx) {
    const unsigned G = gridDim.x * gridDim.y * gridDim.z;
    unsigned sum, cnt, mine, sp = 0u;
    for (;;) {
        sum = 0u; cnt = 0u; mine = 0u;
#pragma unroll
        for (unsigned j = 0; j < 16; ++j) { const unsigned c = xb_ld(&bar[XB_XCNT(j)]); sum += c; cnt += (c > 0u) ? 1u : 0u; mine = (j == x) ? c : mine; }
        if (sum == G) break;
        __builtin_amdgcn_s_sleep(1);
        if ((++sp & 255u) == 0u) { if (xb_ld(&bar[XB_TMO])) break; if (sp > XB_SPIN_CAP) { atomicAdd(&bar[XB_TMO], 1u); break; } }
    }
    nloc = mine > 0u ? mine : 1u; nx = cnt > 0u ? cnt : 1u;
}
__device__ __forceinline__ void xcd_barrier(const XcdBarrier& b) {
    asm volatile("s_waitcnt vmcnt(0)" ::: "memory");
    __syncthreads();
    if (threadIdx.x == 0) {
        unsigned* bar = b.bar; asm volatile("" : "+s"(bar));
        __builtin_amdgcn_s_waitcnt(0);
        unsigned nloc = b.st[0], nx = b.st[1];
        if (nloc == 0u) { xcd_barrier_complete(bar, b.x, nloc, nx); b.st[0] = nloc; b.st[1] = nx; }
        const unsigned old = xb_add(&bar[XB_XSUB(b.x)], 1u);
        const unsigned gen = old / nloc;
        if (old + 1u == (gen + 1u) * nloc) {
            __builtin_amdgcn_fence(__ATOMIC_RELEASE, "agent");
            asm volatile("s_waitcnt vmcnt(0)" ::: "memory");
            const unsigned og = xb_add(&bar[XB_TOP], 1u);
            const unsigned tg = og / nx;
            if (og + 1u == (tg + 1u) * nx) xb_add(&bar[XB_TOPGEN], 1u);
            else XB_SPIN(xb_ld(&bar[XB_TOPGEN]) == tg, bar);
            __builtin_amdgcn_fence(__ATOMIC_ACQUIRE, "agent");
            xb_add(&bar[XB_XGEN(b.x)], 1u);
            asm volatile("s_waitcnt vmcnt(0)" ::: "memory");
        } else {
            XB_SPIN(xb_ld(&bar[XB_XGEN(b.x)]) == gen, bar);
            __builtin_amdgcn_fence(__ATOMIC_ACQUIRE, "agent");
            asm volatile("s_waitcnt vmcnt(0)" ::: "memory");
        }
    }
    __syncthreads();
}

constexpr int RING_BYTES = 131072, MISC_OFF = RING_BYTES + 320, LDS_BYTES = 147456;
enum { PH_PREP = 0, PH_NORM1, PH_INPROJ, PH_SSMS, PH_SSMY, PH_GLU, PH_LATNORM, PH_QUP, PH_KVUP, PH_QKPREP, PH_ATTN, PH_OUTNORM, PH_OUTPROJ, PH_NORM2, PH_F0, PH_F1, PH_F2, PH_F3, PH_F4, PH_PER_LAYER = 32 };
struct Args { Params P; int ph_lo, ph_hi; unsigned skip_mask; int pad; };

struct LArgs { unsigned char* ws; float* outp; int G, bx, vcu, pad; };
#ifndef REPMASK0
#define REPMASK0 0x0
#define REPMASK1 0x0
#endif
#define REPS(k) (((((unsigned)(layer == 0 ? REPMASK0 : REPMASK1)) >> (k)) & 1u) ? 2 : 1)
#define RUN(k, ...) do { { const float rep_scale = 1.f; (void)rep_scale; __VA_ARGS__; } if constexpr (REPS(k) > 1) { const float rep_scale = 0.f; (void)rep_scale; __syncthreads(); __VA_ARGS__; } } while (0)
#define BAR() xcd_barrier(bar)
template <int layer> __device__ __forceinline__ void run_layer(const LArgs a, const XcdBarrier bar, LAS unsigned char* lds) {
    unsigned char* const ws = a.ws; float* const outp = a.outp; const int G = a.G, bx = a.bx, vcu = a.vcu;
    const int tid = threadIdx.x, lane = tid & 63, wave = __builtin_amdgcn_readfirstlane(tid >> 6);
    const int gw = vcu * 8 + wave, NGW = G * 8, gtid = bx * 512 + tid, gthreads = G * 512;
    bf16* HB = (bf16*)(ws + WS_HB); bf16* Z = (bf16*)outp; bf16* LAT = (bf16*)outp; bf16* KN = (bf16*)outp; bf16* MIX = (bf16*)(ws + WS_MIX); bf16* PL = (bf16*)(ws + WS_PL);
    bf16* UA = (bf16*)(ws + WS_UAUG); bf16* YG = (bf16*)(ws + WS_YG); bf16* KVR = (bf16*)(ws + WS_KVRAW); bf16* QR = (bf16*)(ws + WS_QRAW);
    bf16* ACTD = (bf16*)(ws + WS_ACTD); bf16* ACTM = (bf16*)(ws + WS_ACTM);
    LAS float* scr = (LAS float*)(lds + wave * 16384);
    unsigned char* wsm = ws + WS_WSMALL + (size_t)layer * WSM_STRIDE;
    RUN(0, { for (int j = bx; j < 256; j += G) ph_ssm_prep(ws, layer, j & 31, j >> 5, lds, tid);
             conv_small(ws, layer, scr, gw, NGW, lane, gtid, gthreads);
             if constexpr (layer == 0) conv_dense(ws, scr, gw, NGW, lane);
             if constexpr (layer == 0) ph_x2hb(kin(I_X), HB, (float*)(ws + WS_SS3), gw, NGW, lane); });
    BAR();
    RUN(1, { DenseSched S{(const char*)HB, (const char*)(wsm + WSM_IN), DM * 2, DM * 2, M / 256, 4, DM / 64, G, bx}; EpiInProjRs E{UA, PL, (const float*)(ws + WS_SS3), lds, (float*)(ws + WS_SS)}; pg8::gemm_phase(lds, S, E); });
    BAR();
    static_assert(SSM_CT == 1, "one output column tile per (group, row tile): the S and Y unit lists coincide");
    RUN(3, { for (int L = bx; L < NG * SSM_RT; L += G) { SsmSSched S{(const char*)UA, (const char*)(ws + WS_BIGW + BW_WST), UAW * 2, NYC * 2, G, L}; EpiSsmS E{UA, (const float*)(ws + WS_APOW)}; pg8::gemm_phase<EpiSsmS, SsmSSched, false, true>(lds, S, E); }
             asm volatile("s_waitcnt vmcnt(0)" ::: "memory"); __syncthreads();
             { SsmYSched S{(const char*)UA, (const char*)(ws + WS_BIGW + BW_MAUG), UAW * 2, UAW * 2, G, bx}; EpiSsmY E{YG}; pg8::gemm_phase(lds, S, E); }
             { DenseSched S{(const char*)PL, (const char*)(wsm + WSM_Q), 512 * 2, QRANK * 2, M / 256, 3, 4, G, bx}; EpiBf16Rs E{QR, 768, (const float*)(ws + WS_SS), 0, 1.f / QRANK, lds}; pg8::gemm_phase(lds, S, E); }
             { DenseSched S{(const char*)(PL + 256), (const char*)(wsm + WSM_KV), 512 * 2, 256 * 2, M / 256, 4, 4, G, bx}; EpiBf16Rs E{KVR, 1024, (const float*)(ws + WS_SS), 4, 1.f / KVRANK, lds}; pg8::gemm_phase(lds, S, E); } });
    BAR();
    RUN(4, { { DenseSched S{(const char*)YG, (const char*)(wsm + WSM_GLU), DSSM * 2, DSSM * 2, M / 256, 2, DSSM / 64, G, bx}; EpiGlu E{YG, kin(I_B_GLU) + layer * DSSM, MIX, (float*)(ws + WS_SS)}; pg8::gemm_phase(lds, S, E); }
             ph_qkprep(KVR, PL, KN, kin(I_K_GAIN) + layer * DQK, gw, NGW, lane); });
    BAR();
    RUN(5, att::attn_phase(QR, KN, KVR, MIX, (float*)(ws + WS_SS), kin(I_Q_GAIN) + layer * DQK, lds, vcu, G));
    BAR();
    RUN(7, { DenseSched S{(const char*)MIX, (const char*)(wsm + WSM_OUT), DM * 2, DM * 2, M / 256, 4, DM / 64, G, bx}; EpiOutProj E{HB, (const float*)(ws + WS_SS), rep_scale, lds, (float*)(ws + WS_SS2)}; pg8::gemm_phase(lds, S, E); });
    BAR();
    if constexpr (layer == 0) {
        RUN(9, { DenseSched S{(const char*)HB, (const char*)(ws + WS_BIGW + BW_DGU), DM * 2, DM * 2, M / 256, 22, DM / 64, G, bx}; EpiSwigluRs E{ACTD, FFD, (const float*)(ws + WS_SS2), lds}; pg8::gemm_phase(lds, S, E); });
        BAR();
        RUN(10, { DenseSched S{(const char*)ACTD, (const char*)(ws + WS_BIGW + BW_DD), FFD * 2, FFD * 2, M / 256, 4, FFD / 64, G, bx}; EpiResid E{HB, rep_scale, (float*)(ws + WS_SS3)}; pg8::gemm_phase(lds, S, E); });
        BAR();
    } else {
        unsigned char* rt = ws + WS_ROUTE;
        RUN(8, { ph_norm_route(HB, kin(I_FFN_NORM) + layer * DM, kin(I_MW_ROUTER), Z, (v4u*)rt, gw, NGW, lane); });
        BAR();
        RUN(9, { if (bx == G - 1) { ph_route_sort((const v4u*)rt, rt, lds, tid); __syncthreads(); } conv_moe(ws, scr, gw, NGW, lane); });
        BAR();
        bf16* PART0 = (bf16*)((unsigned char*)outp + 64 * MiB); bf16* PART1 = (bf16*)(ws + WS_BIGW);
#pragma unroll 1
        for (int k = 0; k < 2; ++k) {
            const int* tile_e = (const int*)(rt + RT_TILE_E) + k * MOE_TILES; const int* slot_tok = (const int*)(rt + RT_SLOT_TOK) + k * MOE_SLOTS; const float* slot_w = (const float*)(rt + RT_SLOT_W) + k * MOE_SLOTS; const int* ntl = (const int*)(rt + RT_NTILES) + k;
            if (k == 1) ph_moe_reduce<false>((const int*)(rt + RT_SLOT_TOK), (const int*)(rt + RT_NTILES), PART0, HB, outp, gw, NGW, lane);
            LAS int* te = (LAS int*)(lds + pg8::IDX_OFF + 8192);
            if (tid < MOE_TILES) te[tid] = ((const GAS int*)tile_e)[tid];
            const int ntiles = *((const GAS int*)ntl);
            __syncthreads();
            RUN(10, { MoeSched S{(const char*)Z, (const char*)(ws + WS_BIGW + BW_MGU), DM * 2, DM * 2, (size_t)2 * FFE * DM * 2, 28, DM / 64, G, bx, te, slot_tok, ntiles}; EpiSwiglu E{ACTM, FFE}; pg8::gemm_phase(lds, S, E); });
            BAR();
            if (k == 0) RUN(11, { MoeDownSched S{(const char*)ACTM, (const char*)(ws + WS_BIGW + BW_MD), FFE * 2, FFE * 2, (size_t)DM * FFE * 2, G, bx, te, ntiles}; EpiMoeDown<false> E{slot_tok, slot_w, HB, outp, rep_scale, ntl, PART0}; pg8::gemm_phase(lds, S, E); });
            else RUN(12, { MoeDownSched S{(const char*)ACTM, (const char*)(ws + WS_BIGW + BW_MD), FFE * 2, FFE * 2, (size_t)DM * FFE * 2, G, bx, te, ntiles}; EpiMoeDown<true> E{slot_tok, slot_w, HB, outp, 1.f, ntl, PART1}; pg8::gemm_phase(lds, S, E); });
            BAR();
            if (k == 1) ph_moe_reduce<true>(slot_tok, ntl, PART1, HB, outp, gw, NGW, lane);
        }
    }
}
__global__ void __launch_bounds__(512, 2) fwd(Args args) {
    extern __shared__ __attribute__((aligned(16))) unsigned char lds_raw[];
    LAS unsigned char* lds = (LAS unsigned char*)lds_raw;
    unsigned char* const ws = args.P.ws; float* const outp = args.P.out;
    const int tid = threadIdx.x, lane = tid & 63, wave = __builtin_amdgcn_readfirstlane(tid >> 6);
    const int G = gridDim.x, bx = blockIdx.x; const int vcu = (G % 8 == 0) ? (bx % 8) * (G / 8) + bx / 8 : bx;
    const int gw = vcu * 8 + wave, NGW = G * 8, gtid = bx * 512 + tid, gthreads = G * 512;
    volatile LAS unsigned* MISC = (volatile LAS unsigned*)(lds + MISC_OFF);
    for (int u = tid; u < (LDS_BYTES - RING_BYTES) / 4; u += 512) ((LAS unsigned*)(lds + RING_BYTES))[u] = 0u;
    __syncthreads();
    unsigned* ctl = (unsigned*)(ws + WS_CTL);
    XcdBarrier bar = xcd_barrier_post(ctl + CW_BAR, MISC + 8);

    LArgs la; la.ws = ws; la.outp = outp; la.G = G; la.bx = bx; la.vcu = vcu; la.pad = 0;
    run_layer<0>(la, bar, lds);
    run_layer<1>(la, bar, lds);
}
static void launch_fwd(const Params& P, int lo, int hi, unsigned skip, int grid, hipStream_t st) {
    Args a{}; a.P = P; a.ph_lo = lo; a.ph_hi = hi; a.skip_mask = skip; a.pad = 0;
    hipLaunchKernelGGL(fwd, dim3(grid), dim3(512), LDS_BYTES, st, a);
}
extern "C" void kernel_launch(void* const* d_in, const int* in_sizes, int n_in, void* d_out, int out_size, void* d_ws, size_t ws_size, hipStream_t stream) {
    static int grid = 0;
    if (grid == 0) {
        if (n_in != 30 || out_size != M * DM || ws_size < WS_END) { fprintf(stderr, "kernel_launch: unexpected shapes: n_in %d out %d ws %zu (need %zu)\n", n_in, out_size, ws_size, (size_t)WS_END); grid = -1; return; }
        int dev = 0, cus = 0;
        if (hipGetDevice(&dev) != hipSuccess || hipDeviceGetAttribute(&cus, hipDeviceAttributeMultiprocessorCount, dev) != hipSuccess) { grid = -1; return; }
        if (hipFuncSetAttribute((const void*)fwd, hipFuncAttributeMaxDynamicSharedMemorySize, LDS_BYTES) != hipSuccess) { fprintf(stderr, "kernel_launch: hipFuncSetAttribute failed\n"); grid = -1; return; }
        (void)hipGetLastError();
        grid = cus;
    }
    if (grid < 0) return;
    Params P{};
    for (int i = 0; i < 30; ++i) P.in[i] = (const float*)d_in[i];
    P.out = (float*)d_out; P.ws = (unsigned char*)d_ws;
    unsigned char* ws = P.ws;
    (void)hipMemsetAsync(ws + WS_CTL, 0, CTL_ZERO_BYTES, stream);
    launch_fwd(P, 0, DEPTH * PH_PER_LAYER, 0, grid, stream);
}
```
